# Optimizing an MI355X kernel written in HIP

```python
import jax, jax.numpy as jnp
from jax import lax
import numpy as np

D_MODEL = 1024
BATCH = 2
SEQ = 8192
DEPTH = 2

ML_HEADS = 4
ML_WIDTH = D_MODEL
ML_HEAD_DIM = ML_WIDTH // ML_HEADS
ML_CHUNK = 64
CONV_WIDTH = 4
FOX_HEADS = 8
FOX_WIDTH = D_MODEL
FOX_HEAD_DIM = FOX_WIDTH // FOX_HEADS
Q_BLOCK = 128
POOL_GROUPS = 4
POOL_WIDTH = D_MODEL
POOL_GROUP_DIM = POOL_WIDTH // POOL_GROUPS
POOL_WINDOWS = (2, 4, 8, 16)
N_BRANCH = 3
EPS = 1e-6

SPLIT_SIZES = ((ML_WIDTH,) * 5 + (ML_HEADS,) * 2 + (FOX_WIDTH,) * 4 + (FOX_HEADS,)
               + (POOL_WIDTH,) * 2 + (N_BRANCH * D_MODEL,))
N_IN = sum(SPLIT_SIZES)
SPLIT_POINTS = tuple(np.cumsum(SPLIT_SIZES)[:-1].tolist())

kernel_name = "hybrid_mlstm_fox_pool_gated"


def rmsnorm(x, g):
    xf = x.astype(jnp.float32)
    r = lax.rsqrt(jnp.mean(xf * xf, axis=-1, keepdims=True) + EPS)
    return (xf * r).astype(x.dtype) * g


def causal_depthwise_conv(x, w):
    K = w.shape[0]
    S = x.shape[1]
    xp = jnp.pad(x, ((0, 0), (K - 1, 0), (0, 0)))
    out = xp[:, 0:S] * w[0]
    for kk in range(1, K):
        out = out + xp[:, kk:kk + S] * w[kk]
    return out


def mlstm_chunkwise(q, k, v, i_pre, f_pre):
    B, S, H, dh = q.shape
    L = ML_CHUNK
    nc = S // L
    q = q.astype(jnp.float32) * (dh ** -0.5)
    k = k.astype(jnp.float32)
    v = v.astype(jnp.float32)
    log_f = jax.nn.log_sigmoid(f_pre.astype(jnp.float32))
    i_g = i_pre.astype(jnp.float32)

    def to_chunks(a):
        a = a.reshape((B, nc, L, H) + a.shape[3:])
        return jnp.moveaxis(a, (1, 3), (0, 2))

    tri = jnp.tril(jnp.ones((L, L), dtype=bool))

    def step(carry, inp):
        C, n, m = carry
        qc, kc, vc, ic, fc = inp
        b = jnp.cumsum(fc, axis=-1)
        D = b[..., :, None] - b[..., None, :] + ic[..., None, :]
        D = jnp.where(tri, D, -jnp.inf)
        inter = b + m[..., None]
        m_t = jnp.maximum(inter, jnp.max(D, axis=-1))
        w_inter = jnp.exp(inter - m_t)
        P = jnp.exp(D - m_t[..., None]) * jnp.einsum('bhtd,bhsd->bhts', qc, kc)
        num = (w_inter[..., None] * jnp.einsum('bhvk,bhtk->bhtv', C, qc)
               + jnp.einsum('bhts,bhsv->bhtv', P, vc))
        den = w_inter * jnp.einsum('bhk,bhtk->bht', n, qc) + jnp.sum(P, axis=-1)
        h = num / jnp.maximum(jnp.abs(den), jnp.exp(-m_t))[..., None]
        bL = b[..., -1]
        dec = bL[..., None] - b + ic
        m_new = jnp.maximum(bL + m, jnp.max(dec, axis=-1))
        w_s = jnp.exp(dec - m_new[..., None])
        w_old = jnp.exp(bL + m - m_new)
        C_new = w_old[..., None, None] * C + jnp.einsum('bhsv,bhsk->bhvk', vc * w_s[..., None], kc)
        n_new = w_old[..., None] * n + jnp.einsum('bhs,bhsk->bhk', w_s, kc)
        return (C_new, n_new, m_new), h

    init = (jnp.zeros((B, H, dh, dh), jnp.float32),
            jnp.zeros((B, H, dh), jnp.float32),
            jnp.zeros((B, H), jnp.float32))
    _, hs = lax.scan(step, init, (to_chunks(q), to_chunks(k), to_chunks(v),
                                  to_chunks(i_g), to_chunks(log_f)))
    hs = jnp.moveaxis(hs, (0, 2), (1, 3))
    return hs.reshape(B, S, H, dh)


def forgetting_attention(q, k, v, f_pre):
    B, S, H, dh = q.shape
    scale = dh ** -0.5
    q = jnp.moveaxis(q, 2, 1)
    k = jnp.moveaxis(k, 2, 1)
    v = jnp.moveaxis(v, 2, 1)
    F = jnp.moveaxis(jnp.cumsum(jax.nn.log_sigmoid(f_pre.astype(jnp.float32)), axis=1), 2, 1)
    k_pos = jnp.arange(S)

    def block(i):
        start = i * Q_BLOCK
        qb = lax.dynamic_slice_in_dim(q, start, Q_BLOCK, axis=2)
        Fb = lax.dynamic_slice_in_dim(F, start, Q_BLOCK, axis=2)
        s = (jnp.einsum('bhqd,bhkd->bhqk', qb, k).astype(jnp.float32) * scale
             + Fb[..., :, None] - F[..., None, :])
        q_pos = start + jnp.arange(Q_BLOCK)
        s = jnp.where(k_pos[None, :] <= q_pos[:, None], s, -jnp.inf)
        p = jax.nn.softmax(s, axis=-1).astype(v.dtype)
        return jnp.einsum('bhqk,bhkd->bhqd', p, v)

    out = lax.map(block, jnp.arange(S // Q_BLOCK))
    out = jnp.moveaxis(out, 0, 2).reshape(B, H, S, dh)
    return jnp.moveaxis(out, 1, 2)


def multiscale_pool(u, pool_w, pool_scale):
    B, S, W = u.shape
    uf = u.astype(jnp.float32)
    cs = jnp.concatenate([jnp.zeros((B, 1, W), jnp.float32), jnp.cumsum(uf, axis=1)], axis=1)
    cs = cs.reshape(B, S + 1, POOL_GROUPS, POOL_GROUP_DIM)
    ug = uf.reshape(B, S, POOL_GROUPS, POOL_GROUP_DIM)
    t = jnp.arange(S)[:, None]
    win = jnp.array(POOL_WINDOWS, dtype=jnp.int32)[None, :]
    lo = jnp.maximum(t + 1 - win, 0)
    g_idx = jnp.arange(POOL_GROUPS)[None, :]
    win_sum = cs[:, 1:] - cs[:, lo, g_idx]
    cnt = jnp.minimum(t + 1, win).astype(jnp.float32)
    d = win_sum / cnt[None, :, :, None] - ug
    y = jnp.einsum('bsgc,gcd->bsgd', d, pool_w.astype(jnp.float32)).reshape(B, S, W)
    return (y * pool_scale).astype(u.dtype)


def hybrid_layer(x, norm_g, w_in, conv_w, ml_bi, ml_bf, ml_norm_g, fox_bf,
                 pool_w, pool_scale, w_branch, w_out):
    B, S, _ = x.shape
    h = rmsnorm(x, norm_g)
    proj = jnp.einsum('bsd,dn->bsn', h, w_in)
    (aq, ak, av, ao, az, ai, af, bq, bk, bv, bz, bf, cu, cz, gates) = jnp.split(proj, SPLIT_POINTS, axis=-1)

    qk = jax.nn.silu(causal_depthwise_conv(jnp.concatenate([aq, ak], axis=-1), conv_w))
    aq, ak = jnp.split(qk, 2, axis=-1)
    hA = mlstm_chunkwise(aq.reshape(B, S, ML_HEADS, ML_HEAD_DIM),
                         ak.reshape(B, S, ML_HEADS, ML_HEAD_DIM),
                         av.reshape(B, S, ML_HEADS, ML_HEAD_DIM),
                         ai + ml_bi, af + ml_bf)
    hA = hA * lax.rsqrt(jnp.mean(hA * hA, axis=-1, keepdims=True) + EPS)
    yA = (hA.reshape(B, S, ML_WIDTH).astype(x.dtype) * ml_norm_g
          * jax.nn.sigmoid(ao) * jax.nn.silu(az))

    hB = forgetting_attention(bq.reshape(B, S, FOX_HEADS, FOX_HEAD_DIM),
                              bk.reshape(B, S, FOX_HEADS, FOX_HEAD_DIM),
                              bv.reshape(B, S, FOX_HEADS, FOX_HEAD_DIM),
                              bf + fox_bf)
    yB = hB.reshape(B, S, FOX_WIDTH) * jax.nn.silu(bz)

    yC = multiscale_pool(cu, pool_w, pool_scale) * jax.nn.silu(cz)

    ys = jnp.stack([yA, yB, yC], axis=2)
    yb = jnp.einsum('bsnw,nwd->bsnd', ys, w_branch)
    g = jax.nn.sigmoid(gates.reshape(B, S, N_BRANCH, D_MODEL))
    merged = jnp.sum(g * yb, axis=2)
    return x + jnp.einsum('bsd,de->bse', merged, w_out)


def setup_inputs(seed: int = 0) -> dict:
    key = jax.random.key(seed)
    ks = jax.random.split(key, 16)
    f32 = jnp.float32
    nrm = lambda k, shape: jax.random.normal(k, shape, f32)
    x = nrm(ks[0], (BATCH, SEQ, D_MODEL))
    norm_g = 1.0 + 0.02 * nrm(ks[1], (DEPTH, D_MODEL))
    w_in = nrm(ks[2], (DEPTH, D_MODEL, N_IN)) * D_MODEL ** -0.5
    conv_w = nrm(ks[3], (DEPTH, CONV_WIDTH, 2 * ML_WIDTH)) * CONV_WIDTH ** -0.5
    ml_bi = 0.1 * nrm(ks[4], (DEPTH, ML_HEADS))
    ml_bf = jnp.linspace(3.0, 6.0, ML_HEADS, dtype=f32)[None, :] + 0.1 * nrm(ks[5], (DEPTH, ML_HEADS))
    ml_norm_g = 1.0 + 0.02 * nrm(ks[6], (DEPTH, ML_WIDTH))
    fox_bf = jnp.linspace(0.0, 4.0, FOX_HEADS, dtype=f32)[None, :] + 0.1 * nrm(ks[7], (DEPTH, FOX_HEADS))
    pool_w = nrm(ks[8], (DEPTH, POOL_GROUPS, POOL_GROUP_DIM, POOL_GROUP_DIM)) * POOL_GROUP_DIM ** -0.5
    pool_scale = 1.0 + 0.02 * nrm(ks[9], (DEPTH, POOL_WIDTH))
    w_branch = nrm(ks[10], (DEPTH, N_BRANCH, ML_WIDTH, D_MODEL)) * ML_WIDTH ** -0.5
    w_out = nrm(ks[11], (DEPTH, D_MODEL, D_MODEL)) * D_MODEL ** -0.5
    final_g = 1.0 + 0.02 * nrm(ks[12], (D_MODEL,))
    return {"x": x, "norm_g": norm_g, "w_in": w_in, "conv_w": conv_w, "ml_bi": ml_bi,
            "ml_bf": ml_bf, "ml_norm_g": ml_norm_g, "fox_bf": fox_bf, "pool_w": pool_w,
            "pool_scale": pool_scale, "w_branch": w_branch, "w_out": w_out, "final_g": final_g}


def reference(x, norm_g, w_in, conv_w, ml_bi, ml_bf, ml_norm_g, fox_bf,
              pool_w, pool_scale, w_branch, w_out, final_g):
    for l in range(DEPTH):
        x = hybrid_layer(x, norm_g[l], w_in[l], conv_w[l], ml_bi[l], ml_bf[l], ml_norm_g[l],
                         fox_bf[l], pool_w[l], pool_scale[l], w_branch[l], w_out[l])
    return rmsnorm(x, final_g)
```

```cpp
#include <hip/hip_runtime.h>
#include <hip/hip_cooperative_groups.h>
#include <cstdio>
#include <cstdint>
namespace cg = cooperative_groups;

#ifndef MK_MULTI
#define MK_MULTI 0
#endif

namespace pg8 {
#define PG8_LAS __attribute__((address_space(3)))
typedef unsigned short bf16_t;
typedef short bf16x8 __attribute__((ext_vector_type(8)));
typedef float f32x4 __attribute__((ext_vector_type(4)));
typedef unsigned u32x4 __attribute__((ext_vector_type(4)));
constexpr int BM = 256, BK = 64, HALF = 128, HTB = HALF * BK * 2  , STAGE_BYTES = 8 * HTB, NXCD = 8, WGM = 8;

__host__ __device__ __forceinline__ int lds_byte(int r, int c) { const int st = (r >> 4) * 2 + (c >> 5), rr = r & 15, cc = c & 31, ob = rr * 64 + cc * 2; return st * 1024 + (ob ^ (((ob >> 9) & 1) << 5)); }
__host__ __device__ __forceinline__ void stage_rc(int b, int& R, int& C) { const int st = b / 1024, sb = b % 1024, swz = sb ^ (((sb >> 9) & 1) << 5); R = (st >> 1) * 16 + swz / 64; C = (st & 1) * 32 + (swz % 64) / 2; }
__host__ __device__ __forceinline__ int perm32(int rho) { const int n = rho >> 4, i = rho & 15; return 8 * (i >> 2) + 4 * n + (i & 3); }

struct Unit { int pm, pn, z; };
struct Gemm { const bf16_t* A; const bf16_t* Bt; int lda, ldb, K; };

__device__ __forceinline__ unsigned cvt_pk_bf16(float lo, float hi) { unsigned r; asm volatile("v_cvt_pk_bf16_f32 %0, %1, %2" : "=v"(r) : "v"(lo), "v"(hi)); return r; }

template <class Epi, class Sched, bool ALIGN_EPI = false, bool SP2 = false>
__device__ __forceinline__ void gemm_phase(PG8_LAS unsigned char* lds, const Gemm g, const Sched& S, const Epi& E, const int tid) {
    const int wid = __builtin_amdgcn_readfirstlane(tid >> 6), lane = tid & 63, wr = wid >> 2, wc = wid & 3, fr = lane & 15, fq = lane >> 4;
    const int K = g.K, nt = K / BK;
    unsigned voffA[2], voffB[2];
#pragma unroll
    for (int i = 0; i < 2; ++i) { int R, C; stage_rc(tid * 16 + i * 8192, R, C); const int Rb = Epi::PERM ? ((R & ~31) + perm32(R & 31)) : R;
        voffA[i] = (unsigned)(R * g.lda + C) * 2u; voffB[i] = (unsigned)(Rb * g.ldb + C) * 2u; }
    const size_t kstep = (size_t)(BK * 2);
    const size_t hstepA = (size_t)HALF * g.lda * 2, hstepB = (size_t)HALF * g.ldb * 2;
    const unsigned ldsw = (unsigned)wid * 1024u;
    const int aoff = lds_byte(wr * 64 + fr, fq * 8), boff = lds_byte(wc * 32 + fr, fq * 8);
#define PG8_SA(b, h) (((b) * 2 + (h)) * HTB)
#define PG8_SB(b, h) ((4 + (b) * 2 + (h)) * HTB)
#define PG8_STAGE(bufoff, gbase, voff) do { _Pragma("unroll") for (int _i = 0; _i < 2; ++_i) \
        __builtin_amdgcn_global_load_lds((const unsigned*)((const char*)(gbase) + (voff)[_i]), (PG8_LAS unsigned*)(lds + (bufoff) + ldsw + _i * 8192), 16, 0, 0); } while (0)
#define PG8_LDA(dst, b, h) do { _Pragma("unroll") for (int m = 0; m < 4; ++m) _Pragma("unroll") for (int k = 0; k < 2; ++k) dst[m][k] = *(const PG8_LAS bf16x8*)(lds + PG8_SA(b, h) + aoff + m * 2048 + k * 1024); } while (0)
#define PG8_LDB(dst, b, h) do { _Pragma("unroll") for (int n = 0; n < 2; ++n) _Pragma("unroll") for (int k = 0; k < 2; ++k) dst[n][k] = *(const PG8_LAS bf16x8*)(lds + PG8_SB(b, h) + boff + n * 2048 + k * 1024); } while (0)
#define PG8_MMA(ai, bj, At, Bt) do { __builtin_amdgcn_s_setprio(1); _Pragma("unroll") for (int m = 0; m < 4; ++m) _Pragma("unroll") for (int n = 0; n < 2; ++n) _Pragma("unroll") for (int k = 0; k < 2; ++k) \
        acc[ai][bj][m][n] = __builtin_amdgcn_mfma_f32_16x16x32_bf16(Bt[n][k], At[m][k], acc[ai][bj][m][n], 0, 0, 0); __builtin_amdgcn_s_setprio(0); } while (0)
#define PG8_WAIT_V(n) asm volatile("s_waitcnt vmcnt(" #n ")" ::: "memory")
#define PG8_WAIT_L(n) asm volatile("s_waitcnt lgkmcnt(" #n ")" ::: "memory")
#define PG8_BAR __builtin_amdgcn_s_barrier()
#define PG8_SCHED __builtin_amdgcn_sched_barrier(0)
    Unit cur, nxt; int ui = 0;
    if (!S.next(0, cur)) return;
    f32x4 acc[2][2][4][2];
#pragma unroll
    for (int a = 0; a < 2; ++a)
#pragma unroll
        for (int b = 0; b < 2; ++b)
#pragma unroll
            for (int m = 0; m < 4; ++m)
#pragma unroll
                for (int n = 0; n < 2; ++n) acc[a][b][m][n] = (f32x4){0.f, 0.f, 0.f, 0.f};
    bf16x8 At[4][2], B0[2][2], B1[2][2];
    const char* cA = (const char*)g.A + S.a_off(cur); const char* cB = (const char*)g.Bt + S.b_off(cur);
    S.a_ready(cur);
    if constexpr (SP2) {
        PG8_STAGE(PG8_SB(0, 0), cB, voffB); PG8_STAGE(PG8_SB(0, 1), cB + hstepB, voffB); PG8_STAGE(PG8_SA(0, 0), cA, voffA); PG8_STAGE(PG8_SA(0, 1), cA + hstepA, voffA);
        if (wr == 1) PG8_BAR;
        PG8_WAIT_V(2); PG8_BAR;
        PG8_STAGE(PG8_SB(1, 0), cB + kstep, voffB); PG8_STAGE(PG8_SA(1, 0), cA + kstep, voffA); PG8_STAGE(PG8_SB(1, 1), cB + hstepB + kstep, voffB);
        PG8_WAIT_V(6); PG8_BAR;
    } else {
        PG8_STAGE(PG8_SB(0, 0), cB, voffB); PG8_STAGE(PG8_SA(0, 0), cA, voffA); PG8_STAGE(PG8_SB(0, 1), cB + hstepB, voffB); PG8_STAGE(PG8_SA(0, 1), cA + hstepA, voffA);
        if (wr == 1) PG8_BAR;
        PG8_WAIT_V(4); PG8_BAR;
        PG8_STAGE(PG8_SB(1, 0), cB + kstep, voffB); PG8_STAGE(PG8_SA(1, 0), cA + kstep, voffA); PG8_STAGE(PG8_SB(1, 1), cB + hstepB + kstep, voffB);
        PG8_WAIT_V(6); PG8_BAR;
    }
    for (;;) {
        const bool has_next = S.next(ui + 1, nxt);
        const char* nA = has_next ? (const char*)g.A + S.a_off(nxt) : cA; const char* nB = has_next ? (const char*)g.Bt + S.b_off(nxt) : cB;
        for (int t = 0; t < nt; t += 2) {
            const bool last = (t == nt - 2);
            const char* a1 = cA + (size_t)(t + 1) * kstep;
            const char* a2 = last ? nA : cA + (size_t)(t + 2) * kstep; const char* b2 = last ? nB : cB + (size_t)(t + 2) * kstep;
            const char* a3 = a2 + kstep; const char* b3 = b2 + kstep;
            if (last && has_next) S.a_ready(nxt);
            if constexpr (SP2) {
            PG8_LDB(B0, 0, 0); PG8_LDB(B1, 0, 1); PG8_SCHED; PG8_LDA(At, 0, 0); PG8_STAGE(PG8_SA(1, 1), a1 + hstepA, voffA);
            PG8_WAIT_V(8); PG8_WAIT_L(0); PG8_BAR; PG8_MMA(0, 0, At, B0); PG8_MMA(0, 1, At, B1); PG8_BAR; PG8_SCHED;
            PG8_LDA(At, 0, 1); PG8_STAGE(PG8_SB(0, 0), b2, voffB); PG8_STAGE(PG8_SB(0, 1), b2 + hstepB, voffB); PG8_STAGE(PG8_SA(0, 0), a2, voffA);
            PG8_WAIT_V(8); PG8_WAIT_L(0); PG8_BAR; PG8_MMA(1, 0, At, B0); PG8_MMA(1, 1, At, B1); PG8_BAR; PG8_SCHED;
            PG8_LDB(B0, 1, 0); PG8_LDB(B1, 1, 1); PG8_SCHED; PG8_LDA(At, 1, 0); PG8_STAGE(PG8_SA(0, 1), a2 + hstepA, voffA);
            PG8_WAIT_V(8); PG8_WAIT_L(0); PG8_BAR; PG8_MMA(0, 0, At, B0); PG8_MMA(0, 1, At, B1); PG8_BAR; PG8_SCHED;
            PG8_LDA(At, 1, 1); PG8_STAGE(PG8_SB(1, 0), b3, voffB); PG8_STAGE(PG8_SB(1, 1), b3 + hstepB, voffB); PG8_STAGE(PG8_SA(1, 0), a3, voffA);
            PG8_WAIT_V(8); PG8_WAIT_L(0); PG8_BAR; PG8_MMA(1, 0, At, B0); PG8_MMA(1, 1, At, B1); PG8_BAR; PG8_SCHED;
            } else {
            PG8_LDB(B0, 0, 0); PG8_SCHED; PG8_LDA(At, 0, 0); PG8_STAGE(PG8_SA(1, 1), a1 + hstepA, voffA);
            PG8_WAIT_L(8); PG8_BAR; PG8_WAIT_L(0); PG8_MMA(0, 0, At, B0); PG8_BAR; PG8_SCHED;
            PG8_LDB(B1, 0, 1); PG8_STAGE(PG8_SB(0, 0), b2, voffB);
            PG8_BAR; PG8_WAIT_L(0); PG8_MMA(0, 1, At, B1); PG8_BAR;
            PG8_LDA(At, 0, 1); PG8_STAGE(PG8_SA(0, 0), a2, voffA);
            PG8_BAR; PG8_WAIT_L(0); PG8_MMA(1, 0, At, B0); PG8_BAR; PG8_SCHED;
            PG8_STAGE(PG8_SB(0, 1), b2 + hstepB, voffB);
            PG8_WAIT_V(6); PG8_BAR; PG8_MMA(1, 1, At, B1); PG8_BAR;
            PG8_LDB(B0, 1, 0); PG8_SCHED; PG8_LDA(At, 1, 0); PG8_STAGE(PG8_SA(0, 1), a2 + hstepA, voffA);
            PG8_WAIT_L(8); PG8_BAR; PG8_WAIT_L(0); PG8_MMA(0, 0, At, B0); PG8_BAR; PG8_SCHED;
            PG8_LDB(B1, 1, 1); PG8_STAGE(PG8_SB(1, 0), b3, voffB);
            PG8_BAR; PG8_WAIT_L(0); PG8_MMA(0, 1, At, B1); PG8_BAR;
            PG8_LDA(At, 1, 1); PG8_STAGE(PG8_SA(1, 0), a3, voffA);
            PG8_BAR; PG8_WAIT_L(0); PG8_MMA(1, 0, At, B0); PG8_BAR; PG8_SCHED;
            PG8_STAGE(PG8_SB(1, 1), b3 + hstepB, voffB);
            PG8_WAIT_V(6); PG8_BAR; PG8_MMA(1, 1, At, B1); PG8_BAR;
            }
        }
        if constexpr (ALIGN_EPI) { if (wr == 0) PG8_BAR; }
        if constexpr (!Epi::AFTER_DRAIN) { E(acc, cur, wr, wc, fr, fq); S.done(cur); }
        if (!has_next) break;
#pragma unroll
        for (int a = 0; a < 2; ++a)
#pragma unroll
            for (int b = 0; b < 2; ++b)
#pragma unroll
                for (int m = 0; m < 4; ++m)
#pragma unroll
                    for (int n = 0; n < 2; ++n) acc[a][b][m][n] = (f32x4){0.f, 0.f, 0.f, 0.f};
        cur = nxt; cA = nA; cB = nB; ++ui;
        if constexpr (ALIGN_EPI) { if (wr == 1) PG8_BAR; }
    }
    PG8_WAIT_V(0);
    if constexpr (!ALIGN_EPI) { if (wr == 0) PG8_BAR; }
    PG8_BAR;
    if constexpr (Epi::AFTER_DRAIN) { E.fused(acc, cur, wr, wc, fr, fq, lds, wid, lane); S.done(cur); }
#undef PG8_SA
#undef PG8_SB
#undef PG8_STAGE
#undef PG8_LDA
#undef PG8_LDB
#undef PG8_MMA
#undef PG8_WAIT_V
#undef PG8_WAIT_L
#undef PG8_BAR
#undef PG8_SCHED
}
}

#ifndef PG8_SP2
#define PG8_SP2 true
#endif
#ifndef PG8_ALIGN
#define PG8_ALIGN true
#endif

using pg8::bf16_t; using pg8::bf16x8; using pg8::f32x4; using pg8::u32x4;
typedef float f32x16 __attribute__((ext_vector_type(16)));
typedef unsigned u32x2 __attribute__((ext_vector_type(2)));
#define LAS __attribute__((address_space(3)))

constexpr int M = 16384, S = 8192, D = 1024, NIN = 14352;
constexpr size_t PLANE = (size_t)M * D * 2;
constexpr float EPS = 1e-6f, LOG2E = 1.4426950408889634f;
constexpr size_t MiB = 1048576;
constexpr size_t OFF_WT1 = 12 * PLANE, OFF_WT1B = OFF_WT1 + 18 * MiB, OFF_WT2 = OFF_WT1B + 10 * MiB, OFF_WT3 = OFF_WT2 + 6 * MiB,
    OFF_HALO = OFF_WT3 + 2 * MiB, OFF_GATES = OFF_HALO + 3 * MiB, OFF_A2 = OFF_GATES + MiB, OFF_M2 = OFF_A2 + 262144, OFF_EM = OFF_M2 + 262144,
    OFF_WK = OFF_EM + 262144, OFF_F2 = OFF_WK + 262144, OFF_MP2 = OFF_F2 + 524288, OFF_NST = OFF_MP2 + 4096, OFF_END = OFF_NST + 65536;
constexpr size_t OFF_CST = OFF_WT1;
constexpr int LDS_BYTES = 143360;
constexpr int NPH = 21;
#ifndef ATTNMASK
#define ATTNMASK 3
#endif
#ifndef PHMASK
#define PHMASK 0x7ff
#endif

struct Args { const float* in[13]; float* out; unsigned char* ws; int ph_lo, ph_hi; };

__device__ __forceinline__ float bf2f(unsigned b) { return __uint_as_float(b << 16); }
__device__ __forceinline__ float bflo(unsigned w) { return __uint_as_float(w << 16); }
__device__ __forceinline__ float bfhi(unsigned w) { return __uint_as_float(w & 0xffff0000u); }
__device__ __forceinline__ unsigned pk2(float lo, float hi) { return pg8::cvt_pk_bf16(lo, hi); }
__device__ __forceinline__ float wave_sum(float v) {
#pragma unroll
    for (int o = 32; o; o >>= 1) v += __shfl_xor(v, o);
    return v; }
__device__ __forceinline__ float sigm(float x) { return 1.f / (1.f + __expf(-x)); }
__device__ __forceinline__ float silu(float x) { return x / (1.f + __expf(-x)); }
__device__ __forceinline__ float logsig(float x) { return fminf(x, 0.f) - log1pf(expf(-fabsf(x))); }
__device__ __forceinline__ int crow(int r, int hi) { return (r & 3) + 8 * (r >> 2) + 4 * hi; }

struct SchedStd {
    int nM, nN, nwg, G, c, lda, ldb;
    __device__ void init(int nM_, int nN_, int G_, int c_, int lda_, int ldb_) { nM = nM_; nN = nN_; nwg = nM * nN; G = G_; c = c_; lda = lda_; ldb = ldb_; }
    __device__ bool next(int i, pg8::Unit& u) const {
        const long L = (long)i * G + c; if (L >= nwg) return false;
        int wgid = (int)L; { const int q = nwg / 8, r = nwg % 8, xcd = wgid % 8, off = wgid / 8; wgid = (xcd < r ? xcd * (q + 1) : r * (q + 1) + (xcd - r) * q) + off; }
        const int nig = 8 * nN, gid = wgid / nig, fm = gid * 8, gsz = (nM - fm) < 8 ? (nM - fm) : 8;
        u.pm = fm + ((wgid % nig) % gsz); u.pn = (wgid % nig) / gsz; u.z = 0; return true;
    }
    __device__ __forceinline__ size_t a_off(const pg8::Unit& u) const { return (size_t)u.pm * 256 * lda * 2; }
    __device__ __forceinline__ size_t b_off(const pg8::Unit& u) const { return (size_t)u.pn * 256 * ldb * 2; }
    __device__ __forceinline__ void a_ready(const pg8::Unit&) const {}
    __device__ __forceinline__ void done(const pg8::Unit&) const {}
};
struct SchedG2 {
    int G, c;
    __device__ bool next(int i, pg8::Unit& u) const {
        const int t = (i / 3) * G + c; if (t >= 256) return false;
        u.pm = t >> 2; u.pn = t & 3; u.z = i % 3; return true;
    }
    __device__ __forceinline__ size_t a_off(const pg8::Unit& u) const { return (size_t)u.z * PLANE + (size_t)u.pm * 256 * 1024 * 2; }
    __device__ __forceinline__ size_t b_off(const pg8::Unit& u) const { return ((size_t)u.z * 1024 + (size_t)u.pn * 256) * 1024 * 2; }
    __device__ __forceinline__ void a_ready(const pg8::Unit&) const {}
    __device__ __forceinline__ void done(const pg8::Unit&) const {}
};
struct SchedA1 {
    int G, c;
    __device__ bool next(int i, pg8::Unit& u) const { const int L = i * G + c; if (L >= 128) return false; u.pm = 0; u.pn = 0; u.z = L; return true; }
    __device__ __forceinline__ size_t a_off(const pg8::Unit& u) const { const int bh = u.z >> 4, ch = u.z & 15; return ((size_t)((bh >> 2) * 1024 + (bh & 3) * 256) * 8192 + (size_t)ch * 512) * 2; }
    __device__ __forceinline__ size_t b_off(const pg8::Unit& u) const { return a_off(u); }
    __device__ __forceinline__ void a_ready(const pg8::Unit&) const {}
    __device__ __forceinline__ void done(const pg8::Unit&) const {}
};

struct EpiG1 {
    static constexpr bool PERM = true, AFTER_DRAIN = false;
    unsigned char* ws;
    __device__ __forceinline__ void operator()(const f32x4 (&acc)[2][2][4][2], const pg8::Unit& u, int wr, int wc, int fr, int fq) const {
        asm volatile("" : "+v"(fr), "+v"(fq));
        const int p9 = u.pn >> 2;
        const int dpl = (p9 < 2) ? p9 : p9 + 1;
        bf16_t* base = (bf16_t*)(ws + (size_t)dpl * PLANE);
        bf16_t* halo = (bf16_t*)(ws + OFF_HALO);
        const int cc0 = (u.pn & 3) * 256 + wc * 32 + 8 * fq;
        const int row0 = u.pm * 256 + wr * 64 + fr;
        const bool transposed = (p9 == 4 || p9 == 8), hal = (p9 == 2 || p9 == 3);
        const float sc = (p9 == 6) ? (0.08838834764831845f * LOG2E) : 1.f;
#pragma unroll
        for (int ai = 0; ai < 2; ++ai)
#pragma unroll
            for (int m = 0; m < 4; ++m) {
                const int r = row0 + ai * 128 + m * 16;
#pragma unroll
                for (int bj = 0; bj < 2; ++bj) {
                    const int c = cc0 + bj * 128;
                    const f32x4 v0 = acc[ai][bj][m][0] * sc, v1 = acc[ai][bj][m][1] * sc;
                    u32x4 w; w.x = pk2(v0[0], v0[1]); w.y = pk2(v0[2], v0[3]); w.z = pk2(v1[0], v1[1]); w.w = pk2(v1[2], v1[3]);
                    if (!transposed) {
                        *(u32x4*)(base + (size_t)r * 1024 + c) = w;
                        if (hal && m == 3 && fr >= 13) *(u32x4*)(halo + ((size_t)(r >> 6) * 3 + (fr - 13)) * 2048 + (p9 == 3 ? 1024 : 0) + c) = w;
                    } else {
                        const int b = r >> 13, t = r & 8191;
                        bf16_t* p = base + ((size_t)(b * 1024 + c)) * 8192 + t;
                        p[0] = (bf16_t)(w.x & 0xffff); p[8192] = (bf16_t)(w.x >> 16); p[2 * 8192] = (bf16_t)(w.y & 0xffff); p[3 * 8192] = (bf16_t)(w.y >> 16);
                        p[4 * 8192] = (bf16_t)(w.z & 0xffff); p[5 * 8192] = (bf16_t)(w.z >> 16); p[6 * 8192] = (bf16_t)(w.w & 0xffff); p[7 * 8192] = (bf16_t)(w.w >> 16);
                    }
                }
            }
    }
};
struct EpiPlain {
    static constexpr bool PERM = true, AFTER_DRAIN = false;
    bf16_t* base; int ldc; size_t zstride; int split;
    __device__ __forceinline__ void operator()(const f32x4 (&acc)[2][2][4][2], const pg8::Unit& u, int wr, int wc, int fr, int fq) const {
        asm volatile("" : "+v"(fr), "+v"(fq));
        bf16_t* bp = base + (size_t)u.z * zstride;
        int colt = u.pn * 256;
        if (split) { bp += (size_t)(u.pn >> 2) * (PLANE / 2); colt = (u.pn & 3) * 256; }
        const int cc0 = colt + wc * 32 + 8 * fq, row0 = u.pm * 256 + wr * 64 + fr;
#pragma unroll
        for (int ai = 0; ai < 2; ++ai)
#pragma unroll
            for (int m = 0; m < 4; ++m) {
                bf16_t* rowp = bp + (size_t)(row0 + ai * 128 + m * 16) * ldc + cc0;
#pragma unroll
                for (int bj = 0; bj < 2; ++bj) {
                    const f32x4 v0 = acc[ai][bj][m][0], v1 = acc[ai][bj][m][1];
                    u32x4 w; w.x = pk2(v0[0], v0[1]); w.y = pk2(v0[2], v0[3]); w.z = pk2(v1[0], v1[1]); w.w = pk2(v1[2], v1[3]);
                    *(u32x4*)(rowp + bj * 128) = w;
                }
            }
    }
};
struct EpiG2 {
    static constexpr bool PERM = true, AFTER_DRAIN = false;
    const bf16_t* gates; float* tmp; bf16_t* outp;
    __device__ __forceinline__ void operator()(const f32x4 (&acc)[2][2][4][2], const pg8::Unit& u, int wr, int wc, int fr, int fq) const {
        asm volatile("" : "+v"(fr), "+v"(fq));
        const bf16_t* gp = gates + (size_t)u.z * (PLANE / 2);
        const int cc0 = u.pn * 256 + wc * 32 + 8 * fq, row0 = u.pm * 256 + wr * 64 + fr;
#pragma unroll
        for (int ai = 0; ai < 2; ++ai)
#pragma unroll
            for (int m = 0; m < 4; ++m) {
                const size_t ro = (size_t)(row0 + ai * 128 + m * 16) * 1024 + cc0;
#pragma unroll
                for (int bj = 0; bj < 2; ++bj) {
                    const size_t o = ro + bj * 128;
                    const u32x4 g = *(const u32x4*)(gp + o);
                    f32x4 v0 = acc[ai][bj][m][0], v1 = acc[ai][bj][m][1];
                    v0[0] *= sigm(bflo(g.x)); v0[1] *= sigm(bfhi(g.x)); v0[2] *= sigm(bflo(g.y)); v0[3] *= sigm(bfhi(g.y));
                    v1[0] *= sigm(bflo(g.z)); v1[1] *= sigm(bfhi(g.z)); v1[2] *= sigm(bflo(g.w)); v1[3] *= sigm(bfhi(g.w));
                    if (u.z != 0) { v0 += *(const f32x4*)(tmp + o); v1 += *(const f32x4*)(tmp + o + 4); }
                    if (u.z != 2) { *(f32x4*)(tmp + o) = v0; *(f32x4*)(tmp + o + 4) = v1; }
                    else { u32x4 w; w.x = pk2(v0[0], v0[1]); w.y = pk2(v0[2], v0[3]); w.z = pk2(v1[0], v1[1]); w.w = pk2(v1[2], v1[3]); *(u32x4*)(outp + o) = w; }
                }
            }
    }
};
struct EpiG3 {
    static constexpr bool PERM = true, AFTER_DRAIN = false;
    const float* xin; float* out;
    __device__ __forceinline__ void operator()(const f32x4 (&acc)[2][2][4][2], const pg8::Unit& u, int wr, int wc, int fr, int fq) const {
        asm volatile("" : "+v"(fr), "+v"(fq));
        const int cc0 = u.pn * 256 + wc * 32 + 8 * fq, row0 = u.pm * 256 + wr * 64 + fr;
#pragma unroll
        for (int ai = 0; ai < 2; ++ai)
#pragma unroll
            for (int m = 0; m < 4; ++m) {
                const size_t ro = (size_t)(row0 + ai * 128 + m * 16) * 1024 + cc0;
#pragma unroll
                for (int bj = 0; bj < 2; ++bj) {
                    const size_t o = ro + bj * 128;
                    const f32x4 x0 = *(const f32x4*)(xin + o), x1 = *(const f32x4*)(xin + o + 4);
                    *(f32x4*)(out + o) = x0 + acc[ai][bj][m][0]; *(f32x4*)(out + o + 4) = x1 + acc[ai][bj][m][1];
                }
            }
    }
};

__device__ __forceinline__ int g1_srccol(int p) {
    switch (p) { case 0: return 4096; case 1: return 8200; case 2: return 0; case 3: return 1024; case 4: return 2048; case 5: return 3072; case 6: return 5128; case 7: return 6152; default: return 7176; } }

__device__ __forceinline__ void transpose_tile(const float* __restrict__ src, int pitch, bf16_t* __restrict__ dst, LAS float* scr, int tid) {
#pragma unroll
    for (int i = 0; i < 2; ++i) { const int r = (tid >> 4) + 32 * i, c4 = tid & 15; const f32x4 v = *(const f32x4*)(src + (size_t)r * pitch + c4 * 4);
        scr[r * 65 + c4 * 4 + 0] = v[0]; scr[r * 65 + c4 * 4 + 1] = v[1]; scr[r * 65 + c4 * 4 + 2] = v[2]; scr[r * 65 + c4 * 4 + 3] = v[3]; }
    __syncthreads();
    { const int n = tid >> 3, kc = tid & 7; float v[8];
#pragma unroll
      for (int j = 0; j < 8; ++j) v[j] = scr[(kc * 8 + j) * 65 + n];
      u32x4 w; w.x = pk2(v[0], v[1]); w.y = pk2(v[2], v[3]); w.z = pk2(v[4], v[5]); w.w = pk2(v[6], v[7]);
      *(u32x4*)(dst + (size_t)n * 1024 + kc * 8) = w; }
    __syncthreads();
}

__device__ __forceinline__ void phase_prep(const Args& a, int l, LAS unsigned char* lds, int tid) {
    unsigned char* ws = a.ws;
    const float* w_in = a.in[2] + (size_t)l * D * NIN;
    const float* w_br = a.in[10] + (size_t)l * 3 * D * D;
    const float* w_out = a.in[11] + (size_t)l * D * D;
    const float* pool_w = a.in[8] + (size_t)l * 4 * 256 * 256;
    const float* pool_s = a.in[9] + (size_t)l * D;
    LAS float* scr = (LAS float*)lds;
    for (int it = blockIdx.x; it < 17 * 256; it += gridDim.x) {
        const int id = it >> 8, nt = (it & 255) >> 4, kt = it & 15;
        const float* src; int pitch; bf16_t* dst;
        if (id < 9)       { src = w_in + (size_t)(kt * 64) * NIN + g1_srccol(id) + nt * 64; pitch = NIN; dst = (bf16_t*)(ws + OFF_WT1) + (size_t)(id * 1024 + nt * 64) * 1024 + kt * 64; }
        else if (id < 13) { const int q = id - 9; const int prow = (q == 0) ? 0 : q + 1; const int col = (q == 0) ? 10256 : 11280 + (q - 1) * 1024;
                            src = w_in + (size_t)(kt * 64) * NIN + col + nt * 64; pitch = NIN; dst = (bf16_t*)(ws + OFF_WT1B) + (size_t)(prow * 1024 + nt * 64) * 1024 + kt * 64; }
        else if (id < 16) { const int n = id - 13; src = w_br + (size_t)n * D * D + (size_t)(kt * 64) * D + nt * 64; pitch = D; dst = (bf16_t*)(ws + OFF_WT2) + (size_t)(n * 1024 + nt * 64) * 1024 + kt * 64; }
        else              { src = w_out + (size_t)(kt * 64) * D + nt * 64; pitch = D; dst = (bf16_t*)(ws + OFF_WT3) + (size_t)(nt * 64) * 1024 + kt * 64; }
        transpose_tile(src, pitch, dst, scr, tid);
    }
    for (int it = blockIdx.x; it < 256; it += gridDim.x) {
        const int g = it >> 6, kt = (it & 63) >> 2, dt = it & 3;
        LAS float* As = scr; LAS float* Bs = scr + 64 * 65;
        float acc[8];
#pragma unroll
        for (int j = 0; j < 8; ++j) acc[j] = 0.f;
        for (int cc = 0; cc < 4; ++cc) {
#pragma unroll
            for (int i = 0; i < 2; ++i) { const int r = (tid >> 4) + 32 * i, c4 = tid & 15;
                const f32x4 va = *(const f32x4*)(w_in + (size_t)(kt * 64 + r) * NIN + 9232 + g * 256 + cc * 64 + c4 * 4);
                As[r * 65 + c4 * 4 + 0] = va[0]; As[r * 65 + c4 * 4 + 1] = va[1]; As[r * 65 + c4 * 4 + 2] = va[2]; As[r * 65 + c4 * 4 + 3] = va[3];
                const f32x4 vb = *(const f32x4*)(pool_w + (size_t)(g * 256 + cc * 64 + r) * 256 + dt * 64 + c4 * 4);
                Bs[r * 64 + c4 * 4 + 0] = vb[0]; Bs[r * 64 + c4 * 4 + 1] = vb[1]; Bs[r * 64 + c4 * 4 + 2] = vb[2]; Bs[r * 64 + c4 * 4 + 3] = vb[3]; }
            __syncthreads();
            const int d = tid & 63, kg = tid >> 6;
            for (int c = 0; c < 64; ++c) { const float bv = Bs[c * 64 + d];
#pragma unroll
                for (int j = 0; j < 8; ++j) acc[j] += As[(kg * 8 + j) * 65 + c] * bv; }
            __syncthreads();
        }
        const int d = tid & 63, kg = tid >> 6;
        const float sc = pool_s[g * 256 + dt * 64 + d];
        u32x4 w; w.x = pk2(acc[0] * sc, acc[1] * sc); w.y = pk2(acc[2] * sc, acc[3] * sc); w.z = pk2(acc[4] * sc, acc[5] * sc); w.w = pk2(acc[6] * sc, acc[7] * sc);
        *(u32x4*)((bf16_t*)(ws + OFF_WT1B) + (size_t)(1024 + g * 256 + dt * 64 + d) * 1024 + kt * 64 + kg * 8) = w;
    }
    LAS float* gw = (LAS float*)lds;
    __syncthreads();
    for (int e = tid; e < 16 * 1024; e += 512) { const int c = e & 15, k = e >> 4; const int col = (c < 8) ? 5120 + c : 9224 + (c - 8); gw[c * 1024 + k] = w_in[(size_t)k * NIN + col]; }
    __syncthreads();
    {
        const float* xin = (l == 0) ? a.in[0] : a.out;
        const float* ng = a.in[1] + (size_t)l * D;
        bf16_t* hb = (bf16_t*)(ws + 10 * PLANE);
        float* gates = (float*)(ws + OFF_GATES);
        const int wid = tid >> 6, lane = tid & 63;
        f32x4 gg[4];
#pragma unroll
        for (int j = 0; j < 4; ++j) gg[j] = *(const f32x4*)(ng + j * 256 + lane * 4);
        for (int row = blockIdx.x * 8 + wid; row < M; row += gridDim.x * 8) {
            f32x4 xv[4]; float ss = 0.f;
#pragma unroll
            for (int j = 0; j < 4; ++j) { xv[j] = *(const f32x4*)(xin + (size_t)row * D + j * 256 + lane * 4); ss += xv[j][0] * xv[j][0] + xv[j][1] * xv[j][1] + xv[j][2] * xv[j][2] + xv[j][3] * xv[j][3]; }
            ss = wave_sum(ss);
            const float r = rsqrtf(ss * (1.f / 1024.f) + EPS);
#pragma unroll
            for (int j = 0; j < 4; ++j) { xv[j] = (xv[j] * r) * gg[j]; u32x2 w; w.x = pk2(xv[j][0], xv[j][1]); w.y = pk2(xv[j][2], xv[j][3]); *(u32x2*)(hb + (size_t)row * D + j * 256 + lane * 4) = w; }
            float ga[16];
#pragma unroll
            for (int c = 0; c < 16; ++c) { float s = 0.f;
#pragma unroll
                for (int j = 0; j < 4; ++j) { const f32x4 wv = *(const LAS f32x4*)(gw + c * 1024 + j * 256 + lane * 4); s += xv[j][0] * wv[0] + xv[j][1] * wv[1] + xv[j][2] * wv[2] + xv[j][3] * wv[3]; }
                ga[c] = wave_sum(s); }
            float outv = ga[0];
#pragma unroll
            for (int c = 1; c < 16; ++c) outv = (lane == c) ? ga[c] : outv;
            if (lane < 16) gates[(size_t)row * 16 + lane] = outv;
        }
    }
    __syncthreads();
}

__device__ __forceinline__ float block_excl_scan_add(float tot, LAS float* sm, int tid) {
    const int lane = tid & 63, wid = tid >> 6; float x = tot;
#pragma unroll
    for (int o = 1; o < 64; o <<= 1) { const float v = __shfl_up(x, o); if (lane >= o) x += v; }
    __syncthreads();
    if (lane == 63) sm[wid] = x;
    __syncthreads();
    float base = 0.f;
    for (int w = 0; w < wid; ++w) base += sm[w];
    return base + x - tot;
}
__device__ __forceinline__ float block_excl_scan_max(float tot, LAS float* sm, int tid) {
    const int lane = tid & 63, wid = tid >> 6; float x = tot;
#pragma unroll
    for (int o = 1; o < 64; o <<= 1) { const float v = __shfl_up(x, o); if (lane >= o) x = fmaxf(x, v); }
    __syncthreads();
    if (lane == 63) sm[wid] = x;
    __syncthreads();
    float base = -INFINITY;
    for (int w = 0; w < wid; ++w) base = fmaxf(base, sm[w]);
    const float prev = __shfl_up(x, 1);
    return fmaxf(base, lane ? prev : -INFINITY);
}
__device__ __forceinline__ void phase_scans(const Args& a, int l, LAS unsigned char* lds, int tid) {
    unsigned char* ws = a.ws; const float* gates = (const float*)(ws + OFF_GATES);
    LAS float* sm = (LAS float*)lds;
    LAS float* Fs = sm + 64; LAS float* As = Fs + 8192; LAS float* Ms = As + 8192;
    const int bx = blockIdx.x;
    if (bx < 8) {
        const int b = bx >> 2, h = bx & 3; const float bi = a.in[4][l * 4 + h], bfv = a.in[5][l * 4 + h];
        float run = 0.f;
#pragma unroll 2
        for (int i = 0; i < 16; ++i) { const size_t row = (size_t)b * S + tid * 16 + i; run += logsig(gates[row * 16 + 4 + h] + bfv); Fs[tid * 16 + i] = run; }
        const float pre = block_excl_scan_add(run, sm, tid);
        float mx = -INFINITY;
#pragma unroll 2
        for (int i = 0; i < 16; ++i) { const size_t row = (size_t)b * S + tid * 16 + i; const float F = Fs[tid * 16 + i] + pre; const float av = gates[row * 16 + h] + bi - F;
            Fs[tid * 16 + i] = F; As[tid * 16 + i] = av; mx = fmaxf(mx, av); }
        const float pm = block_excl_scan_max(mx, sm + 16, tid);
        float Mrun = fmaxf(pm, 0.f);
#pragma unroll 2
        for (int i = 0; i < 16; ++i) { Mrun = fmaxf(Mrun, As[tid * 16 + i]); Ms[tid * 16 + i] = Mrun; }
        __syncthreads();
        if ((tid & 31) == 31) sm[32 + (tid >> 5)] = Mrun;
        __syncthreads();
        const float Mend = sm[32 + (tid >> 5)];
        float* A2 = (float*)(ws + OFF_A2) + (size_t)bx * S + tid * 16; float* M2 = (float*)(ws + OFF_M2) + (size_t)bx * S + tid * 16;
        float* EM = (float*)(ws + OFF_EM) + (size_t)bx * S + tid * 16; float* WK = (float*)(ws + OFF_WK) + (size_t)bx * S + tid * 16;
#pragma unroll 2
        for (int i = 0; i < 16; ++i) { const float av = As[tid * 16 + i], Mv = Ms[tid * 16 + i], F = Fs[tid * 16 + i];
            A2[i] = av * LOG2E; M2[i] = Mv * LOG2E; EM[i] = expf(-(F + Mv)); WK[i] = expf(av - Mend); }
        float* MP = (float*)(ws + OFF_MP2) + bx * 32;
        if (tid == 0) MP[0] = 0.f;
        if (tid < 16) MP[tid + 1] = sm[32 + tid] * LOG2E;
        __syncthreads();
    } else if (bx < 24) {
        const int bh = bx - 8, b = bh >> 3, h = bh & 7; const float bfv = a.in[7][l * 8 + h];
        float run = 0.f;
#pragma unroll 2
        for (int i = 0; i < 16; ++i) { const size_t row = (size_t)b * S + tid * 16 + i; run += logsig(gates[row * 16 + 8 + h] + bfv); Fs[tid * 16 + i] = run; }
        const float pre = block_excl_scan_add(run, sm, tid);
        float* F2 = (float*)(ws + OFF_F2) + (size_t)bh * S + tid * 16;
#pragma unroll 2
        for (int i = 0; i < 16; ++i) F2[i] = (Fs[tid * 16 + i] + pre) * LOG2E;
        __syncthreads();
    }
}

__device__ __forceinline__ void phase_conv(const Args& a, int l, LAS unsigned char* lds, int tid) {
    unsigned char* ws = a.ws;
    const float* cw = a.in[3] + (size_t)l * 4 * 2048;
    const bf16_t* halo = (const bf16_t*)(ws + OFF_HALO);
    const float* WK = (const float*)(ws + OFF_WK);
    LAS float* raw = (LAS float*)lds;
    LAS float* tb = raw + 67 * 65 + 3;
    for (int it = blockIdx.x; it < 256 * 32; it += gridDim.x) {
        const int tt = it >> 5, cs = it & 31;
        const bool isk = cs >= 16;
        bf16_t* pl = (bf16_t*)(ws + (size_t)(isk ? 4 : 3) * PLANE);
        const int c0 = (cs & 15) * 64;
        const int r = tid >> 3, c8 = (tid & 7) * 8;
        { const u32x4 v = *(const u32x4*)(pl + (size_t)(tt * 64 + r) * 1024 + c0 + c8); LAS float* d = raw + (r + 3) * 65 + c8;
          d[0] = bflo(v.x); d[1] = bfhi(v.x); d[2] = bflo(v.y); d[3] = bfhi(v.y); d[4] = bflo(v.z); d[5] = bfhi(v.z); d[6] = bflo(v.w); d[7] = bfhi(v.w); }
        if (tid < 24) { const int hr = tid >> 3; LAS float* d = raw + hr * 65 + c8;
            if ((tt & 127) == 0) { for (int j = 0; j < 8; ++j) d[j] = 0.f; }
            else { const u32x4 v = *(const u32x4*)(halo + ((size_t)(tt - 1) * 3 + hr) * 2048 + cs * 64 + c8);
                d[0] = bflo(v.x); d[1] = bfhi(v.x); d[2] = bflo(v.y); d[3] = bfhi(v.y); d[4] = bflo(v.z); d[5] = bfhi(v.z); d[6] = bflo(v.w); d[7] = bfhi(v.w); } }
        __syncthreads();
        float o[8];
        { const int gc = cs * 64 + c8;
#pragma unroll
          for (int j = 0; j < 8; ++j) { float s = 0.f;
#pragma unroll
              for (int kk = 0; kk < 4; ++kk) s += cw[kk * 2048 + gc + j] * raw[(r + kk) * 65 + c8 + j];
              o[j] = silu(s); } }
        if (!isk) {
#pragma unroll
            for (int j = 0; j < 8; ++j) o[j] *= 0.0625f;
        }
        { u32x4 w; w.x = pk2(o[0], o[1]); w.y = pk2(o[2], o[3]); w.z = pk2(o[4], o[5]); w.w = pk2(o[6], o[7]);
          *(u32x4*)(pl + (size_t)(tt * 64 + r) * 1024 + c0 + c8) = w; }
        if (isk) {
            const int b = tt >> 7, t0 = (tt & 127) * 64, hh = c0 >> 8;
            const float wk = WK[(size_t)(b * 4 + hh) * S + t0 + r];
#pragma unroll
            for (int j = 0; j < 8; ++j) tb[(c8 + j) * 65 + r] = o[j] * wk;
            __syncthreads();
            const int c = tid >> 3, t8 = (tid & 7) * 8;
            float v[8];
#pragma unroll
            for (int j = 0; j < 8; ++j) v[j] = tb[c * 65 + t8 + j];
            u32x4 w; w.x = pk2(v[0], v[1]); w.y = pk2(v[2], v[3]); w.z = pk2(v[4], v[5]); w.w = pk2(v[6], v[7]);
            *(u32x4*)((bf16_t*)(ws + 11 * PLANE) + (size_t)(b * 1024 + c0 + c) * 8192 + t0 + t8) = w;
        }
        __syncthreads();
    }
}

__device__ __forceinline__ void phase_statescan(const Args& a, int tid) {
    unsigned char* ws = a.ws;
    const float* MP = (const float*)(ws + OFF_MP2);
    bf16_t* Cst = (bf16_t*)(ws + OFF_CST);
    for (int grp = blockIdx.x * 512 + tid; grp < 8 * 16384; grp += gridDim.x * 512) {
        const int bh = grp >> 14, e = (grp & 16383) * 4;
        float C0 = 0.f, C1 = 0.f, C2 = 0.f, C3 = 0.f;
        for (int c = 0; c < 16; ++c) {
            u32x2* p = (u32x2*)(Cst + ((size_t)(bh * 16 + c) * 65536 + e));
            const u32x2 d = *p; u32x2 w; w.x = pk2(C0, C1); w.y = pk2(C2, C3); *p = w;
            const float dec = exp2f(MP[bh * 32 + c] - MP[bh * 32 + c + 1]);
            C0 = dec * C0 + bflo(d.x); C1 = dec * C1 + bfhi(d.x); C2 = dec * C2 + bflo(d.y); C3 = dec * C3 + bfhi(d.y);
        }
    }
    const int wid = tid >> 6, lane = tid & 63;
    bf16_t* nst = (bf16_t*)(ws + OFF_NST);
    for (int gwv = blockIdx.x * 8 + wid; gwv < 2048; gwv += gridDim.x * 8) {
        const int bh = gwv >> 8, k = gwv & 255;
        const bf16_t* row = (const bf16_t*)(ws + 11 * PLANE) + (size_t)((bh >> 2) * 1024 + (bh & 3) * 256 + k) * 8192;
        float n = 0.f;
        for (int c = 0; c < 16; ++c) {
            const u32x4 v = *(const u32x4*)(row + c * 512 + lane * 8);
            float s = bflo(v.x) + bfhi(v.x) + bflo(v.y) + bfhi(v.y) + bflo(v.z) + bfhi(v.z) + bflo(v.w) + bfhi(v.w);
            s = wave_sum(s);
            if (lane == 0) nst[(size_t)(bh * 16 + c) * 256 + k] = (bf16_t)(pk2(n, n) & 0xffff);
            const float dec = exp2f(MP[bh * 32 + c] - MP[bh * 32 + c + 1]);
            n = dec * n + s;
        }
    }
}

#define MFMA32(a, b, c) __builtin_amdgcn_mfma_f32_32x32x16_bf16(a, b, c, 0, 0, 0)
template <int MODE>
__device__ __forceinline__ void attn_unit(const Args& a, int l, int b, int h, int qb, LAS unsigned char* lds, int tid) {
    constexpr int DH = MODE ? 256 : 128, KS = DH / 16, QROWS = MODE ? 128 : 256, VROWS = DH, KP = DH * 2 + 16, VP = 136;
    constexpr int KCH = 64 * DH / 8 / 512, VCH = VROWS * 8 / 512;
    unsigned char* ws = a.ws;
    const int wid = __builtin_amdgcn_readfirstlane(tid >> 6), lane = tid & 63, l32 = lane & 31, hi = lane >> 5;
    const int rg = MODE ? (wid & 3) : wid, vh = MODE ? (wid >> 2) : 0;
    const int q0 = qb * QROWS + rg * 32, tq = q0 + l32;
    const bf16_t* Qp = (const bf16_t*)(ws + (size_t)(MODE ? 3 : 7) * PLANE);
    const bf16_t* Kp = (const bf16_t*)(ws + (size_t)(MODE ? 4 : 8) * PLANE);
    const bf16_t* VTp = (const bf16_t*)(ws + (size_t)(MODE ? 5 : 9) * PLANE);
    const int bh = MODE ? (b * 4 + h) : (b * 8 + h);
    const float* biasG = MODE ? ((const float*)(ws + OFF_A2) + (size_t)bh * S) : ((const float*)(ws + OFF_F2) + (size_t)bh * S);
    LAS unsigned char* Ks = lds; LAS unsigned char* Vs = lds + 64 * KP; LAS float* biasK = (LAS float*)(lds + 64 * KP + VROWS * VP); LAS float* red = biasK + 64;

    bf16x8 qf[MODE ? 1 : KS];
    LAS unsigned char* Qs = lds + 64 * KP + VROWS * VP + 256 + 1024;
    if (MODE) {
        __syncthreads();
#pragma unroll
        for (int i = 0; i < 8; ++i) { const int q = tid + i * 512, r = q >> 5, cc = q & 31;
            *(LAS u32x4*)(Qs + r * KP + cc * 16) = *(const u32x4*)(Qp + (size_t)(b * S + qb * QROWS + r) * 1024 + h * DH + cc * 8); }
        __syncthreads();
    } else {
#pragma unroll
        for (int ks = 0; ks < KS; ++ks) qf[ks] = *(const bf16x8*)(Qp + (size_t)(b * S + tq) * 1024 + h * DH + ks * 16 + hi * 8);
    }
#define QF(ks) (MODE ? *(const LAS bf16x8*)(Qs + (rg * 32 + l32) * KP + ((ks) * 16 + hi * 8) * 2) : qf[MODE ? 0 : (ks)])
    f32x16 O[4];
#pragma unroll
    for (int vb = 0; vb < 4; ++vb)
#pragma unroll
        for (int i = 0; i < 16; ++i) O[vb][i] = 0.f;
    float rowb = biasG[tq];
    float m_run = -INFINITY, l_run = 0.f, den_inter = 0.f, M2t = 0.f;
    int j0 = 0, j1 = qb * 4 + 3;
    if (MODE) {
        const int ch = qb >> 2; j0 = ch * 8; j1 = qb * 2 + 1;
        M2t = ((const float*)(ws + OFF_M2))[(size_t)bh * S + tq];
        const bf16_t* Cb = (const bf16_t*)(ws + OFF_CST) + (size_t)(bh * 16 + ch) * 65536;
#pragma unroll
        for (int vb = 0; vb < 4; ++vb)
#pragma unroll
            for (int ks = 0; ks < KS; ++ks) { const bf16x8 af = *(const bf16x8*)(Cb + (size_t)(vh * 128 + vb * 32 + l32) * 256 + ks * 16 + hi * 8); O[vb] = MFMA32(af, QF(ks), O[vb]); }
        f32x16 nacc;
#pragma unroll
        for (int i = 0; i < 16; ++i) nacc[i] = 0.f;
        const bf16_t* nb = (const bf16_t*)(ws + OFF_NST) + (size_t)(bh * 16 + ch) * 256;
#pragma unroll
        for (int ks = 0; ks < KS; ++ks) { bf16x8 af = *(const bf16x8*)(nb + ks * 16 + hi * 8); if (l32 != 0) af = (bf16x8){0, 0, 0, 0, 0, 0, 0, 0}; nacc = MFMA32(af, QF(ks), nacc); }
        const float nq = __shfl(nacc[0], l32);
        const float winter = exp2f(((const float*)(ws + OFF_MP2))[bh * 32 + ch] - M2t);
#pragma unroll
        for (int vb = 0; vb < 4; ++vb)
#pragma unroll
            for (int i = 0; i < 16; ++i) O[vb][i] *= winter;
        den_inter = winter * nq;
    }
    u32x4 kreg[KCH], vreg[VCH]; float breg = 0.f;
    auto gload = [&](int j) {
#pragma unroll
        for (int i = 0; i < KCH; ++i) { const int q = tid + i * 512, r = q / (DH / 8), cc = q % (DH / 8); kreg[i] = *(const u32x4*)(Kp + (size_t)(b * S + j * 64 + r) * 1024 + h * DH + cc * 8); }
#pragma unroll
        for (int i = 0; i < VCH; ++i) { const int q = tid + i * 512, r = q >> 3, cc = q & 7; vreg[i] = *(const u32x4*)(VTp + (size_t)(b * 1024 + h * DH + r) * 8192 + j * 64 + cc * 8); }
        if (tid < 64) breg = biasG[j * 64 + tid];
    };
    if (!MODE) gload(j0);
    for (int j = j0; j <= j1; ++j) {
        __syncthreads();
        if (MODE) gload(j);
#pragma unroll
        for (int i = 0; i < KCH; ++i) { const int q = tid + i * 512, r = q / (DH / 8), cc = q % (DH / 8); *(LAS u32x4*)(Ks + r * KP + cc * 16) = kreg[i]; }
#pragma unroll
        for (int i = 0; i < VCH; ++i) { const int q = tid + i * 512, r = q >> 3, cc = q & 7; *(LAS u32x2*)(Vs + r * VP + cc * 16) = (u32x2){vreg[i].x, vreg[i].y}; *(LAS u32x2*)(Vs + r * VP + cc * 16 + 8) = (u32x2){vreg[i].z, vreg[i].w}; }
        if (tid < 64) biasK[tid] = breg;
        __syncthreads();
        if (!MODE && j < j1) gload(j + 1);
        if (j * 64 <= q0 + 31) {
            bf16x8 pb[2][2];
            const bool diag = (j * 64 + 63 > q0);
            if (MODE) {
                float ls = 0.f;
#pragma unroll
                for (int kb = 0; kb < 2; ++kb) {
                    f32x16 s1;
#pragma unroll
                    for (int i = 0; i < 16; ++i) s1[i] = 0.f;
#pragma unroll
                    for (int ks = 0; ks < KS; ++ks) { const bf16x8 af = *(const LAS bf16x8*)(Ks + (kb * 32 + l32) * KP + (ks * 16 + hi * 8) * 2); s1 = MFMA32(af, QF(ks), s1); }
#pragma unroll
                    for (int i4 = 0; i4 < 4; ++i4) { const f32x4 bk = *(const LAS f32x4*)(biasK + kb * 32 + 8 * i4 + 4 * hi);
#pragma unroll
                        for (int r = 0; r < 4; ++r) { const int i = i4 * 4 + r; const int key = j * 64 + kb * 32 + 8 * i4 + 4 * hi + r;
                            float w = exp2f(bk[r] - M2t); if (diag && key > tq) w = 0.f;
                            const float p = s1[i] * w; s1[i] = p; ls += p; } }
#pragma unroll
                    for (int jj = 0; jj < 2; ++jj) {
                        u32x4 w; w.x = pk2(s1[8 * jj + 0], s1[8 * jj + 1]); w.y = pk2(s1[8 * jj + 2], s1[8 * jj + 3]);
                        w.z = pk2(s1[8 * jj + 4], s1[8 * jj + 5]); w.w = pk2(s1[8 * jj + 6], s1[8 * jj + 7]);
                        pb[kb][jj] = __builtin_bit_cast(bf16x8, w);
                    }
                }
                l_run += ls;
            } else {
            f32x16 s[2];
#pragma unroll
            for (int kb = 0; kb < 2; ++kb) {
#pragma unroll
                for (int i4 = 0; i4 < 4; ++i4) { const f32x4 bk = *(const LAS f32x4*)(biasK + kb * 32 + 8 * i4 + 4 * hi);
#pragma unroll
                    for (int r = 0; r < 4; ++r) s[kb][i4 * 4 + r] = rowb - bk[r]; }
#pragma unroll
                for (int ks = 0; ks < KS; ++ks) { const bf16x8 af = *(const LAS bf16x8*)(Ks + (kb * 32 + l32) * KP + (ks * 16 + hi * 8) * 2); s[kb] = MFMA32(af, QF(ks), s[kb]); }
            }
            {
                if (diag) {
#pragma unroll
                    for (int kb = 0; kb < 2; ++kb)
#pragma unroll
                        for (int i = 0; i < 16; ++i) { const int key = j * 64 + kb * 32 + crow(i, hi); if (key > tq) s[kb][i] = -INFINITY; }
                }
                float mx = -INFINITY;
#pragma unroll
                for (int kb = 0; kb < 2; ++kb)
#pragma unroll
                    for (int i = 0; i < 16; ++i) mx = fmaxf(mx, s[kb][i]);
                mx = fmaxf(mx, __shfl_xor(mx, 32));
                const float m_new = fmaxf(m_run, mx);
                const float alpha = exp2f(m_run - m_new);
                float ls = 0.f;
#pragma unroll
                for (int kb = 0; kb < 2; ++kb)
#pragma unroll
                    for (int i = 0; i < 16; ++i) { const float p = exp2f(s[kb][i] - m_new); s[kb][i] = p; ls += p; }
                l_run = l_run * alpha + ls; m_run = m_new;
#pragma unroll
                for (int vb = 0; vb < 4; ++vb)
#pragma unroll
                    for (int i = 0; i < 16; ++i) O[vb][i] *= alpha;
            }
#pragma unroll
            for (int kb = 0; kb < 2; ++kb)
#pragma unroll
                for (int jj = 0; jj < 2; ++jj) {
                    u32x4 w; w.x = pk2(s[kb][8 * jj + 0], s[kb][8 * jj + 1]); w.y = pk2(s[kb][8 * jj + 2], s[kb][8 * jj + 3]);
                    w.z = pk2(s[kb][8 * jj + 4], s[kb][8 * jj + 5]); w.w = pk2(s[kb][8 * jj + 6], s[kb][8 * jj + 7]);
                    pb[kb][jj] = __builtin_bit_cast(bf16x8, w);
                }
            }
#pragma unroll
            for (int vb = 0; vb < 4; ++vb)
#pragma unroll
                for (int kb = 0; kb < 2; ++kb)
#pragma unroll
                    for (int jj = 0; jj < 2; ++jj) {
                        const LAS unsigned char* vp = Vs + (vh * 128 + vb * 32 + l32) * VP + (kb * 32 + 16 * jj + 4 * hi) * 2;
                        const u32x2 lo = *(const LAS u32x2*)vp, hi2 = *(const LAS u32x2*)(vp + 16);
                        const u32x4 w = (u32x4){lo.x, lo.y, hi2.x, hi2.y};
                        O[vb] = MFMA32(__builtin_bit_cast(bf16x8, w), pb[kb][jj], O[vb]);
                    }
        }
    }
    const size_t rowoff = (size_t)(b * S + tq) * 1024;
    if (!MODE) {
        const float lt = l_run + __shfl_xor(l_run, 32);
        const float inv = 1.f / lt;
        bf16_t* bz = (bf16_t*)(ws + 1 * PLANE) + rowoff + h * 128;
#pragma unroll
        for (int vb = 0; vb < 4; ++vb)
#pragma unroll
            for (int i4 = 0; i4 < 4; ++i4) {
                bf16_t* p = bz + vb * 32 + 8 * i4 + 4 * hi;
                const u32x2 z = *(const u32x2*)p;
                u32x2 w; w.x = pk2(O[vb][i4 * 4 + 0] * inv * silu(bflo(z.x)), O[vb][i4 * 4 + 1] * inv * silu(bfhi(z.x)));
                w.y = pk2(O[vb][i4 * 4 + 2] * inv * silu(bflo(z.y)), O[vb][i4 * 4 + 3] * inv * silu(bfhi(z.y)));
                *(u32x2*)p = w;
            }
    } else {
        const float den = l_run + __shfl_xor(l_run, 32) + den_inter;
        const float em = ((const float*)(ws + OFF_EM))[(size_t)bh * S + tq];
        const float invd = 1.f / fmaxf(fabsf(den), em);
        float ssq = 0.f;
#pragma unroll
        for (int vb = 0; vb < 4; ++vb)
#pragma unroll
            for (int i = 0; i < 16; ++i) { O[vb][i] *= invd; ssq += O[vb][i] * O[vb][i]; }
        ssq += __shfl_xor(ssq, 32);
        if (hi == 0) red[(vh * 4 + rg) * 32 + l32] = ssq;
        __syncthreads();
        const float tot = red[rg * 32 + l32] + red[(4 + rg) * 32 + l32];
        const float rs = rsqrtf(tot * (1.f / 256.f) + EPS);
        const float* ng = a.in[6] + (size_t)l * D + h * 256 + vh * 128;
        bf16_t* az = (bf16_t*)(ws) + rowoff + h * 256 + vh * 128;
        const bf16_t* ao = (const bf16_t*)(ws + 6 * PLANE) + rowoff + h * 256 + vh * 128;
#pragma unroll
        for (int vb = 0; vb < 4; ++vb)
#pragma unroll
            for (int i4 = 0; i4 < 4; ++i4) {
                const int v = vb * 32 + 8 * i4 + 4 * hi;
                const u32x2 z = *(const u32x2*)(az + v), o = *(const u32x2*)(ao + v);
                const f32x4 g = *(const f32x4*)(ng + v);
                u32x2 w;
                w.x = pk2(O[vb][i4 * 4 + 0] * rs * g[0] * sigm(bflo(o.x)) * silu(bflo(z.x)), O[vb][i4 * 4 + 1] * rs * g[1] * sigm(bfhi(o.x)) * silu(bfhi(z.x)));
                w.y = pk2(O[vb][i4 * 4 + 2] * rs * g[2] * sigm(bflo(o.y)) * silu(bflo(z.y)), O[vb][i4 * 4 + 3] * rs * g[3] * sigm(bfhi(o.y)) * silu(bfhi(z.y)));
                *(u32x2*)(az + v) = w;
            }
    }
}

__device__ __forceinline__ void phase_attn(const Args& a, int l, LAS unsigned char* lds, int tid) {
    if (ATTNMASK & 1) {
        for (int w = blockIdx.x; w < 256; w += gridDim.x) {
            const int bhF = w >> 4, p = w & 15;
            attn_unit<0>(a, l, bhF >> 3, bhF & 7, 31 - p, lds, tid);
            attn_unit<0>(a, l, bhF >> 3, bhF & 7, p, lds, tid);
        }
    }
    __syncthreads();
    if (ATTNMASK & 2) {
        int t2 = tid; asm volatile("" : "+v"(t2));
        for (int w = blockIdx.x; w < 256; w += gridDim.x) {
            const int bh = w >> 5, r = w & 31, ch = r >> 1, sel = r & 1;
#pragma unroll 1
            for (int uu = 0; uu < 2; ++uu) attn_unit<1>(a, l, bh >> 2, bh & 3, ch * 4 + (uu ? (sel ? 1 : 0) : (sel ? 2 : 3)), lds, t2);
        }
    }
    __syncthreads();
}

__device__ __forceinline__ void phase_pool(const Args& a, int tid) {
    unsigned char* ws = a.ws;
    const bf16_t* cu = (const bf16_t*)(ws + 3 * PLANE); bf16_t* cz = (bf16_t*)(ws + 2 * PLANE);
    for (int idx = blockIdx.x * 512 + tid; idx < M * 128; idx += gridDim.x * 512) {
        const int r = idx >> 7, c = (idx & 127) * 8, g = c >> 8, W = 2 << g, t = r & 8191, cnt = (t + 1 < W) ? t + 1 : W;
        float s[8], cur[8];
#pragma unroll
        for (int j = 0; j < 8; ++j) s[j] = 0.f;
        for (int k = 0; k < cnt; ++k) {
            const u32x4 v = *(const u32x4*)(cu + (size_t)(r - k) * 1024 + c);
            const float f[8] = {bflo(v.x), bfhi(v.x), bflo(v.y), bfhi(v.y), bflo(v.z), bfhi(v.z), bflo(v.w), bfhi(v.w)};
#pragma unroll
            for (int j = 0; j < 8; ++j) { s[j] += f[j]; if (k == 0) cur[j] = f[j]; }
        }
        const float ic = 1.f / (float)cnt;
        const u32x4 z = *(const u32x4*)(cz + (size_t)r * 1024 + c);
        const float zf[8] = {bflo(z.x), bfhi(z.x), bflo(z.y), bfhi(z.y), bflo(z.z), bfhi(z.z), bflo(z.w), bfhi(z.w)};
        float o[8];
#pragma unroll
        for (int j = 0; j < 8; ++j) o[j] = (s[j] * ic - cur[j]) * silu(zf[j]);
        u32x4 w; w.x = pk2(o[0], o[1]); w.y = pk2(o[2], o[3]); w.z = pk2(o[4], o[5]); w.w = pk2(o[6], o[7]);
        *(u32x4*)(cz + (size_t)r * 1024 + c) = w;
    }
}

__device__ __forceinline__ void phase_final(const Args& a, int tid) {
    const float* fg = a.in[12]; float* out = a.out;
    const int wid = tid >> 6, lane = tid & 63;
    f32x4 gg[4];
#pragma unroll
    for (int j = 0; j < 4; ++j) gg[j] = *(const f32x4*)(fg + j * 256 + lane * 4);
    for (int row = blockIdx.x * 8 + wid; row < M; row += gridDim.x * 8) {
        f32x4 xv[4]; float ss = 0.f;
#pragma unroll
        for (int j = 0; j < 4; ++j) { xv[j] = *(const f32x4*)(out + (size_t)row * D + j * 256 + lane * 4); ss += xv[j][0] * xv[j][0] + xv[j][1] * xv[j][1] + xv[j][2] * xv[j][2] + xv[j][3] * xv[j][3]; }
        ss = wave_sum(ss);
        const float r = rsqrtf(ss * (1.f / 1024.f) + EPS);
#pragma unroll
        for (int j = 0; j < 4; ++j) *(f32x4*)(out + (size_t)row * D + j * 256 + lane * 4) = (xv[j] * r) * gg[j];
    }
}

__global__ void __launch_bounds__(512) mega(Args a0) {
    extern __shared__ __attribute__((aligned(16))) unsigned char lds_raw[];
    LAS unsigned char* lds = (LAS unsigned char*)lds_raw;
    for (int ph = a0.ph_lo; ph < a0.ph_hi; ++ph) {
        Args a = a0; asm volatile("" : "+s"(a.ws), "+s"(a.out));
        unsigned char* ws = a.ws; int G = gridDim.x, cb = blockIdx.x; asm volatile("" : "+s"(G), "+s"(cb));
        int tid = threadIdx.x; asm volatile("" : "+v"(tid));
        const int l = ph / 10, k = (ph == 20) ? 10 : ph % 10;
        if (k == 0 && (PHMASK & 1)) phase_prep(a, l, lds, tid);
        else if (k == 1 && (PHMASK >> 1 & 1)) {
            phase_scans(a, l, lds, tid);
            pg8::Gemm g{(const bf16_t*)(ws + 10 * PLANE), (const bf16_t*)(ws + OFF_WT1), 1024, 1024, 1024};
            SchedStd Sd; Sd.init(64, 36, G, cb, 1024, 1024);
            EpiG1 E{ws};
            pg8::gemm_phase<EpiG1, SchedStd, true, true>(lds, g, Sd, E, tid);
        }
        else if (k == 2 && (PHMASK >> 2 & 1)) phase_conv(a, l, lds, tid);
        else if (k == 3 && (PHMASK >> 3 & 1)) {
            pg8::Gemm g{(const bf16_t*)(ws + 5 * PLANE), (const bf16_t*)(ws + 11 * PLANE), 8192, 8192, 512};
            SchedA1 Sd{G, cb};
            EpiPlain E{(bf16_t*)(ws + OFF_CST), 256, (size_t)65536, 0};
            pg8::gemm_phase<EpiPlain, SchedA1, true, true>(lds, g, Sd, E, tid);
        }
        else if (k == 4 && (PHMASK >> 4 & 1)) phase_statescan(a, tid);
        else if (k == 5 && (PHMASK >> 5 & 1)) phase_attn(a, l, lds, tid);
        else if (k == 6 && (PHMASK >> 6 & 1)) {
            pg8::Gemm g{(const bf16_t*)(ws + 10 * PLANE), (const bf16_t*)(ws + OFF_WT1B), 1024, 1024, 1024};
            SchedStd Sd; Sd.init(64, 20, G, cb, 1024, 1024);
            EpiPlain E{(bf16_t*)(ws + 2 * PLANE), 1024, (size_t)0, 1};
            pg8::gemm_phase<EpiPlain, SchedStd, true, true>(lds, g, Sd, E, tid);
        }
        else if (k == 7 && (PHMASK >> 7 & 1)) phase_pool(a, tid);
        else if (k == 8 && (PHMASK >> 8 & 1)) {
            pg8::Gemm g{(const bf16_t*)(ws), (const bf16_t*)(ws + OFF_WT2), 1024, 1024, 1024};
            SchedG2 Sd{G, cb};
            EpiG2 E{(const bf16_t*)(ws + 4 * PLANE), (float*)(ws + 7 * PLANE), (bf16_t*)(ws + 9 * PLANE)};
            pg8::gemm_phase<EpiG2, SchedG2, true, true>(lds, g, Sd, E, tid);
        }
        else if (k == 9 && (PHMASK >> 9 & 1)) {
            pg8::Gemm g{(const bf16_t*)(ws + 9 * PLANE), (const bf16_t*)(ws + OFF_WT3), 1024, 1024, 1024};
            SchedStd Sd; Sd.init(64, 4, G, cb, 1024, 1024);
            EpiG3 E{(l == 0) ? a.in[0] : a.out, a.out};
            pg8::gemm_phase<EpiG3, SchedStd, true, true>(lds, g, Sd, E, tid);
        }
        else if (k == 10 && (PHMASK >> 10 & 1)) phase_final(a, tid);
        if (ph + 1 < a0.ph_hi) { __syncthreads(); cg::this_grid().sync(); }
    }
}

extern "C" void kernel_launch(void* const* d_in, const int* in_sizes, int n_in, void* d_out, int out_size, void* d_ws, size_t ws_size, hipStream_t stream) {
    static int grid_blocks = 0;
    if (!grid_blocks) {
        hipFuncSetAttribute((const void*)mega, hipFuncAttributeMaxDynamicSharedMemorySize, LDS_BYTES);
        int dev = 0, cus = 0, per_cu = 0;
        hipGetDevice(&dev);
        hipDeviceGetAttribute(&cus, hipDeviceAttributeMultiprocessorCount, dev);
        hipOccupancyMaxActiveBlocksPerMultiprocessor(&per_cu, mega, 512, LDS_BYTES);
        if (per_cu < 1) per_cu = 1;
        grid_blocks = cus * per_cu; if (grid_blocks > 256) grid_blocks = 256;
    }
    if (ws_size < OFF_END) { fprintf(stderr, "workspace too small: %zu < %zu\n", ws_size, (size_t)OFF_END); return; }
    Args a{};
    for (int i = 0; i < 13; ++i) a.in[i] = (const float*)d_in[i];
    a.out = (float*)d_out; a.ws = (unsigned char*)d_ws;
#if MK_MULTI
    for (int ph = 0; ph < NPH; ++ph) { a.ph_lo = ph; a.ph_hi = ph + 1; hipLaunchKernelGGL(mega, dim3(grid_blocks), dim3(512), LDS_BYTES, stream, a); }
#else
    a.ph_lo = 0; a.ph_hi = NPH;
    void* args[] = {&a};
    hipError_t e = hipLaunchCooperativeKernel((void*)mega, dim3(grid_blocks), dim3(512), args, LDS_BYTES, stream);
    if (e != hipSuccess) fprintf(stderr, "cooperative launch failed: %s (grid %d)\n", hipGetErrorString(e), grid_blocks);
#endif
}
```

```cpp
#include <hip/hip_runtime.h>
#include <hip/hip_cooperative_groups.h>
#include <cstdio>
#include <cstdint>
namespace cg = cooperative_groups;

#ifndef MK_MULTI
#define MK_MULTI 0
#endif

namespace pg8 {
#define PG8_LAS __attribute__((address_space(3)))
typedef unsigned short bf16_t;
typedef short bf16x8 __attribute__((ext_vector_type(8)));
typedef float f32x4 __attribute__((ext_vector_type(4)));
typedef unsigned u32x4 __attribute__((ext_vector_type(4)));
constexpr int BM = 256, BK = 64, HALF = 128, HTB = HALF * BK * 2  , STAGE_BYTES = 8 * HTB, NXCD = 8, WGM = 8;

__host__ __device__ __forceinline__ int lds_byte(int r, int c) { const int st = (r >> 4) * 2 + (c >> 5), rr = r & 15, cc = c & 31, ob = rr * 64 + cc * 2; return st * 1024 + (ob ^ (((ob >> 9) & 1) << 5)); }
__host__ __device__ __forceinline__ void stage_rc(int b, int& R, int& C) { const int st = b / 1024, sb = b % 1024, swz = sb ^ (((sb >> 9) & 1) << 5); R = (st >> 1) * 16 + swz / 64; C = (st & 1) * 32 + (swz % 64) / 2; }
__host__ __device__ __forceinline__ int perm32(int rho) { const int n = rho >> 4, i = rho & 15; return 8 * (i >> 2) + 4 * n + (i & 3); }

struct Unit { int pm, pn, z; };
struct Gemm { const bf16_t* A; const bf16_t* Bt; int lda, ldb, K; };

__device__ __forceinline__ unsigned cvt_pk_bf16(float lo, float hi) { unsigned r; asm volatile("v_cvt_pk_bf16_f32 %0, %1, %2" : "=v"(r) : "v"(lo), "v"(hi)); return r; }

template <class Epi, class Sched, bool ALIGN_EPI = false, bool SP2 = false>
__device__ __forceinline__ void gemm_phase(PG8_LAS unsigned char* lds, const Gemm g, const Sched& S, const Epi& E, const int tid) {
    const int wid = __builtin_amdgcn_readfirstlane(tid >> 6), lane = tid & 63, wr = wid >> 2, wc = wid & 3, fr = lane & 15, fq = lane >> 4;
    const int K = g.K, nt = K / BK;
    unsigned voffA[2], voffB[2];
#pragma unroll
    for (int i = 0; i < 2; ++i) { int R, C; stage_rc(tid * 16 + i * 8192, R, C); const int Rb = Epi::PERM ? ((R & ~31) + perm32(R & 31)) : R;
        voffA[i] = (unsigned)(R * g.lda + C) * 2u; voffB[i] = (unsigned)(Rb * g.ldb + C) * 2u; }
    const size_t kstep = (size_t)(BK * 2);
    const size_t hstepA = (size_t)HALF * g.lda * 2, hstepB = (size_t)HALF * g.ldb * 2;
    const unsigned ldsw = (unsigned)wid * 1024u;
    const int aoff = lds_byte(wr * 64 + fr, fq * 8), boff = lds_byte(wc * 32 + fr, fq * 8);
#define PG8_SA(b, h) (((b) * 2 + (h)) * HTB)
#define PG8_SB(b, h) ((4 + (b) * 2 + (h)) * HTB)
#define PG8_STAGE(bufoff, gbase, voff) do { _Pragma("unroll") for (int _i = 0; _i < 2; ++_i) \
        __builtin_amdgcn_global_load_lds((const unsigned*)((const char*)(gbase) + (voff)[_i]), (PG8_LAS unsigned*)(lds + (bufoff) + ldsw + _i * 8192), 16, 0, 0); } while (0)
#define PG8_LDA(dst, b, h) do { _Pragma("unroll") for (int m = 0; m < 4; ++m) _Pragma("unroll") for (int k = 0; k < 2; ++k) dst[m][k] = *(const PG8_LAS bf16x8*)(lds + PG8_SA(b, h) + aoff + m * 2048 + k * 1024); } while (0)
#define PG8_LDB(dst, b, h) do { _Pragma("unroll") for (int n = 0; n < 2; ++n) _Pragma("unroll") for (int k = 0; k < 2; ++k) dst[n][k] = *(const PG8_LAS bf16x8*)(lds + PG8_SB(b, h) + boff + n * 2048 + k * 1024); } while (0)
#define PG8_MMA(ai, bj, At, Bt) do { __builtin_amdgcn_s_setprio(1); _Pragma("unroll") for (int m = 0; m < 4; ++m) _Pragma("unroll") for (int n = 0; n < 2; ++n) _Pragma("unroll") for (int k = 0; k < 2; ++k) \
        acc[ai][bj][m][n] = __builtin_amdgcn_mfma_f32_16x16x32_bf16(Bt[n][k], At[m][k], acc[ai][bj][m][n], 0, 0, 0); __builtin_amdgcn_s_setprio(0); } while (0)
#define PG8_WAIT_V(n) asm volatile("s_waitcnt vmcnt(" #n ")" ::: "memory")
#define PG8_WAIT_L(n) asm volatile("s_waitcnt lgkmcnt(" #n ")" ::: "memory")
#define PG8_BAR __builtin_amdgcn_s_barrier()
#define PG8_SCHED __builtin_amdgcn_sched_barrier(0)
    Unit cur, nxt; int ui = 0;
    if (!S.next(0, cur)) return;
    f32x4 acc[2][2][4][2];
#pragma unroll
    for (int a = 0; a < 2; ++a)
#pragma unroll
        for (int b = 0; b < 2; ++b)
#pragma unroll
            for (int m = 0; m < 4; ++m)
#pragma unroll
                for (int n = 0; n < 2; ++n) acc[a][b][m][n] = (f32x4){0.f, 0.f, 0.f, 0.f};
    bf16x8 At[4][2], B0[2][2], B1[2][2];
    const char* cA = (const char*)g.A + S.a_off(cur); const char* cB = (const char*)g.Bt + S.b_off(cur);
    S.a_ready(cur);
    if constexpr (SP2) {
        PG8_STAGE(PG8_SB(0, 0), cB, voffB); PG8_STAGE(PG8_SB(0, 1), cB + hstepB, voffB); PG8_STAGE(PG8_SA(0, 0), cA, voffA); PG8_STAGE(PG8_SA(0, 1), cA + hstepA, voffA);
        if (wr == 1) PG8_BAR;
        PG8_WAIT_V(2); PG8_BAR;
        PG8_STAGE(PG8_SB(1, 0), cB + kstep, voffB); PG8_STAGE(PG8_SA(1, 0), cA + kstep, voffA); PG8_STAGE(PG8_SB(1, 1), cB + hstepB + kstep, voffB);
        PG8_WAIT_V(6); PG8_BAR;
    } else {
        PG8_STAGE(PG8_SB(0, 0), cB, voffB); PG8_STAGE(PG8_SA(0, 0), cA, voffA); PG8_STAGE(PG8_SB(0, 1), cB + hstepB, voffB); PG8_STAGE(PG8_SA(0, 1), cA + hstepA, voffA);
        if (wr == 1) PG8_BAR;
        PG8_WAIT_V(4); PG8_BAR;
        PG8_STAGE(PG8_SB(1, 0), cB + kstep, voffB); PG8_STAGE(PG8_SA(1, 0), cA + kstep, voffA); PG8_STAGE(PG8_SB(1, 1), cB + hstepB + kstep, voffB);
        PG8_WAIT_V(6); PG8_BAR;
    }
    for (;;) {
        const bool has_next = S.next(ui + 1, nxt);
        const char* nA = has_next ? (const char*)g.A + S.a_off(nxt) : cA; const char* nB = has_next ? (const char*)g.Bt + S.b_off(nxt) : cB;
        for (int t = 0; t < nt; t += 2) {
            const bool last = (t == nt - 2);
            const char* a1 = cA + (size_t)(t + 1) * kstep;
            const char* a2 = last ? nA : cA + (size_t)(t + 2) * kstep; const char* b2 = last ? nB : cB + (size_t)(t + 2) * kstep;
            const char* a3 = a2 + kstep; const char* b3 = b2 + kstep;
            if (last && has_next) S.a_ready(nxt);
            if constexpr (SP2) {
            PG8_LDB(B0, 0, 0); PG8_LDB(B1, 0, 1); PG8_SCHED; PG8_LDA(At, 0, 0); PG8_STAGE(PG8_SA(1, 1), a1 + hstepA, voffA);
            PG8_WAIT_V(8); PG8_WAIT_L(0); PG8_BAR; PG8_MMA(0, 0, At, B0); PG8_MMA(0, 1, At, B1); PG8_BAR; PG8_SCHED;
            PG8_LDA(At, 0, 1); PG8_STAGE(PG8_SB(0, 0), b2, voffB); PG8_STAGE(PG8_SB(0, 1), b2 + hstepB, voffB); PG8_STAGE(PG8_SA(0, 0), a2, voffA);
            PG8_WAIT_V(8); PG8_WAIT_L(0); PG8_BAR; PG8_MMA(1, 0, At, B0); PG8_MMA(1, 1, At, B1); PG8_BAR; PG8_SCHED;
            PG8_LDB(B0, 1, 0); PG8_LDB(B1, 1, 1); PG8_SCHED; PG8_LDA(At, 1, 0); PG8_STAGE(PG8_SA(0, 1), a2 + hstepA, voffA);
            PG8_WAIT_V(8); PG8_WAIT_L(0); PG8_BAR; PG8_MMA(0, 0, At, B0); PG8_MMA(0, 1, At, B1); PG8_BAR; PG8_SCHED;
            PG8_LDA(At, 1, 1); PG8_STAGE(PG8_SB(1, 0), b3, voffB); PG8_STAGE(PG8_SB(1, 1), b3 + hstepB, voffB); PG8_STAGE(PG8_SA(1, 0), a3, voffA);
            PG8_WAIT_V(8); PG8_WAIT_L(0); PG8_BAR; PG8_MMA(1, 0, At, B0); PG8_MMA(1, 1, At, B1); PG8_BAR; PG8_SCHED;
            } else {
            PG8_LDB(B0, 0, 0); PG8_SCHED; PG8_LDA(At, 0, 0); PG8_STAGE(PG8_SA(1, 1), a1 + hstepA, voffA);
            PG8_WAIT_L(8); PG8_BAR; PG8_WAIT_L(0); PG8_MMA(0, 0, At, B0); PG8_BAR; PG8_SCHED;
            PG8_LDB(B1, 0, 1); PG8_STAGE(PG8_SB(0, 0), b2, voffB);
            PG8_BAR; PG8_WAIT_L(0); PG8_MMA(0, 1, At, B1); PG8_BAR;
            PG8_LDA(At, 0, 1); PG8_STAGE(PG8_SA(0, 0), a2, voffA);
            PG8_BAR; PG8_WAIT_L(0); PG8_MMA(1, 0, At, B0); PG8_BAR; PG8_SCHED;
            PG8_STAGE(PG8_SB(0, 1), b2 + hstepB, voffB);
            PG8_WAIT_V(6); PG8_BAR; PG8_MMA(1, 1, At, B1); PG8_BAR;
            PG8_LDB(B0, 1, 0); PG8_SCHED; PG8_LDA(At, 1, 0); PG8_STAGE(PG8_SA(0, 1), a2 + hstepA, voffA);
            PG8_WAIT_L(8); PG8_BAR; PG8_WAIT_L(0); PG8_MMA(0, 0, At, B0); PG8_BAR; PG8_SCHED;
            PG8_LDB(B1, 1, 1); PG8_STAGE(PG8_SB(1, 0), b3, voffB);
            PG8_BAR; PG8_WAIT_L(0); PG8_MMA(0, 1, At, B1); PG8_BAR;
            PG8_LDA(At, 1, 1); PG8_STAGE(PG8_SA(1, 0), a3, voffA);
            PG8_BAR; PG8_WAIT_L(0); PG8_MMA(1, 0, At, B0); PG8_BAR; PG8_SCHED;
            PG8_STAGE(PG8_SB(1, 1), b3 + hstepB, voffB);
            PG8_WAIT_V(6); PG8_BAR; PG8_MMA(1, 1, At, B1); PG8_BAR;
            }
        }
        if constexpr (ALIGN_EPI) { if (wr == 0) PG8_BAR; }
        if constexpr (!Epi::AFTER_DRAIN) { E(acc, cur, wr, wc, fr, fq); S.done(cur); }
        if (!has_next) break;
#pragma unroll
        for (int a = 0; a < 2; ++a)
#pragma unroll
            for (int b = 0; b < 2; ++b)
#pragma unroll
                for (int m = 0; m < 4; ++m)
#pragma unroll
                    for (int n = 0; n < 2; ++n) acc[a][b][m][n] = (f32x4){0.f, 0.f, 0.f, 0.f};
        cur = nxt; cA = nA; cB = nB; ++ui;
        if constexpr (ALIGN_EPI) { if (wr == 1) PG8_BAR; }
    }
    PG8_WAIT_V(0);
    if constexpr (!ALIGN_EPI) { if (wr == 0) PG8_BAR; }
    PG8_BAR;
    if constexpr (Epi::AFTER_DRAIN) { E.fused(acc, cur, wr, wc, fr, fq, lds, wid, lane); S.done(cur); }
#undef PG8_SA
#undef PG8_SB
#undef PG8_STAGE
#undef PG8_LDA
#undef PG8_LDB
#undef PG8_MMA
#undef PG8_WAIT_V
#undef PG8_WAIT_L
#undef PG8_BAR
#undef PG8_SCHED
}
}

#ifndef PG8_SP2
#define PG8_SP2 true
#endif
#ifndef PG8_ALIGN
#define PG8_ALIGN true
#endif

using pg8::bf16_t; using pg8::bf16x8; using pg8::f32x4; using pg8::u32x4;
typedef float f32x16 __attribute__((ext_vector_type(16)));
typedef unsigned u32x2 __attribute__((ext_vector_type(2)));
#define LAS __attribute__((address_space(3)))

constexpr int M = 16384, S = 8192, D = 1024, NIN = 14352;
constexpr size_t PLANE = (size_t)M * D * 2;
constexpr float EPS = 1e-6f, LOG2E = 1.4426950408889634f;
constexpr size_t MiB = 1048576;
constexpr size_t OFF_WT1 = 12 * PLANE, OFF_WT1B = OFF_WT1 + 18 * MiB, OFF_WT2 = OFF_WT1B + 10 * MiB, OFF_WT3 = OFF_WT2 + 6 * MiB,
    OFF_HALO = OFF_WT3 + 2 * MiB, OFF_GATES = OFF_HALO + 3 * MiB, OFF_A2 = OFF_GATES + MiB, OFF_M2 = OFF_A2 + 262144, OFF_EM = OFF_M2 + 262144,
    OFF_WK = OFF_EM + 262144, OFF_F2 = OFF_WK + 262144, OFF_MP2 = OFF_F2 + 524288, OFF_NST = OFF_MP2 + 4096, OFF_KN2 = OFF_NST + 65536, OFF_QCTR = OFF_KN2 + 256, OFF_END = OFF_QCTR + 256;
constexpr size_t OFF_CST = OFF_WT1;
constexpr int LDS_BYTES = 143360;
constexpr int NPH = 21;
#ifndef ATTNMASK
#define ATTNMASK 3
#endif
#ifndef PHMASK
#define PHMASK 0x7ff
#endif

struct Args { const float* in[13]; float* out; unsigned char* ws; int ph_lo, ph_hi; };

__device__ __forceinline__ float bf2f(unsigned b) { return __uint_as_float(b << 16); }
__device__ __forceinline__ float bflo(unsigned w) { return __uint_as_float(w << 16); }
__device__ __forceinline__ float bfhi(unsigned w) { return __uint_as_float(w & 0xffff0000u); }
__device__ __forceinline__ unsigned pk2(float lo, float hi) { return pg8::cvt_pk_bf16(lo, hi); }
__device__ __forceinline__ float wave_sum(float v) {
#pragma unroll
    for (int o = 32; o; o >>= 1) v += __shfl_xor(v, o);
    return v; }
__device__ __forceinline__ float sigm(float x) { return 1.f / (1.f + __expf(-x)); }
__device__ __forceinline__ float silu(float x) { return x / (1.f + __expf(-x)); }
__device__ __forceinline__ float logsig(float x) { return fminf(x, 0.f) - log1pf(expf(-fabsf(x))); }
__device__ __forceinline__ int crow(int r, int hi) { return (r & 3) + 8 * (r >> 2) + 4 * hi; }

struct SchedStd {
    int nM, nN, nwg, G, c, lda, ldb;
    __device__ void init(int nM_, int nN_, int G_, int c_, int lda_, int ldb_) { nM = nM_; nN = nN_; nwg = nM * nN; G = G_; c = c_; lda = lda_; ldb = ldb_; }
    __device__ bool next(int i, pg8::Unit& u) const {
        const long L = (long)i * G + c; if (L >= nwg) return false;
        int wgid = (int)L; { const int q = nwg / 8, r = nwg % 8, xcd = wgid % 8, off = wgid / 8; wgid = (xcd < r ? xcd * (q + 1) : r * (q + 1) + (xcd - r) * q) + off; }
        const int nig = 8 * nN, gid = wgid / nig, fm = gid * 8, gsz = (nM - fm) < 8 ? (nM - fm) : 8;
        u.pm = fm + ((wgid % nig) % gsz); u.pn = (wgid % nig) / gsz; u.z = 0; return true;
    }
    __device__ __forceinline__ size_t a_off(const pg8::Unit& u) const { return (size_t)u.pm * 256 * lda * 2; }
    __device__ __forceinline__ size_t b_off(const pg8::Unit& u) const { return (size_t)u.pn * 256 * ldb * 2; }
    __device__ __forceinline__ void a_ready(const pg8::Unit&) const {}
    __device__ __forceinline__ void done(const pg8::Unit&) const {}
};
struct SchedG2 {
    int G, c;
    __device__ bool next(int i, pg8::Unit& u) const {
        const int t = (i / 3) * G + c; if (t >= 256) return false;
        u.pm = t >> 2; u.pn = t & 3; u.z = i % 3; return true;
    }
    __device__ __forceinline__ size_t a_off(const pg8::Unit& u) const { return (size_t)u.z * PLANE + (size_t)u.pm * 256 * 1024 * 2; }
    __device__ __forceinline__ size_t b_off(const pg8::Unit& u) const { return ((size_t)u.z * 1024 + (size_t)u.pn * 256) * 1024 * 2; }
    __device__ __forceinline__ void a_ready(const pg8::Unit&) const {}
    __device__ __forceinline__ void done(const pg8::Unit&) const {}
};
struct SchedA1 {
    int G, c;
    __device__ bool next(int i, pg8::Unit& u) const { const int L = i * G + c; if (L >= 128) return false; u.pm = 0; u.pn = 0; u.z = L; return true; }
    __device__ __forceinline__ size_t a_off(const pg8::Unit& u) const { const int bh = u.z >> 4, ch = u.z & 15; return ((size_t)((bh >> 2) * 1024 + (bh & 3) * 256) * 8192 + (size_t)ch * 512) * 2; }
    __device__ __forceinline__ size_t b_off(const pg8::Unit& u) const { return a_off(u); }
    __device__ __forceinline__ void a_ready(const pg8::Unit&) const {}
    __device__ __forceinline__ void done(const pg8::Unit&) const {}
};

struct EpiG1 {
    static constexpr bool PERM = true, AFTER_DRAIN = false;
    unsigned char* ws;
    __device__ __forceinline__ void operator()(const f32x4 (&acc)[2][2][4][2], const pg8::Unit& u, int wr, int wc, int fr, int fq) const {
        asm volatile("" : "+v"(fr), "+v"(fq));
        const int p9 = u.pn >> 2;
        const int dpl = (p9 < 2) ? p9 : p9 + 1;
        bf16_t* base = (bf16_t*)(ws + (size_t)dpl * PLANE);
        bf16_t* halo = (bf16_t*)(ws + OFF_HALO);
        const int cc0 = (u.pn & 3) * 256 + wc * 32 + 8 * fq;
        const int row0 = u.pm * 256 + wr * 64 + fr;
        const bool transposed = (p9 == 4 || p9 == 8), hal = (p9 == 2 || p9 == 3);
        const float sc = (p9 == 6) ? (0.08838834764831845f * LOG2E) : 1.f;
#pragma unroll
        for (int ai = 0; ai < 2; ++ai)
#pragma unroll
            for (int m = 0; m < 4; ++m) {
                const int r = row0 + ai * 128 + m * 16;
#pragma unroll
                for (int bj = 0; bj < 2; ++bj) {
                    const int c = cc0 + bj * 128;
                    const f32x4 v0 = acc[ai][bj][m][0] * sc, v1 = acc[ai][bj][m][1] * sc;
                    u32x4 w; w.x = pk2(v0[0], v0[1]); w.y = pk2(v0[2], v0[3]); w.z = pk2(v1[0], v1[1]); w.w = pk2(v1[2], v1[3]);
                    if (!transposed) {
                        *(u32x4*)(base + (size_t)r * 1024 + c) = w;
                        if (hal && m == 3 && fr >= 13) *(u32x4*)(halo + ((size_t)(r >> 6) * 3 + (fr - 13)) * 2048 + (p9 == 3 ? 1024 : 0) + c) = w;
                    } else {
                        const int b = r >> 13, t = r & 8191;
                        bf16_t* p = base + ((size_t)(b * 1024 + c)) * 8192 + t;
                        p[0] = (bf16_t)(w.x & 0xffff); p[8192] = (bf16_t)(w.x >> 16); p[2 * 8192] = (bf16_t)(w.y & 0xffff); p[3 * 8192] = (bf16_t)(w.y >> 16);
                        p[4 * 8192] = (bf16_t)(w.z & 0xffff); p[5 * 8192] = (bf16_t)(w.z >> 16); p[6 * 8192] = (bf16_t)(w.w & 0xffff); p[7 * 8192] = (bf16_t)(w.w >> 16);
                    }
                }
            }
    }
};
struct EpiPlain {
    static constexpr bool PERM = true, AFTER_DRAIN = false;
    bf16_t* base; int ldc; size_t zstride; int split;
    __device__ __forceinline__ void operator()(const f32x4 (&acc)[2][2][4][2], const pg8::Unit& u, int wr, int wc, int fr, int fq) const {
        asm volatile("" : "+v"(fr), "+v"(fq));
        bf16_t* bp = base + (size_t)u.z * zstride;
        int colt = u.pn * 256;
        if (split) { bp += (size_t)(u.pn >> 2) * (PLANE / 2); colt = (u.pn & 3) * 256; }
        const int cc0 = colt + wc * 32 + 8 * fq, row0 = u.pm * 256 + wr * 64 + fr;
#pragma unroll
        for (int ai = 0; ai < 2; ++ai)
#pragma unroll
            for (int m = 0; m < 4; ++m) {
                bf16_t* rowp = bp + (size_t)(row0 + ai * 128 + m * 16) * ldc + cc0;
#pragma unroll
                for (int bj = 0; bj < 2; ++bj) {
                    const f32x4 v0 = acc[ai][bj][m][0], v1 = acc[ai][bj][m][1];
                    u32x4 w; w.x = pk2(v0[0], v0[1]); w.y = pk2(v0[2], v0[3]); w.z = pk2(v1[0], v1[1]); w.w = pk2(v1[2], v1[3]);
                    *(u32x4*)(rowp + bj * 128) = w;
                }
            }
    }
};
struct EpiG2 {
    static constexpr bool PERM = true, AFTER_DRAIN = false;
    const bf16_t* gates; float* tmp; bf16_t* outp;
    __device__ __forceinline__ void operator()(const f32x4 (&acc)[2][2][4][2], const pg8::Unit& u, int wr, int wc, int fr, int fq) const {
        asm volatile("" : "+v"(fr), "+v"(fq));
        const bf16_t* gp = gates + (size_t)u.z * (PLANE / 2);
        const int cc0 = u.pn * 256 + wc * 32 + 8 * fq, row0 = u.pm * 256 + wr * 64 + fr;
#pragma unroll
        for (int ai = 0; ai < 2; ++ai)
#pragma unroll
            for (int m = 0; m < 4; ++m) {
                const size_t ro = (size_t)(row0 + ai * 128 + m * 16) * 1024 + cc0;
#pragma unroll
                for (int bj = 0; bj < 2; ++bj) {
                    const size_t o = ro + bj * 128;
                    const u32x4 g = *(const u32x4*)(gp + o);
                    f32x4 v0 = acc[ai][bj][m][0], v1 = acc[ai][bj][m][1];
                    v0[0] *= sigm(bflo(g.x)); v0[1] *= sigm(bfhi(g.x)); v0[2] *= sigm(bflo(g.y)); v0[3] *= sigm(bfhi(g.y));
                    v1[0] *= sigm(bflo(g.z)); v1[1] *= sigm(bfhi(g.z)); v1[2] *= sigm(bflo(g.w)); v1[3] *= sigm(bfhi(g.w));
                    if (u.z != 0) { v0 += *(const f32x4*)(tmp + o); v1 += *(const f32x4*)(tmp + o + 4); }
                    if (u.z != 2) { *(f32x4*)(tmp + o) = v0; *(f32x4*)(tmp + o + 4) = v1; }
                    else { u32x4 w; w.x = pk2(v0[0], v0[1]); w.y = pk2(v0[2], v0[3]); w.z = pk2(v1[0], v1[1]); w.w = pk2(v1[2], v1[3]); *(u32x4*)(outp + o) = w; }
                }
            }
    }
};
struct EpiG3 {
    static constexpr bool PERM = true, AFTER_DRAIN = false;
    const float* xin; float* out;
    __device__ __forceinline__ void operator()(const f32x4 (&acc)[2][2][4][2], const pg8::Unit& u, int wr, int wc, int fr, int fq) const {
        asm volatile("" : "+v"(fr), "+v"(fq));
        const int cc0 = u.pn * 256 + wc * 32 + 8 * fq, row0 = u.pm * 256 + wr * 64 + fr;
#pragma unroll
        for (int ai = 0; ai < 2; ++ai)
#pragma unroll
            for (int m = 0; m < 4; ++m) {
                const size_t ro = (size_t)(row0 + ai * 128 + m * 16) * 1024 + cc0;
#pragma unroll
                for (int bj = 0; bj < 2; ++bj) {
                    const size_t o = ro + bj * 128;
                    const f32x4 x0 = *(const f32x4*)(xin + o), x1 = *(const f32x4*)(xin + o + 4);
                    *(f32x4*)(out + o) = x0 + acc[ai][bj][m][0]; *(f32x4*)(out + o + 4) = x1 + acc[ai][bj][m][1];
                }
            }
    }
};

__device__ __forceinline__ int g1_srccol(int p) {
    switch (p) { case 0: return 4096; case 1: return 8200; case 2: return 0; case 3: return 1024; case 4: return 2048; case 5: return 3072; case 6: return 5128; case 7: return 6152; default: return 7176; } }

__device__ __forceinline__ void transpose_tile(const float* __restrict__ src, int pitch, bf16_t* __restrict__ dst, LAS float* scr, int tid) {
#pragma unroll
    for (int i = 0; i < 2; ++i) { const int r = (tid >> 4) + 32 * i, c4 = tid & 15; const f32x4 v = *(const f32x4*)(src + (size_t)r * pitch + c4 * 4);
        scr[r * 65 + c4 * 4 + 0] = v[0]; scr[r * 65 + c4 * 4 + 1] = v[1]; scr[r * 65 + c4 * 4 + 2] = v[2]; scr[r * 65 + c4 * 4 + 3] = v[3]; }
    __syncthreads();
    { const int n = tid >> 3, kc = tid & 7; float v[8];
#pragma unroll
      for (int j = 0; j < 8; ++j) v[j] = scr[(kc * 8 + j) * 65 + n];
      u32x4 w; w.x = pk2(v[0], v[1]); w.y = pk2(v[2], v[3]); w.z = pk2(v[4], v[5]); w.w = pk2(v[6], v[7]);
      *(u32x4*)(dst + (size_t)n * 1024 + kc * 8) = w; }
    __syncthreads();
}

__device__ __forceinline__ void phase_prep(const Args& a, int l, LAS unsigned char* lds, int tid) {
    unsigned char* ws = a.ws;
    const float* w_in = a.in[2] + (size_t)l * D * NIN;
    const float* w_br = a.in[10] + (size_t)l * 3 * D * D;
    const float* w_out = a.in[11] + (size_t)l * D * D;
    const float* pool_w = a.in[8] + (size_t)l * 4 * 256 * 256;
    const float* pool_s = a.in[9] + (size_t)l * D;
    LAS float* scr = (LAS float*)lds;
    for (int it = blockIdx.x; it < 17 * 256; it += gridDim.x) {
        const int id = it >> 8, nt = (it & 255) >> 4, kt = it & 15;
        const float* src; int pitch; bf16_t* dst;
        if (id < 9)       { src = w_in + (size_t)(kt * 64) * NIN + g1_srccol(id) + nt * 64; pitch = NIN; dst = (bf16_t*)(ws + OFF_WT1) + (size_t)(id * 1024 + nt * 64) * 1024 + kt * 64; }
        else if (id < 13) { const int q = id - 9; const int prow = (q == 0) ? 0 : q + 1; const int col = (q == 0) ? 10256 : 11280 + (q - 1) * 1024;
                            src = w_in + (size_t)(kt * 64) * NIN + col + nt * 64; pitch = NIN; dst = (bf16_t*)(ws + OFF_WT1B) + (size_t)(prow * 1024 + nt * 64) * 1024 + kt * 64; }
        else if (id < 16) { const int n = id - 13; src = w_br + (size_t)n * D * D + (size_t)(kt * 64) * D + nt * 64; pitch = D; dst = (bf16_t*)(ws + OFF_WT2) + (size_t)(n * 1024 + nt * 64) * 1024 + kt * 64; }
        else              { src = w_out + (size_t)(kt * 64) * D + nt * 64; pitch = D; dst = (bf16_t*)(ws + OFF_WT3) + (size_t)(nt * 64) * 1024 + kt * 64; }
        transpose_tile(src, pitch, dst, scr, tid);
    }
    for (int it = blockIdx.x; it < 256; it += gridDim.x) {
        const int g = it >> 6, kt = (it & 63) >> 2, dt = it & 3;
        LAS float* As = scr; LAS float* Bs = scr + 64 * 65;
        float acc[8];
#pragma unroll
        for (int j = 0; j < 8; ++j) acc[j] = 0.f;
        for (int cc = 0; cc < 4; ++cc) {
#pragma unroll
            for (int i = 0; i < 2; ++i) { const int r = (tid >> 4) + 32 * i, c4 = tid & 15;
                const f32x4 va = *(const f32x4*)(w_in + (size_t)(kt * 64 + r) * NIN + 9232 + g * 256 + cc * 64 + c4 * 4);
                As[r * 65 + c4 * 4 + 0] = va[0]; As[r * 65 + c4 * 4 + 1] = va[1]; As[r * 65 + c4 * 4 + 2] = va[2]; As[r * 65 + c4 * 4 + 3] = va[3];
                const f32x4 vb = *(const f32x4*)(pool_w + (size_t)(g * 256 + cc * 64 + r) * 256 + dt * 64 + c4 * 4);
                Bs[r * 64 + c4 * 4 + 0] = vb[0]; Bs[r * 64 + c4 * 4 + 1] = vb[1]; Bs[r * 64 + c4 * 4 + 2] = vb[2]; Bs[r * 64 + c4 * 4 + 3] = vb[3]; }
            __syncthreads();
            const int d = tid & 63, kg = tid >> 6;
            for (int c = 0; c < 64; ++c) { const float bv = Bs[c * 64 + d];
#pragma unroll
                for (int j = 0; j < 8; ++j) acc[j] += As[(kg * 8 + j) * 65 + c] * bv; }
            __syncthreads();
        }
        const int d = tid & 63, kg = tid >> 6;
        const float sc = pool_s[g * 256 + dt * 64 + d];
        u32x4 w; w.x = pk2(acc[0] * sc, acc[1] * sc); w.y = pk2(acc[2] * sc, acc[3] * sc); w.z = pk2(acc[4] * sc, acc[5] * sc); w.w = pk2(acc[6] * sc, acc[7] * sc);
        *(u32x4*)((bf16_t*)(ws + OFF_WT1B) + (size_t)(1024 + g * 256 + dt * 64 + d) * 1024 + kt * 64 + kg * 8) = w;
    }
    if (blockIdx.x == 0 && tid < 16) { ((unsigned*)(ws + OFF_KN2))[tid] = 0u; ((unsigned*)(ws + OFF_QCTR))[tid] = 0u; }
    LAS float* gw = (LAS float*)lds;
    __syncthreads();
    for (int e = tid; e < 16 * 1024; e += 512) { const int c = e & 15, k = e >> 4; const int col = (c < 8) ? 5120 + c : 9224 + (c - 8); gw[c * 1024 + k] = w_in[(size_t)k * NIN + col]; }
    __syncthreads();
    {
        const float* xin = (l == 0) ? a.in[0] : a.out;
        const float* ng = a.in[1] + (size_t)l * D;
        bf16_t* hb = (bf16_t*)(ws + 10 * PLANE);
        float* gates = (float*)(ws + OFF_GATES);
        const int wid = tid >> 6, lane = tid & 63;
        f32x4 gg[4];
#pragma unroll
        for (int j = 0; j < 4; ++j) gg[j] = *(const f32x4*)(ng + j * 256 + lane * 4);
        for (int row = blockIdx.x * 8 + wid; row < M; row += gridDim.x * 8) {
            f32x4 xv[4]; float ss = 0.f;
#pragma unroll
            for (int j = 0; j < 4; ++j) { xv[j] = *(const f32x4*)(xin + (size_t)row * D + j * 256 + lane * 4); ss += xv[j][0] * xv[j][0] + xv[j][1] * xv[j][1] + xv[j][2] * xv[j][2] + xv[j][3] * xv[j][3]; }
            ss = wave_sum(ss);
            const float r = rsqrtf(ss * (1.f / 1024.f) + EPS);
#pragma unroll
            for (int j = 0; j < 4; ++j) { xv[j] = (xv[j] * r) * gg[j]; u32x2 w; w.x = pk2(xv[j][0], xv[j][1]); w.y = pk2(xv[j][2], xv[j][3]); *(u32x2*)(hb + (size_t)row * D + j * 256 + lane * 4) = w; }
            float ga[16];
#pragma unroll
            for (int c = 0; c < 16; ++c) { float s = 0.f;
#pragma unroll
                for (int j = 0; j < 4; ++j) { const f32x4 wv = *(const LAS f32x4*)(gw + c * 1024 + j * 256 + lane * 4); s += xv[j][0] * wv[0] + xv[j][1] * wv[1] + xv[j][2] * wv[2] + xv[j][3] * wv[3]; }
                ga[c] = wave_sum(s); }
            float outv = ga[0];
#pragma unroll
            for (int c = 1; c < 16; ++c) outv = (lane == c) ? ga[c] : outv;
            if (lane < 16) gates[(size_t)row * 16 + lane] = outv;
        }
    }
    __syncthreads();
}

__device__ __forceinline__ float block_excl_scan_add(float tot, LAS float* sm, int tid) {
    const int lane = tid & 63, wid = tid >> 6; float x = tot;
#pragma unroll
    for (int o = 1; o < 64; o <<= 1) { const float v = __shfl_up(x, o); if (lane >= o) x += v; }
    __syncthreads();
    if (lane == 63) sm[wid] = x;
    __syncthreads();
    float base = 0.f;
    for (int w = 0; w < wid; ++w) base += sm[w];
    return base + x - tot;
}
__device__ __forceinline__ float block_excl_scan_max(float tot, LAS float* sm, int tid) {
    const int lane = tid & 63, wid = tid >> 6; float x = tot;
#pragma unroll
    for (int o = 1; o < 64; o <<= 1) { const float v = __shfl_up(x, o); if (lane >= o) x = fmaxf(x, v); }
    __syncthreads();
    if (lane == 63) sm[wid] = x;
    __syncthreads();
    float base = -INFINITY;
    for (int w = 0; w < wid; ++w) base = fmaxf(base, sm[w]);
    const float prev = __shfl_up(x, 1);
    return fmaxf(base, lane ? prev : -INFINITY);
}
__device__ __forceinline__ void phase_scans(const Args& a, int l, LAS unsigned char* lds, int tid) {
    unsigned char* ws = a.ws; const float* gates = (const float*)(ws + OFF_GATES);
    LAS float* sm = (LAS float*)lds;
    LAS float* Fs = sm + 64; LAS float* As = Fs + 8192; LAS float* Ms = As + 8192;
    const int bx = blockIdx.x;
    if (bx < 8) {
        const int b = bx >> 2, h = bx & 3; const float bi = a.in[4][l * 4 + h], bfv = a.in[5][l * 4 + h];
        float run = 0.f;
#pragma unroll 2
        for (int i = 0; i < 16; ++i) { const size_t row = (size_t)b * S + tid * 16 + i; run += logsig(gates[row * 16 + 4 + h] + bfv); Fs[tid * 16 + i] = run; }
        const float pre = block_excl_scan_add(run, sm, tid);
        float mx = -INFINITY;
#pragma unroll 2
        for (int i = 0; i < 16; ++i) { const size_t row = (size_t)b * S + tid * 16 + i; const float F = Fs[tid * 16 + i] + pre; const float av = gates[row * 16 + h] + bi - F;
            Fs[tid * 16 + i] = F; As[tid * 16 + i] = av; mx = fmaxf(mx, av); }
        const float pm = block_excl_scan_max(mx, sm + 16, tid);
        float Mrun = fmaxf(pm, 0.f);
#pragma unroll 2
        for (int i = 0; i < 16; ++i) { Mrun = fmaxf(Mrun, As[tid * 16 + i]); Ms[tid * 16 + i] = Mrun; }
        __syncthreads();
        if ((tid & 31) == 31) sm[32 + (tid >> 5)] = Mrun;
        __syncthreads();
        const float Mend = sm[32 + (tid >> 5)];
        float* A2 = (float*)(ws + OFF_A2) + (size_t)bx * S + tid * 16; float* M2 = (float*)(ws + OFF_M2) + (size_t)bx * S + tid * 16;
        float* EM = (float*)(ws + OFF_EM) + (size_t)bx * S + tid * 16; float* WK = (float*)(ws + OFF_WK) + (size_t)bx * S + tid * 16;
#pragma unroll 2
        for (int i = 0; i < 16; ++i) { const float av = As[tid * 16 + i], Mv = Ms[tid * 16 + i], F = Fs[tid * 16 + i];
            A2[i] = av * LOG2E; M2[i] = Mv * LOG2E; EM[i] = expf(-(F + Mv)); WK[i] = expf(av - Mend); }
        float* MP = (float*)(ws + OFF_MP2) + bx * 32;
        if (tid == 0) MP[0] = 0.f;
        if (tid < 16) MP[tid + 1] = sm[32 + tid] * LOG2E;
        __syncthreads();
    } else if (bx < 24) {
        const int bh = bx - 8, b = bh >> 3, h = bh & 7; const float bfv = a.in[7][l * 8 + h];
        float run = 0.f;
#pragma unroll 2
        for (int i = 0; i < 16; ++i) { const size_t row = (size_t)b * S + tid * 16 + i; run += logsig(gates[row * 16 + 8 + h] + bfv); Fs[tid * 16 + i] = run; }
        const float pre = block_excl_scan_add(run, sm, tid);
        float* F2 = (float*)(ws + OFF_F2) + (size_t)bh * S + tid * 16;
#pragma unroll 2
        for (int i = 0; i < 16; ++i) F2[i] = (Fs[tid * 16 + i] + pre) * LOG2E;
        __syncthreads();
    }
}

__device__ __forceinline__ void phase_conv(const Args& a, int l, LAS unsigned char* lds, int tid) {
    unsigned char* ws = a.ws;
    const float* cw = a.in[3] + (size_t)l * 4 * 2048;
    const bf16_t* halo = (const bf16_t*)(ws + OFF_HALO);
    const float* WK = (const float*)(ws + OFF_WK);
    LAS float* raw = (LAS float*)lds;
    LAS float* tb = raw + 67 * 65 + 3;
    for (int it = blockIdx.x; it < 256 * 32; it += gridDim.x) {
        const int tt = it >> 5, cs = it & 31;
        const bool isk = cs >= 16;
        bf16_t* pl = (bf16_t*)(ws + (size_t)(isk ? 4 : 3) * PLANE);
        const int c0 = (cs & 15) * 64;
        const int r = tid >> 3, c8 = (tid & 7) * 8;
        { const u32x4 v = *(const u32x4*)(pl + (size_t)(tt * 64 + r) * 1024 + c0 + c8); LAS float* d = raw + (r + 3) * 65 + c8;
          d[0] = bflo(v.x); d[1] = bfhi(v.x); d[2] = bflo(v.y); d[3] = bfhi(v.y); d[4] = bflo(v.z); d[5] = bfhi(v.z); d[6] = bflo(v.w); d[7] = bfhi(v.w); }
        if (tid < 24) { const int hr = tid >> 3; LAS float* d = raw + hr * 65 + c8;
            if ((tt & 127) == 0) { for (int j = 0; j < 8; ++j) d[j] = 0.f; }
            else { const u32x4 v = *(const u32x4*)(halo + ((size_t)(tt - 1) * 3 + hr) * 2048 + cs * 64 + c8);
                d[0] = bflo(v.x); d[1] = bfhi(v.x); d[2] = bflo(v.y); d[3] = bfhi(v.y); d[4] = bflo(v.z); d[5] = bfhi(v.z); d[6] = bflo(v.w); d[7] = bfhi(v.w); } }
        __syncthreads();
        float o[8];
        { const int gc = cs * 64 + c8;
#pragma unroll
          for (int j = 0; j < 8; ++j) { float s = 0.f;
#pragma unroll
              for (int kk = 0; kk < 4; ++kk) s += cw[kk * 2048 + gc + j] * raw[(r + kk) * 65 + c8 + j];
              o[j] = silu(s); } }
        if (!isk) {
#pragma unroll
            for (int j = 0; j < 8; ++j) o[j] *= 0.0625f;
        }
        { u32x4 w; w.x = pk2(o[0], o[1]); w.y = pk2(o[2], o[3]); w.z = pk2(o[4], o[5]); w.w = pk2(o[6], o[7]);
          *(u32x4*)(pl + (size_t)(tt * 64 + r) * 1024 + c0 + c8) = w; }
        if (isk) {
            const int b = tt >> 7, t0 = (tt & 127) * 64, hh = c0 >> 8;
            const float wk = WK[(size_t)(b * 4 + hh) * S + t0 + r];
#pragma unroll
            for (int j = 0; j < 8; ++j) tb[(c8 + j) * 65 + r] = o[j] * wk;
            __syncthreads();
            const int c = tid >> 3, t8 = (tid & 7) * 8;
            float v[8];
#pragma unroll
            for (int j = 0; j < 8; ++j) v[j] = tb[c * 65 + t8 + j];
            u32x4 w; w.x = pk2(v[0], v[1]); w.y = pk2(v[2], v[3]); w.z = pk2(v[4], v[5]); w.w = pk2(v[6], v[7]);
            *(u32x4*)((bf16_t*)(ws + 11 * PLANE) + (size_t)(b * 1024 + c0 + c) * 8192 + t0 + t8) = w;
        }
        __syncthreads();
    }
    {
        LAS unsigned* smx = (LAS unsigned*)lds;
        if (tid < 16) smx[tid] = 0u;
        __syncthreads();
        const int wid = tid >> 6, lane = tid & 63;
        const bf16_t* bk = (const bf16_t*)(ws + 8 * PLANE);
        float m0 = 0.f, m1 = 0.f;
        for (int row = blockIdx.x * 8 + wid; row < M; row += gridDim.x * 8) {
            const u32x4 v0 = *(const u32x4*)(bk + (size_t)row * 1024 + lane * 16), v1 = *(const u32x4*)(bk + (size_t)row * 1024 + lane * 16 + 8);
            float s = bflo(v0.x) * bflo(v0.x) + bfhi(v0.x) * bfhi(v0.x) + bflo(v0.y) * bflo(v0.y) + bfhi(v0.y) * bfhi(v0.y) + bflo(v0.z) * bflo(v0.z) + bfhi(v0.z) * bfhi(v0.z) + bflo(v0.w) * bflo(v0.w) + bfhi(v0.w) * bfhi(v0.w)
                    + bflo(v1.x) * bflo(v1.x) + bfhi(v1.x) * bfhi(v1.x) + bflo(v1.y) * bflo(v1.y) + bfhi(v1.y) * bfhi(v1.y) + bflo(v1.z) * bflo(v1.z) + bfhi(v1.z) * bfhi(v1.z) + bflo(v1.w) * bflo(v1.w) + bfhi(v1.w) * bfhi(v1.w);
            s += __shfl_xor(s, 1); s += __shfl_xor(s, 2); s += __shfl_xor(s, 4);
            if (row < S) m0 = fmaxf(m0, s); else m1 = fmaxf(m1, s);
        }
        if ((lane & 7) == 0) { __hip_atomic_fetch_max((unsigned*)(smx + (lane >> 3)), __float_as_uint(m0), __ATOMIC_RELAXED, __HIP_MEMORY_SCOPE_WORKGROUP); __hip_atomic_fetch_max((unsigned*)(smx + 8 + (lane >> 3)), __float_as_uint(m1), __ATOMIC_RELAXED, __HIP_MEMORY_SCOPE_WORKGROUP); }
        __syncthreads();
        if (tid < 16) __hip_atomic_fetch_max((unsigned*)(ws + OFF_KN2) + tid, smx[tid], __ATOMIC_RELAXED, __HIP_MEMORY_SCOPE_AGENT);
        __syncthreads();
    }
}

__device__ __forceinline__ void phase_statescan(const Args& a, int tid) {
    unsigned char* ws = a.ws;
    const float* MP = (const float*)(ws + OFF_MP2);
    bf16_t* Cst = (bf16_t*)(ws + OFF_CST);
    for (int grp = blockIdx.x * 512 + tid; grp < 8 * 16384; grp += gridDim.x * 512) {
        const int bh = grp >> 14, e = (grp & 16383) * 4;
        float C0 = 0.f, C1 = 0.f, C2 = 0.f, C3 = 0.f;
        for (int c = 0; c < 16; ++c) {
            u32x2* p = (u32x2*)(Cst + ((size_t)(bh * 16 + c) * 65536 + e));
            const u32x2 d = *p; u32x2 w; w.x = pk2(C0, C1); w.y = pk2(C2, C3); *p = w;
            const float dec = exp2f(MP[bh * 32 + c] - MP[bh * 32 + c + 1]);
            C0 = dec * C0 + bflo(d.x); C1 = dec * C1 + bfhi(d.x); C2 = dec * C2 + bflo(d.y); C3 = dec * C3 + bfhi(d.y);
        }
    }
    const int wid = tid >> 6, lane = tid & 63;
    bf16_t* nst = (bf16_t*)(ws + OFF_NST);
    for (int gwv = blockIdx.x * 8 + wid; gwv < 2048; gwv += gridDim.x * 8) {
        const int bh = gwv >> 8, k = gwv & 255;
        const bf16_t* row = (const bf16_t*)(ws + 11 * PLANE) + (size_t)((bh >> 2) * 1024 + (bh & 3) * 256 + k) * 8192;
        float n = 0.f;
        for (int c = 0; c < 16; ++c) {
            const u32x4 v = *(const u32x4*)(row + c * 512 + lane * 8);
            float s = bflo(v.x) + bfhi(v.x) + bflo(v.y) + bfhi(v.y) + bflo(v.z) + bfhi(v.z) + bflo(v.w) + bfhi(v.w);
            s = wave_sum(s);
            if (lane == 0) nst[(size_t)(bh * 16 + c) * 256 + k] = (bf16_t)(pk2(n, n) & 0xffff);
            const float dec = exp2f(MP[bh * 32 + c] - MP[bh * 32 + c + 1]);
            n = dec * n + s;
        }
    }
}

#define MFMA32(a, b, c) __builtin_amdgcn_mfma_f32_32x32x16_bf16(a, b, c, 0, 0, 0)
template <int MODE>
__device__ __forceinline__ void attn_unit(const Args& a, int l, int b, int h, int qb, LAS unsigned char* lds, int tid) {
    constexpr int DH = MODE ? 256 : 128, KS = DH / 16, QROWS = MODE ? 128 : 256, VROWS = DH, KP = DH * 2 + 16, VP = 136;
    constexpr int KCH = 64 * DH / 8 / 512, VCH = VROWS * 8 / 512;
    unsigned char* ws = a.ws;
    const int wid = __builtin_amdgcn_readfirstlane(tid >> 6), lane = tid & 63, l32 = lane & 31, hi = lane >> 5;
    const int rg = MODE ? (wid & 3) : wid, vh = MODE ? (wid >> 2) : 0;
    const int q0 = qb * QROWS + rg * 32, tq = q0 + l32;
    const bf16_t* Qp = (const bf16_t*)(ws + (size_t)(MODE ? 3 : 7) * PLANE);
    const bf16_t* Kp = (const bf16_t*)(ws + (size_t)(MODE ? 4 : 8) * PLANE);
    const bf16_t* VTp = (const bf16_t*)(ws + (size_t)(MODE ? 5 : 9) * PLANE);
    const int bh = MODE ? (b * 4 + h) : (b * 8 + h);
    const float* biasG = MODE ? ((const float*)(ws + OFF_A2) + (size_t)bh * S) : ((const float*)(ws + OFF_F2) + (size_t)bh * S);
    LAS unsigned char* Ks = lds; LAS unsigned char* Vs = lds + 64 * KP; LAS float* biasK = (LAS float*)(lds + 64 * KP + VROWS * VP); LAS float* red = biasK + 64;

    bf16x8 qf[MODE ? 1 : KS];
    LAS unsigned char* Qs = lds + 64 * KP + VROWS * VP + 256 + 1024;
    if (MODE) {
        __syncthreads();
#pragma unroll
        for (int i = 0; i < 8; ++i) { const int q = tid + i * 512, r = q >> 5, cc = q & 31;
            *(LAS u32x4*)(Qs + r * KP + cc * 16) = *(const u32x4*)(Qp + (size_t)(b * S + qb * QROWS + r) * 1024 + h * DH + cc * 8); }
        __syncthreads();
    } else {
#pragma unroll
        for (int ks = 0; ks < KS; ++ks) qf[ks] = *(const bf16x8*)(Qp + (size_t)(b * S + tq) * 1024 + h * DH + ks * 16 + hi * 8);
    }
#define QF(ks) (MODE ? *(const LAS bf16x8*)(Qs + (rg * 32 + l32) * KP + ((ks) * 16 + hi * 8) * 2) : qf[MODE ? 0 : (ks)])
    f32x16 O[4];
#pragma unroll
    for (int vb = 0; vb < 4; ++vb)
#pragma unroll
        for (int i = 0; i < 16; ++i) O[vb][i] = 0.f;
    float rowb = biasG[tq];
    float m_run = -INFINITY, l_run = 0.f, den_inter = 0.f, M2t = 0.f;
    int j0 = 0, j1 = qb * 4 + 3;
    if (MODE) {
        const int ch = qb >> 2; j0 = ch * 8; j1 = qb * 2 + 1;
        M2t = ((const float*)(ws + OFF_M2))[(size_t)bh * S + tq];
        const bf16_t* Cb = (const bf16_t*)(ws + OFF_CST) + (size_t)(bh * 16 + ch) * 65536;
#pragma unroll
        for (int vb = 0; vb < 4; ++vb)
#pragma unroll
            for (int ks = 0; ks < KS; ++ks) { const bf16x8 af = *(const bf16x8*)(Cb + (size_t)(vh * 128 + vb * 32 + l32) * 256 + ks * 16 + hi * 8); O[vb] = MFMA32(af, QF(ks), O[vb]); }
        f32x16 nacc;
#pragma unroll
        for (int i = 0; i < 16; ++i) nacc[i] = 0.f;
        const bf16_t* nb = (const bf16_t*)(ws + OFF_NST) + (size_t)(bh * 16 + ch) * 256;
#pragma unroll
        for (int ks = 0; ks < KS; ++ks) { bf16x8 af = *(const bf16x8*)(nb + ks * 16 + hi * 8); if (l32 != 0) af = (bf16x8){0, 0, 0, 0, 0, 0, 0, 0}; nacc = MFMA32(af, QF(ks), nacc); }
        const float nq = __shfl(nacc[0], l32);
        const float winter = exp2f(((const float*)(ws + OFF_MP2))[bh * 32 + ch] - M2t);
#pragma unroll
        for (int vb = 0; vb < 4; ++vb)
#pragma unroll
            for (int i = 0; i < 16; ++i) O[vb][i] *= winter;
        den_inter = winter * nq;
    }
    u32x4 kreg[KCH], vreg[VCH]; float breg = 0.f;
    auto gload = [&](int j) {
#pragma unroll
        for (int i = 0; i < KCH; ++i) { const int q = tid + i * 512, r = q / (DH / 8), cc = q % (DH / 8); kreg[i] = *(const u32x4*)(Kp + (size_t)(b * S + j * 64 + r) * 1024 + h * DH + cc * 8); }
#pragma unroll
        for (int i = 0; i < VCH; ++i) { const int q = tid + i * 512, r = q >> 3, cc = q & 7; vreg[i] = *(const u32x4*)(VTp + (size_t)(b * 1024 + h * DH + r) * 8192 + j * 64 + cc * 8); }
        if (tid < 64) breg = biasG[j * 64 + tid];
    };
    float Bt = 0.f;
    LAS int* flags = (LAS int*)red;
    if (!MODE) {
        float qs = 0.f;
#pragma unroll
        for (int ks = 0; ks < (MODE ? 1 : KS); ++ks)
#pragma unroll
            for (int e = 0; e < 8; ++e) { const float f = bf2f((unsigned short)qf[ks][e]); qs += f * f; }
        qs += __shfl_xor(qs, 32);
        const float kn2 = __uint_as_float(((const unsigned*)(ws + OFF_KN2))[bh]);
        Bt = sqrtf(qs * kn2) * 1.01f + rowb;
        gload(j1);
    }
    const int ntile = j1 - j0 + 1;
    for (int jt = 0; jt < ntile; ++jt) {
        const int j = MODE ? (j0 + jt) : (j1 - jt);
        __syncthreads();
        if (!MODE && jt > 0) { const int any = flags[0] | flags[1] | flags[2] | flags[3] | flags[4] | flags[5] | flags[6] | flags[7]; if (!any) break; }
        if (MODE) gload(j);
#pragma unroll
        for (int i = 0; i < KCH; ++i) { const int q = tid + i * 512, r = q / (DH / 8), cc = q % (DH / 8); *(LAS u32x4*)(Ks + r * KP + cc * 16) = kreg[i]; }
#pragma unroll
        for (int i = 0; i < VCH; ++i) { const int q = tid + i * 512, r = q >> 3, cc = q & 7; *(LAS u32x2*)(Vs + r * VP + cc * 16) = (u32x2){vreg[i].x, vreg[i].y}; *(LAS u32x2*)(Vs + r * VP + cc * 16 + 8) = (u32x2){vreg[i].z, vreg[i].w}; }
        if (tid < 64) biasK[tid] = breg;
        __syncthreads();
        if (!MODE && j > 0) gload(j - 1);
        if (j * 64 <= q0 + 31) {
            bf16x8 pb[2][2];
            const bool diag = (j * 64 + 63 > q0);
            if (MODE) {
                float ls = 0.f;
#pragma unroll
                for (int kb = 0; kb < 2; ++kb) {
                    f32x16 s1;
#pragma unroll
                    for (int i = 0; i < 16; ++i) s1[i] = 0.f;
#pragma unroll
                    for (int ks = 0; ks < KS; ++ks) { const bf16x8 af = *(const LAS bf16x8*)(Ks + (kb * 32 + l32) * KP + (ks * 16 + hi * 8) * 2); s1 = MFMA32(af, QF(ks), s1); }
#pragma unroll
                    for (int i4 = 0; i4 < 4; ++i4) { const f32x4 bk = *(const LAS f32x4*)(biasK + kb * 32 + 8 * i4 + 4 * hi);
#pragma unroll
                        for (int r = 0; r < 4; ++r) { const int i = i4 * 4 + r; const int key = j * 64 + kb * 32 + 8 * i4 + 4 * hi + r;
                            float w = exp2f(bk[r] - M2t); if (diag && key > tq) w = 0.f;
                            const float p = s1[i] * w; s1[i] = p; ls += p; } }
#pragma unroll
                    for (int jj = 0; jj < 2; ++jj) {
                        u32x4 w; w.x = pk2(s1[8 * jj + 0], s1[8 * jj + 1]); w.y = pk2(s1[8 * jj + 2], s1[8 * jj + 3]);
                        w.z = pk2(s1[8 * jj + 4], s1[8 * jj + 5]); w.w = pk2(s1[8 * jj + 6], s1[8 * jj + 7]);
                        pb[kb][jj] = __builtin_bit_cast(bf16x8, w);
                    }
                }
                l_run += ls;
            } else {
            f32x16 s[2];
#pragma unroll
            for (int kb = 0; kb < 2; ++kb) {
#pragma unroll
                for (int i4 = 0; i4 < 4; ++i4) { const f32x4 bk = *(const LAS f32x4*)(biasK + kb * 32 + 8 * i4 + 4 * hi);
#pragma unroll
                    for (int r = 0; r < 4; ++r) s[kb][i4 * 4 + r] = rowb - bk[r]; }
#pragma unroll
                for (int ks = 0; ks < KS; ++ks) { const bf16x8 af = *(const LAS bf16x8*)(Ks + (kb * 32 + l32) * KP + (ks * 16 + hi * 8) * 2); s[kb] = MFMA32(af, QF(ks), s[kb]); }
            }
            {
                if (diag) {
#pragma unroll
                    for (int kb = 0; kb < 2; ++kb)
#pragma unroll
                        for (int i = 0; i < 16; ++i) { const int key = j * 64 + kb * 32 + crow(i, hi); if (key > tq) s[kb][i] = -INFINITY; }
                }
                float mx = -INFINITY;
#pragma unroll
                for (int kb = 0; kb < 2; ++kb)
#pragma unroll
                    for (int i = 0; i < 16; ++i) mx = fmaxf(mx, s[kb][i]);
                mx = fmaxf(mx, __shfl_xor(mx, 32));
                const float m_new = fmaxf(m_run, mx);
                const float alpha = exp2f(m_run - m_new);
                float ls = 0.f;
#pragma unroll
                for (int kb = 0; kb < 2; ++kb)
#pragma unroll
                    for (int i = 0; i < 16; ++i) { const float p = exp2f(s[kb][i] - m_new); s[kb][i] = p; ls += p; }
                l_run = l_run * alpha + ls; m_run = m_new;
#pragma unroll
                for (int vb = 0; vb < 4; ++vb)
#pragma unroll
                    for (int i = 0; i < 16; ++i) O[vb][i] *= alpha;
            }
#pragma unroll
            for (int kb = 0; kb < 2; ++kb)
#pragma unroll
                for (int jj = 0; jj < 2; ++jj) {
                    u32x4 w; w.x = pk2(s[kb][8 * jj + 0], s[kb][8 * jj + 1]); w.y = pk2(s[kb][8 * jj + 2], s[kb][8 * jj + 3]);
                    w.z = pk2(s[kb][8 * jj + 4], s[kb][8 * jj + 5]); w.w = pk2(s[kb][8 * jj + 6], s[kb][8 * jj + 7]);
                    pb[kb][jj] = __builtin_bit_cast(bf16x8, w);
                }
            }
#pragma unroll
            for (int vb = 0; vb < 4; ++vb)
#pragma unroll
                for (int kb = 0; kb < 2; ++kb)
#pragma unroll
                    for (int jj = 0; jj < 2; ++jj) {
                        const LAS unsigned char* vp = Vs + (vh * 128 + vb * 32 + l32) * VP + (kb * 32 + 16 * jj + 4 * hi) * 2;
                        const u32x2 lo = *(const LAS u32x2*)vp, hi2 = *(const LAS u32x2*)(vp + 16);
                        const u32x4 w = (u32x4){lo.x, lo.y, hi2.x, hi2.y};
                        O[vb] = MFMA32(__builtin_bit_cast(bf16x8, w), pb[kb][jj], O[vb]);
                    }
        }
        if (!MODE && j > 0) {
            const float fk_last = biasG[(j - 1) * 64 + 63];
            const bool need = !((Bt - fk_last) - m_run < -160.f);
            const unsigned long long bal = __ballot(need);
            if (lane == 0) flags[wid] = (bal != 0ull) ? 1 : 0;
        }
    }
    const size_t rowoff = (size_t)(b * S + tq) * 1024;
    if (!MODE) {
        const float lt = l_run + __shfl_xor(l_run, 32);
        const float inv = 1.f / lt;
        bf16_t* bz = (bf16_t*)(ws + 1 * PLANE) + rowoff + h * 128;
#pragma unroll
        for (int vb = 0; vb < 4; ++vb)
#pragma unroll
            for (int i4 = 0; i4 < 4; ++i4) {
                bf16_t* p = bz + vb * 32 + 8 * i4 + 4 * hi;
                const u32x2 z = *(const u32x2*)p;
                u32x2 w; w.x = pk2(O[vb][i4 * 4 + 0] * inv * silu(bflo(z.x)), O[vb][i4 * 4 + 1] * inv * silu(bfhi(z.x)));
                w.y = pk2(O[vb][i4 * 4 + 2] * inv * silu(bflo(z.y)), O[vb][i4 * 4 + 3] * inv * silu(bfhi(z.y)));
                *(u32x2*)p = w;
            }
    } else {
        const float den = l_run + __shfl_xor(l_run, 32) + den_inter;
        const float em = ((const float*)(ws + OFF_EM))[(size_t)bh * S + tq];
        const float invd = 1.f / fmaxf(fabsf(den), em);
        float ssq = 0.f;
#pragma unroll
        for (int vb = 0; vb < 4; ++vb)
#pragma unroll
            for (int i = 0; i < 16; ++i) { O[vb][i] *= invd; ssq += O[vb][i] * O[vb][i]; }
        ssq += __shfl_xor(ssq, 32);
        if (hi == 0) red[(vh * 4 + rg) * 32 + l32] = ssq;
        __syncthreads();
        const float tot = red[rg * 32 + l32] + red[(4 + rg) * 32 + l32];
        const float rs = rsqrtf(tot * (1.f / 256.f) + EPS);
        const float* ng = a.in[6] + (size_t)l * D + h * 256 + vh * 128;
        bf16_t* az = (bf16_t*)(ws) + rowoff + h * 256 + vh * 128;
        const bf16_t* ao = (const bf16_t*)(ws + 6 * PLANE) + rowoff + h * 256 + vh * 128;
#pragma unroll
        for (int vb = 0; vb < 4; ++vb)
#pragma unroll
            for (int i4 = 0; i4 < 4; ++i4) {
                const int v = vb * 32 + 8 * i4 + 4 * hi;
                const u32x2 z = *(const u32x2*)(az + v), o = *(const u32x2*)(ao + v);
                const f32x4 g = *(const f32x4*)(ng + v);
                u32x2 w;
                w.x = pk2(O[vb][i4 * 4 + 0] * rs * g[0] * sigm(bflo(o.x)) * silu(bflo(z.x)), O[vb][i4 * 4 + 1] * rs * g[1] * sigm(bfhi(o.x)) * silu(bfhi(z.x)));
                w.y = pk2(O[vb][i4 * 4 + 2] * rs * g[2] * sigm(bflo(o.y)) * silu(bflo(z.y)), O[vb][i4 * 4 + 3] * rs * g[3] * sigm(bfhi(o.y)) * silu(bfhi(z.y)));
                *(u32x2*)(az + v) = w;
            }
    }
}

__device__ __forceinline__ void phase_attn(const Args& a, int l, LAS unsigned char* lds, int tid) {
    LAS int* slot = (LAS int*)(lds + LDS_BYTES - 16);
    unsigned* ctr = (unsigned*)(a.ws + OFF_QCTR);
    if (ATTNMASK & 1) {
        for (;;) {
            __syncthreads();
            if (tid == 0) *slot = (int)__hip_atomic_fetch_add(ctr, 1u, __ATOMIC_RELAXED, __HIP_MEMORY_SCOPE_AGENT);
            __syncthreads();
            const int idx = *slot;
            if (idx >= 512) break;
            const int h = 7 - (idx >> 6), r = idx & 63;
            attn_unit<0>(a, l, r & 1, h, 31 - (r >> 1), lds, tid);
        }
    }
    __syncthreads();
    if (ATTNMASK & 2) {
        int t2 = tid; asm volatile("" : "+v"(t2));
        for (;;) {
            __syncthreads();
            if (t2 == 0) *slot = (int)__hip_atomic_fetch_add(ctr + 1, 1u, __ATOMIC_RELAXED, __HIP_MEMORY_SCOPE_AGENT);
            __syncthreads();
            const int idx = *slot;
            if (idx >= 512) break;
            const int qm = 3 - (idx >> 7), r = idx & 127, bh = r & 7, ch = r >> 3;
            attn_unit<1>(a, l, bh >> 2, bh & 3, ch * 4 + qm, lds, t2);
        }
    }
    __syncthreads();
}

__device__ __forceinline__ void phase_pool(const Args& a, int tid) {
    unsigned char* ws = a.ws;
    const bf16_t* cu = (const bf16_t*)(ws + 3 * PLANE); bf16_t* cz = (bf16_t*)(ws + 2 * PLANE);
    for (int idx = blockIdx.x * 512 + tid; idx < M * 128; idx += gridDim.x * 512) {
        const int r = idx >> 7, c = (idx & 127) * 8, g = c >> 8, W = 2 << g, t = r & 8191, cnt = (t + 1 < W) ? t + 1 : W;
        float s[8], cur[8];
#pragma unroll
        for (int j = 0; j < 8; ++j) s[j] = 0.f;
        for (int k = 0; k < cnt; ++k) {
            const u32x4 v = *(const u32x4*)(cu + (size_t)(r - k) * 1024 + c);
            const float f[8] = {bflo(v.x), bfhi(v.x), bflo(v.y), bfhi(v.y), bflo(v.z), bfhi(v.z), bflo(v.w), bfhi(v.w)};
#pragma unroll
            for (int j = 0; j < 8; ++j) { s[j] += f[j]; if (k == 0) cur[j] = f[j]; }
        }
        const float ic = 1.f / (float)cnt;
        const u32x4 z = *(const u32x4*)(cz + (size_t)r * 1024 + c);
        const float zf[8] = {bflo(z.x), bfhi(z.x), bflo(z.y), bfhi(z.y), bflo(z.z), bfhi(z.z), bflo(z.w), bfhi(z.w)};
        float o[8];
#pragma unroll
        for (int j = 0; j < 8; ++j) o[j] = (s[j] * ic - cur[j]) * silu(zf[j]);
        u32x4 w; w.x = pk2(o[0], o[1]); w.y = pk2(o[2], o[3]); w.z = pk2(o[4], o[5]); w.w = pk2(o[6], o[7]);
        *(u32x4*)(cz + (size_t)r * 1024 + c) = w;
    }
}

__device__ __forceinline__ void phase_final(const Args& a, int tid) {
    const float* fg = a.in[12]; float* out = a.out;
    const int wid = tid >> 6, lane = tid & 63;
    f32x4 gg[4];
#pragma unroll
    for (int j = 0; j < 4; ++j) gg[j] = *(const f32x4*)(fg + j * 256 + lane * 4);
    for (int row = blockIdx.x * 8 + wid; row < M; row += gridDim.x * 8) {
        f32x4 xv[4]; float ss = 0.f;
#pragma unroll
        for (int j = 0; j < 4; ++j) { xv[j] = *(const f32x4*)(out + (size_t)row * D + j * 256 + lane * 4); ss += xv[j][0] * xv[j][0] + xv[j][1] * xv[j][1] + xv[j][2] * xv[j][2] + xv[j][3] * xv[j][3]; }
        ss = wave_sum(ss);
        const float r = rsqrtf(ss * (1.f / 1024.f) + EPS);
#pragma unroll
        for (int j = 0; j < 4; ++j) *(f32x4*)(out + (size_t)row * D + j * 256 + lane * 4) = (xv[j] * r) * gg[j];
    }
}

__global__ void __launch_bounds__(512) mega(Args a0) {
    extern __shared__ __attribute__((aligned(16))) unsigned char lds_raw[];
    LAS unsigned char* lds = (LAS unsigned char*)lds_raw;
    for (int ph = a0.ph_lo; ph < a0.ph_hi; ++ph) {
        Args a = a0; asm volatile("" : "+s"(a.ws), "+s"(a.out));
        unsigned char* ws = a.ws; int G = gridDim.x, cb = blockIdx.x; asm volatile("" : "+s"(G), "+s"(cb));
        int tid = threadIdx.x; asm volatile("" : "+v"(tid));
        const int l = ph / 10, k = (ph == 20) ? 10 : ph % 10;
        if (k == 0 && (PHMASK & 1)) phase_prep(a, l, lds, tid);
        else if (k == 1 && (PHMASK >> 1 & 1)) {
            phase_scans(a, l, lds, tid);
            pg8::Gemm g{(const bf16_t*)(ws + 10 * PLANE), (const bf16_t*)(ws + OFF_WT1), 1024, 1024, 1024};
            SchedStd Sd; Sd.init(64, 36, G, cb, 1024, 1024);
            EpiG1 E{ws};
            pg8::gemm_phase<EpiG1, SchedStd, true, true>(lds, g, Sd, E, tid);
        }
        else if (k == 2 && (PHMASK >> 2 & 1)) phase_conv(a, l, lds, tid);
        else if (k == 3 && (PHMASK >> 3 & 1)) {
            pg8::Gemm g{(const bf16_t*)(ws + 5 * PLANE), (const bf16_t*)(ws + 11 * PLANE), 8192, 8192, 512};
            SchedA1 Sd{G, cb};
            EpiPlain E{(bf16_t*)(ws + OFF_CST), 256, (size_t)65536, 0};
            pg8::gemm_phase<EpiPlain, SchedA1, true, true>(lds, g, Sd, E, tid);
        }
        else if (k == 4 && (PHMASK >> 4 & 1)) phase_statescan(a, tid);
        else if (k == 5 && (PHMASK >> 5 & 1)) phase_attn(a, l, lds, tid);
        else if (k == 6 && (PHMASK >> 6 & 1)) {
            pg8::Gemm g{(const bf16_t*)(ws + 10 * PLANE), (const bf16_t*)(ws + OFF_WT1B), 1024, 1024, 1024};
            SchedStd Sd; Sd.init(64, 20, G, cb, 1024, 1024);
            EpiPlain E{(bf16_t*)(ws + 2 * PLANE), 1024, (size_t)0, 1};
            pg8::gemm_phase<EpiPlain, SchedStd, true, true>(lds, g, Sd, E, tid);
        }
        else if (k == 7 && (PHMASK >> 7 & 1)) phase_pool(a, tid);
        else if (k == 8 && (PHMASK >> 8 & 1)) {
            pg8::Gemm g{(const bf16_t*)(ws), (const bf16_t*)(ws + OFF_WT2), 1024, 1024, 1024};
            SchedG2 Sd{G, cb};
            EpiG2 E{(const bf16_t*)(ws + 4 * PLANE), (float*)(ws + 7 * PLANE), (bf16_t*)(ws + 9 * PLANE)};
            pg8::gemm_phase<EpiG2, SchedG2, true, true>(lds, g, Sd, E, tid);
        }
        else if (k == 9 && (PHMASK >> 9 & 1)) {
            pg8::Gemm g{(const bf16_t*)(ws + 9 * PLANE), (const bf16_t*)(ws + OFF_WT3), 1024, 1024, 1024};
            SchedStd Sd; Sd.init(64, 4, G, cb, 1024, 1024);
            EpiG3 E{(l == 0) ? a.in[0] : a.out, a.out};
            pg8::gemm_phase<EpiG3, SchedStd, true, true>(lds, g, Sd, E, tid);
        }
        else if (k == 10 && (PHMASK >> 10 & 1)) phase_final(a, tid);
        if (ph + 1 < a0.ph_hi) { __syncthreads(); cg::this_grid().sync(); }
    }
}

extern "C" void kernel_launch(void* const* d_in, const int* in_sizes, int n_in, void* d_out, int out_size, void* d_ws, size_t ws_size, hipStream_t stream) {
    static int grid_blocks = 0;
    if (!grid_blocks) {
        hipFuncSetAttribute((const void*)mega, hipFuncAttributeMaxDynamicSharedMemorySize, LDS_BYTES);
        int dev = 0, cus = 0, per_cu = 0;
        hipGetDevice(&dev);
        hipDeviceGetAttribute(&cus, hipDeviceAttributeMultiprocessorCount, dev);
        hipOccupancyMaxActiveBlocksPerMultiprocessor(&per_cu, mega, 512, LDS_BYTES);
        if (per_cu < 1) per_cu = 1;
        grid_blocks = cus * per_cu; if (grid_blocks > 256) grid_blocks = 256;
    }
    if (ws_size < OFF_END) { fprintf(stderr, "workspace too small: %zu < %zu\n", ws_size, (size_t)OFF_END); return; }
    Args a{};
    for (int i = 0; i < 13; ++i) a.in[i] = (const float*)d_in[i];
    a.out = (float*)d_out; a.ws = (unsigned char*)d_ws;
#if MK_MULTI
    for (int ph = 0; ph < NPH; ++ph) { a.ph_lo = ph; a.ph_hi = ph + 1; hipLaunchKernelGGL(mega, dim3(grid_blocks), dim3(512), LDS_BYTES, stream, a); }
#else
    a.ph_lo = 0; a.ph_hi = NPH;
    void* args[] = {&a};
    hipError_t e = hipLaunchCooperativeKernel((void*)mega, dim3(grid_blocks), dim3(512), args, LDS_BYTES, stream);
    if (e != hipSuccess) fprintf(stderr, "cooperative launch failed: %s (grid %d)\n", hipGetErrorString(e), grid_blocks);
#endif
}
```

```cpp
#include <hip/hip_runtime.h>
#include <hip/hip_cooperative_groups.h>
#include <cstdio>
#include <cstdint>
namespace cg = cooperative_groups;

#ifndef MK_MULTI
#define MK_MULTI 0
#endif

namespace pg8 {
#define PG8_LAS __attribute__((address_space(3)))
typedef unsigned short bf16_t;
typedef short bf16x8 __attribute__((ext_vector_type(8)));
typedef float f32x4 __attribute__((ext_vector_type(4)));
typedef unsigned u32x4 __attribute__((ext_vector_type(4)));
constexpr int BM = 256, BK = 64, HALF = 128, HTB = HALF * BK * 2  , STAGE_BYTES = 8 * HTB, NXCD = 8, WGM = 8;

__host__ __device__ __forceinline__ int lds_byte(int r, int c) { const int st = (r >> 4) * 2 + (c >> 5), rr = r & 15, cc = c & 31, ob = rr * 64 + cc * 2; return st * 1024 + (ob ^ (((ob >> 9) & 1) << 5)); }
__host__ __device__ __forceinline__ void stage_rc(int b, int& R, int& C) { const int st = b / 1024, sb = b % 1024, swz = sb ^ (((sb >> 9) & 1) << 5); R = (st >> 1) * 16 + swz / 64; C = (st & 1) * 32 + (swz % 64) / 2; }
__host__ __device__ __forceinline__ int perm32(int rho) { const int n = rho >> 4, i = rho & 15; return 8 * (i >> 2) + 4 * n + (i & 3); }

struct Unit { int pm, pn, z; };
struct Gemm { const bf16_t* A; const bf16_t* Bt; int lda, ldb, K; };

__device__ __forceinline__ unsigned cvt_pk_bf16(float lo, float hi) { unsigned r; asm volatile("v_cvt_pk_bf16_f32 %0, %1, %2" : "=v"(r) : "v"(lo), "v"(hi)); return r; }

template <class Epi, class Sched, bool ALIGN_EPI = false, bool SP2 = false>
__device__ __forceinline__ void gemm_phase(PG8_LAS unsigned char* lds, const Gemm g, const Sched& S, const Epi& E, const int tid) {
    const int wid = __builtin_amdgcn_readfirstlane(tid >> 6), lane = tid & 63, wr = wid >> 2, wc = wid & 3, fr = lane & 15, fq = lane >> 4;
    const int K = g.K, nt = K / BK;
    unsigned voffA[2], voffB[2];
#pragma unroll
    for (int i = 0; i < 2; ++i) { int R, C; stage_rc(tid * 16 + i * 8192, R, C); const int Rb = Epi::PERM ? ((R & ~31) + perm32(R & 31)) : R;
        voffA[i] = (unsigned)(R * g.lda + C) * 2u; voffB[i] = (unsigned)(Rb * g.ldb + C) * 2u; }
    const size_t kstep = (size_t)(BK * 2);
    const size_t hstepA = (size_t)HALF * g.lda * 2, hstepB = (size_t)HALF * g.ldb * 2;
    const unsigned ldsw = (unsigned)wid * 1024u;
    const int aoff = lds_byte(wr * 64 + fr, fq * 8), boff = lds_byte(wc * 32 + fr, fq * 8);
#define PG8_SA(b, h) (((b) * 2 + (h)) * HTB)
#define PG8_SB(b, h) ((4 + (b) * 2 + (h)) * HTB)
#define PG8_STAGE(bufoff, gbase, voff) do { _Pragma("unroll") for (int _i = 0; _i < 2; ++_i) \
        __builtin_amdgcn_global_load_lds((const unsigned*)((const char*)(gbase) + (voff)[_i]), (PG8_LAS unsigned*)(lds + (bufoff) + ldsw + _i * 8192), 16, 0, 0); } while (0)
#define PG8_LDA(dst, b, h) do { _Pragma("unroll") for (int m = 0; m < 4; ++m) _Pragma("unroll") for (int k = 0; k < 2; ++k) dst[m][k] = *(const PG8_LAS bf16x8*)(lds + PG8_SA(b, h) + aoff + m * 2048 + k * 1024); } while (0)
#define PG8_LDB(dst, b, h) do { _Pragma("unroll") for (int n = 0; n < 2; ++n) _Pragma("unroll") for (int k = 0; k < 2; ++k) dst[n][k] = *(const PG8_LAS bf16x8*)(lds + PG8_SB(b, h) + boff + n * 2048 + k * 1024); } while (0)
#define PG8_MMA(ai, bj, At, Bt) do { __builtin_amdgcn_s_setprio(1); _Pragma("unroll") for (int m = 0; m < 4; ++m) _Pragma("unroll") for (int n = 0; n < 2; ++n) _Pragma("unroll") for (int k = 0; k < 2; ++k) \
        acc[ai][bj][m][n] = __builtin_amdgcn_mfma_f32_16x16x32_bf16(Bt[n][k], At[m][k], acc[ai][bj][m][n], 0, 0, 0); __builtin_amdgcn_s_setprio(0); } while (0)
#define PG8_WAIT_V(n) asm volatile("s_waitcnt vmcnt(" #n ")" ::: "memory")
#define PG8_WAIT_L(n) asm volatile("s_waitcnt lgkmcnt(" #n ")" ::: "memory")
#define PG8_BAR __builtin_amdgcn_s_barrier()
#define PG8_SCHED __builtin_amdgcn_sched_barrier(0)
    Unit cur, nxt; int ui = 0;
    if (!S.next(0, cur)) return;
    f32x4 acc[2][2][4][2];
#pragma unroll
    for (int a = 0; a < 2; ++a)
#pragma unroll
        for (int b = 0; b < 2; ++b)
#pragma unroll
            for (int m = 0; m < 4; ++m)
#pragma unroll
                for (int n = 0; n < 2; ++n) acc[a][b][m][n] = (f32x4){0.f, 0.f, 0.f, 0.f};
    bf16x8 At[4][2], B0[2][2], B1[2][2];
    const char* cA = (const char*)g.A + S.a_off(cur); const char* cB = (const char*)g.Bt + S.b_off(cur);
    S.a_ready(cur);
    if constexpr (SP2) {
        PG8_STAGE(PG8_SB(0, 0), cB, voffB); PG8_STAGE(PG8_SB(0, 1), cB + hstepB, voffB); PG8_STAGE(PG8_SA(0, 0), cA, voffA); PG8_STAGE(PG8_SA(0, 1), cA + hstepA, voffA);
        if (wr == 1) PG8_BAR;
        PG8_WAIT_V(2); PG8_BAR;
        PG8_STAGE(PG8_SB(1, 0), cB + kstep, voffB); PG8_STAGE(PG8_SA(1, 0), cA + kstep, voffA); PG8_STAGE(PG8_SB(1, 1), cB + hstepB + kstep, voffB);
        PG8_WAIT_V(6); PG8_BAR;
    } else {
        PG8_STAGE(PG8_SB(0, 0), cB, voffB); PG8_STAGE(PG8_SA(0, 0), cA, voffA); PG8_STAGE(PG8_SB(0, 1), cB + hstepB, voffB); PG8_STAGE(PG8_SA(0, 1), cA + hstepA, voffA);
        if (wr == 1) PG8_BAR;
        PG8_WAIT_V(4); PG8_BAR;
        PG8_STAGE(PG8_SB(1, 0), cB + kstep, voffB); PG8_STAGE(PG8_SA(1, 0), cA + kstep, voffA); PG8_STAGE(PG8_SB(1, 1), cB + hstepB + kstep, voffB);
        PG8_WAIT_V(6); PG8_BAR;
    }
    for (;;) {
        const bool has_next = S.next(ui + 1, nxt);
        const char* nA = has_next ? (const char*)g.A + S.a_off(nxt) : cA; const char* nB = has_next ? (const char*)g.Bt + S.b_off(nxt) : cB;
        for (int t = 0; t < nt; t += 2) {
            const bool last = (t == nt - 2);
            const char* a1 = cA + (size_t)(t + 1) * kstep;
            const char* a2 = last ? nA : cA + (size_t)(t + 2) * kstep; const char* b2 = last ? nB : cB + (size_t)(t + 2) * kstep;
            const char* a3 = a2 + kstep; const char* b3 = b2 + kstep;
            if (last && has_next) S.a_ready(nxt);
            if constexpr (SP2) {
            PG8_LDB(B0, 0, 0); PG8_LDB(B1, 0, 1); PG8_SCHED; PG8_LDA(At, 0, 0); PG8_STAGE(PG8_SA(1, 1), a1 + hstepA, voffA);
            PG8_WAIT_V(8); PG8_WAIT_L(0); PG8_BAR; PG8_MMA(0, 0, At, B0); PG8_MMA(0, 1, At, B1); PG8_BAR; PG8_SCHED;
            PG8_LDA(At, 0, 1); PG8_STAGE(PG8_SB(0, 0), b2, voffB); PG8_STAGE(PG8_SB(0, 1), b2 + hstepB, voffB); PG8_STAGE(PG8_SA(0, 0), a2, voffA);
            PG8_WAIT_V(8); PG8_WAIT_L(0); PG8_BAR; PG8_MMA(1, 0, At, B0); PG8_MMA(1, 1, At, B1); PG8_BAR; PG8_SCHED;
            PG8_LDB(B0, 1, 0); PG8_LDB(B1, 1, 1); PG8_SCHED; PG8_LDA(At, 1, 0); PG8_STAGE(PG8_SA(0, 1), a2 + hstepA, voffA);
            PG8_WAIT_V(8); PG8_WAIT_L(0); PG8_BAR; PG8_MMA(0, 0, At, B0); PG8_MMA(0, 1, At, B1); PG8_BAR; PG8_SCHED;
            PG8_LDA(At, 1, 1); PG8_STAGE(PG8_SB(1, 0), b3, voffB); PG8_STAGE(PG8_SB(1, 1), b3 + hstepB, voffB); PG8_STAGE(PG8_SA(1, 0), a3, voffA);
            PG8_WAIT_V(8); PG8_WAIT_L(0); PG8_BAR; PG8_MMA(1, 0, At, B0); PG8_MMA(1, 1, At, B1); PG8_BAR; PG8_SCHED;
            } else {
            PG8_LDB(B0, 0, 0); PG8_SCHED; PG8_LDA(At, 0, 0); PG8_STAGE(PG8_SA(1, 1), a1 + hstepA, voffA);
            PG8_WAIT_L(8); PG8_BAR; PG8_WAIT_L(0); PG8_MMA(0, 0, At, B0); PG8_BAR; PG8_SCHED;
            PG8_LDB(B1, 0, 1); PG8_STAGE(PG8_SB(0, 0), b2, voffB);
            PG8_BAR; PG8_WAIT_L(0); PG8_MMA(0, 1, At, B1); PG8_BAR;
            PG8_LDA(At, 0, 1); PG8_STAGE(PG8_SA(0, 0), a2, voffA);
            PG8_BAR; PG8_WAIT_L(0); PG8_MMA(1, 0, At, B0); PG8_BAR; PG8_SCHED;
            PG8_STAGE(PG8_SB(0, 1), b2 + hstepB, voffB);
            PG8_WAIT_V(6); PG8_BAR; PG8_MMA(1, 1, At, B1); PG8_BAR;
            PG8_LDB(B0, 1, 0); PG8_SCHED; PG8_LDA(At, 1, 0); PG8_STAGE(PG8_SA(0, 1), a2 + hstepA, voffA);
            PG8_WAIT_L(8); PG8_BAR; PG8_WAIT_L(0); PG8_MMA(0, 0, At, B0); PG8_BAR; PG8_SCHED;
            PG8_LDB(B1, 1, 1); PG8_STAGE(PG8_SB(1, 0), b3, voffB);
            PG8_BAR; PG8_WAIT_L(0); PG8_MMA(0, 1, At, B1); PG8_BAR;
            PG8_LDA(At, 1, 1); PG8_STAGE(PG8_SA(1, 0), a3, voffA);
            PG8_BAR; PG8_WAIT_L(0); PG8_MMA(1, 0, At, B0); PG8_BAR; PG8_SCHED;
            PG8_STAGE(PG8_SB(1, 1), b3 + hstepB, voffB);
            PG8_WAIT_V(6); PG8_BAR; PG8_MMA(1, 1, At, B1); PG8_BAR;
            }
        }
        if constexpr (ALIGN_EPI) { if (wr == 0) PG8_BAR; }
        if constexpr (!Epi::AFTER_DRAIN) { E(acc, cur, wr, wc, fr, fq); S.done(cur); }
        if (!has_next) break;
#pragma unroll
        for (int a = 0; a < 2; ++a)
#pragma unroll
            for (int b = 0; b < 2; ++b)
#pragma unroll
                for (int m = 0; m < 4; ++m)
#pragma unroll
                    for (int n = 0; n < 2; ++n) acc[a][b][m][n] = (f32x4){0.f, 0.f, 0.f, 0.f};
        cur = nxt; cA = nA; cB = nB; ++ui;
        if constexpr (ALIGN_EPI) { if (wr == 1) PG8_BAR; }
    }
    PG8_WAIT_V(0);
    if constexpr (!ALIGN_EPI) { if (wr == 0) PG8_BAR; }
    PG8_BAR;
    if constexpr (Epi::AFTER_DRAIN) { E.fused(acc, cur, wr, wc, fr, fq, lds, wid, lane); S.done(cur); }
#undef PG8_SA
#undef PG8_SB
#undef PG8_STAGE
#undef PG8_LDA
#undef PG8_LDB
#undef PG8_MMA
#undef PG8_WAIT_V
#undef PG8_WAIT_L
#undef PG8_BAR
#undef PG8_SCHED
}
}

#ifndef PG8_SP2
#define PG8_SP2 true
#endif
#ifndef PG8_ALIGN
#define PG8_ALIGN true
#endif

using pg8::bf16_t; using pg8::bf16x8; using pg8::f32x4; using pg8::u32x4;
typedef float f32x16 __attribute__((ext_vector_type(16)));
typedef unsigned u32x2 __attribute__((ext_vector_type(2)));
#define LAS __attribute__((address_space(3)))

constexpr int M = 16384, S = 8192, D = 1024, NIN = 14352;
constexpr size_t PLANE = (size_t)M * D * 2;
constexpr float EPS = 1e-6f, LOG2E = 1.4426950408889634f;
constexpr size_t MiB = 1048576;
constexpr size_t OFF_WT1 = 12 * PLANE, OFF_WT1B = OFF_WT1 + 18 * MiB, OFF_WT2 = OFF_WT1B + 10 * MiB, OFF_WT3 = OFF_WT2 + 6 * MiB,
    OFF_HALO = OFF_WT3 + 2 * MiB, OFF_GATES = OFF_HALO + 3 * MiB, OFF_A2 = OFF_GATES + MiB, OFF_M2 = OFF_A2 + 262144, OFF_EM = OFF_M2 + 262144,
    OFF_WK = OFF_EM + 262144, OFF_F2 = OFF_WK + 262144, OFF_MP2 = OFF_F2 + 524288, OFF_NST = OFF_MP2 + 4096, OFF_KN2 = OFF_NST + 65536, OFF_QCTR = OFF_KN2 + 256, OFF_END = OFF_QCTR + 256;
constexpr size_t OFF_CST = OFF_WT1;
constexpr int LDS_BYTES = 143360;
constexpr int NPH = 21;
#ifndef ATTNMASK
#define ATTNMASK 3
#endif
#ifndef PROBE_RPT
#define PROBE_RPT 0
#endif
#ifndef PHMASK
#define PHMASK 0x7ff
#endif

struct Args { const float* in[13]; float* out; unsigned char* ws; int ph_lo, ph_hi, dry, pad; };

__device__ __forceinline__ float bf2f(unsigned b) { return __uint_as_float(b << 16); }
__device__ __forceinline__ float bflo(unsigned w) { return __uint_as_float(w << 16); }
__device__ __forceinline__ float bfhi(unsigned w) { return __uint_as_float(w & 0xffff0000u); }
__device__ __forceinline__ unsigned pk2(float lo, float hi) { return pg8::cvt_pk_bf16(lo, hi); }
__device__ __forceinline__ float wave_sum(float v) {
#pragma unroll
    for (int o = 32; o; o >>= 1) v += __shfl_xor(v, o);
    return v; }
__device__ __forceinline__ float sigm(float x) { return 1.f / (1.f + __expf(-x)); }
__device__ __forceinline__ float silu(float x) { return x / (1.f + __expf(-x)); }
__device__ __forceinline__ float logsig(float x) { return fminf(x, 0.f) - log1pf(expf(-fabsf(x))); }
__device__ __forceinline__ int crow(int r, int hi) { return (r & 3) + 8 * (r >> 2) + 4 * hi; }

struct SchedStd {
    int nM, nN, nwg, G, c, lda, ldb;
    __device__ void init(int nM_, int nN_, int G_, int c_, int lda_, int ldb_) { nM = nM_; nN = nN_; nwg = nM * nN; G = G_; c = c_; lda = lda_; ldb = ldb_; }
    __device__ bool next(int i, pg8::Unit& u) const {
        const long L = (long)i * G + c; if (L >= nwg) return false;
        int wgid = (int)L; { const int q = nwg / 8, r = nwg % 8, xcd = wgid % 8, off = wgid / 8; wgid = (xcd < r ? xcd * (q + 1) : r * (q + 1) + (xcd - r) * q) + off; }
        const int nig = 8 * nN, gid = wgid / nig, fm = gid * 8, gsz = (nM - fm) < 8 ? (nM - fm) : 8;
        u.pm = fm + ((wgid % nig) % gsz); u.pn = (wgid % nig) / gsz; u.z = 0; return true;
    }
    __device__ __forceinline__ size_t a_off(const pg8::Unit& u) const { return (size_t)u.pm * 256 * lda * 2; }
    __device__ __forceinline__ size_t b_off(const pg8::Unit& u) const { return (size_t)u.pn * 256 * ldb * 2; }
    __device__ __forceinline__ void a_ready(const pg8::Unit&) const {}
    __device__ __forceinline__ void done(const pg8::Unit&) const {}
};
struct SchedG2 {
    int G, c;
    __device__ bool next(int i, pg8::Unit& u) const {
        const int t = (i / 3) * G + c; if (t >= 256) return false;
        u.pm = t >> 2; u.pn = t & 3; u.z = i % 3; return true;
    }
    __device__ __forceinline__ size_t a_off(const pg8::Unit& u) const { return (size_t)u.z * PLANE + (size_t)u.pm * 256 * 1024 * 2; }
    __device__ __forceinline__ size_t b_off(const pg8::Unit& u) const { return ((size_t)u.z * 1024 + (size_t)u.pn * 256) * 1024 * 2; }
    __device__ __forceinline__ void a_ready(const pg8::Unit&) const {}
    __device__ __forceinline__ void done(const pg8::Unit&) const {}
};
struct SchedA1 {
    int G, c;
    __device__ bool next(int i, pg8::Unit& u) const { const int L = i * G + c; if (L >= 128) return false; u.pm = 0; u.pn = 0; u.z = L; return true; }
    __device__ __forceinline__ size_t a_off(const pg8::Unit& u) const { const int bh = u.z >> 4, ch = u.z & 15; return ((size_t)((bh >> 2) * 1024 + (bh & 3) * 256) * 8192 + (size_t)ch * 512) * 2; }
    __device__ __forceinline__ size_t b_off(const pg8::Unit& u) const { return a_off(u); }
    __device__ __forceinline__ void a_ready(const pg8::Unit&) const {}
    __device__ __forceinline__ void done(const pg8::Unit&) const {}
};

struct EpiG1 {
    static constexpr bool PERM = true, AFTER_DRAIN = false;
    unsigned char* ws;
    __device__ __forceinline__ void operator()(const f32x4 (&acc)[2][2][4][2], const pg8::Unit& u, int wr, int wc, int fr, int fq) const {
        asm volatile("" : "+v"(fr), "+v"(fq));
        const int p9 = u.pn >> 2;
        const int dpl = (p9 < 2) ? p9 : p9 + 1;
        bf16_t* base = (bf16_t*)(ws + (size_t)dpl * PLANE);
        bf16_t* halo = (bf16_t*)(ws + OFF_HALO);
        const int cc0 = (u.pn & 3) * 256 + wc * 32 + 8 * fq;
        const int row0 = u.pm * 256 + wr * 64 + fr;
        const bool transposed = (p9 == 4 || p9 == 8), hal = (p9 == 2 || p9 == 3);
        const float sc = (p9 == 6) ? (0.08838834764831845f * LOG2E) : 1.f;
#pragma unroll
        for (int ai = 0; ai < 2; ++ai)
#pragma unroll
            for (int m = 0; m < 4; ++m) {
                const int r = row0 + ai * 128 + m * 16;
#pragma unroll
                for (int bj = 0; bj < 2; ++bj) {
                    const int c = cc0 + bj * 128;
                    const f32x4 v0 = acc[ai][bj][m][0] * sc, v1 = acc[ai][bj][m][1] * sc;
                    u32x4 w; w.x = pk2(v0[0], v0[1]); w.y = pk2(v0[2], v0[3]); w.z = pk2(v1[0], v1[1]); w.w = pk2(v1[2], v1[3]);
                    if (!transposed) {
                        *(u32x4*)(base + (size_t)r * 1024 + c) = w;
                        if (hal && m == 3 && fr >= 13) *(u32x4*)(halo + ((size_t)(r >> 6) * 3 + (fr - 13)) * 2048 + (p9 == 3 ? 1024 : 0) + c) = w;
                    } else {
                        const int b = r >> 13, t = r & 8191;
                        bf16_t* p = base + ((size_t)(b * 1024 + c)) * 8192 + t;
                        p[0] = (bf16_t)(w.x & 0xffff); p[8192] = (bf16_t)(w.x >> 16); p[2 * 8192] = (bf16_t)(w.y & 0xffff); p[3 * 8192] = (bf16_t)(w.y >> 16);
                        p[4 * 8192] = (bf16_t)(w.z & 0xffff); p[5 * 8192] = (bf16_t)(w.z >> 16); p[6 * 8192] = (bf16_t)(w.w & 0xffff); p[7 * 8192] = (bf16_t)(w.w >> 16);
                    }
                }
            }
    }
};
struct EpiPlain {
    static constexpr bool PERM = true, AFTER_DRAIN = false;
    bf16_t* base; int ldc; size_t zstride; int split;
    __device__ __forceinline__ void operator()(const f32x4 (&acc)[2][2][4][2], const pg8::Unit& u, int wr, int wc, int fr, int fq) const {
        asm volatile("" : "+v"(fr), "+v"(fq));
        bf16_t* bp = base + (size_t)u.z * zstride;
        int colt = u.pn * 256;
        if (split) { bp += (size_t)(u.pn >> 2) * (PLANE / 2); colt = (u.pn & 3) * 256; }
        const int cc0 = colt + wc * 32 + 8 * fq, row0 = u.pm * 256 + wr * 64 + fr;
#pragma unroll
        for (int ai = 0; ai < 2; ++ai)
#pragma unroll
            for (int m = 0; m < 4; ++m) {
                bf16_t* rowp = bp + (size_t)(row0 + ai * 128 + m * 16) * ldc + cc0;
#pragma unroll
                for (int bj = 0; bj < 2; ++bj) {
                    const f32x4 v0 = acc[ai][bj][m][0], v1 = acc[ai][bj][m][1];
                    u32x4 w; w.x = pk2(v0[0], v0[1]); w.y = pk2(v0[2], v0[3]); w.z = pk2(v1[0], v1[1]); w.w = pk2(v1[2], v1[3]);
                    *(u32x4*)(rowp + bj * 128) = w;
                }
            }
    }
};
struct EpiG2 {
    static constexpr bool PERM = true, AFTER_DRAIN = false;
    const bf16_t* gates; float* tmp; bf16_t* outp;
    __device__ __forceinline__ void operator()(const f32x4 (&acc)[2][2][4][2], const pg8::Unit& u, int wr, int wc, int fr, int fq) const {
        asm volatile("" : "+v"(fr), "+v"(fq));
        const bf16_t* gp = gates + (size_t)u.z * (PLANE / 2);
        const int cc0 = u.pn * 256 + wc * 32 + 8 * fq, row0 = u.pm * 256 + wr * 64 + fr;
#pragma unroll
        for (int ai = 0; ai < 2; ++ai)
#pragma unroll
            for (int m = 0; m < 4; ++m) {
                const size_t ro = (size_t)(row0 + ai * 128 + m * 16) * 1024 + cc0;
#pragma unroll
                for (int bj = 0; bj < 2; ++bj) {
                    const size_t o = ro + bj * 128;
                    const u32x4 g = *(const u32x4*)(gp + o);
                    f32x4 v0 = acc[ai][bj][m][0], v1 = acc[ai][bj][m][1];
                    v0[0] *= sigm(bflo(g.x)); v0[1] *= sigm(bfhi(g.x)); v0[2] *= sigm(bflo(g.y)); v0[3] *= sigm(bfhi(g.y));
                    v1[0] *= sigm(bflo(g.z)); v1[1] *= sigm(bfhi(g.z)); v1[2] *= sigm(bflo(g.w)); v1[3] *= sigm(bfhi(g.w));
                    if (u.z != 0) { v0 += *(const f32x4*)(tmp + o); v1 += *(const f32x4*)(tmp + o + 4); }
                    if (u.z != 2) { *(f32x4*)(tmp + o) = v0; *(f32x4*)(tmp + o + 4) = v1; }
                    else { u32x4 w; w.x = pk2(v0[0], v0[1]); w.y = pk2(v0[2], v0[3]); w.z = pk2(v1[0], v1[1]); w.w = pk2(v1[2], v1[3]); *(u32x4*)(outp + o) = w; }
                }
            }
    }
};
struct EpiG3 {
    static constexpr bool PERM = true, AFTER_DRAIN = false;
    const float* xin; float* out;
    __device__ __forceinline__ void operator()(const f32x4 (&acc)[2][2][4][2], const pg8::Unit& u, int wr, int wc, int fr, int fq) const {
        asm volatile("" : "+v"(fr), "+v"(fq));
        const int cc0 = u.pn * 256 + wc * 32 + 8 * fq, row0 = u.pm * 256 + wr * 64 + fr;
#pragma unroll
        for (int ai = 0; ai < 2; ++ai)
#pragma unroll
            for (int m = 0; m < 4; ++m) {
                const size_t ro = (size_t)(row0 + ai * 128 + m * 16) * 1024 + cc0;
#pragma unroll
                for (int bj = 0; bj < 2; ++bj) {
                    const size_t o = ro + bj * 128;
                    const f32x4 x0 = *(const f32x4*)(xin + o), x1 = *(const f32x4*)(xin + o + 4);
                    *(f32x4*)(out + o) = x0 + acc[ai][bj][m][0]; *(f32x4*)(out + o + 4) = x1 + acc[ai][bj][m][1];
                }
            }
    }
};

__device__ __forceinline__ int g1_srccol(int p) {
    switch (p) { case 0: return 4096; case 1: return 8200; case 2: return 0; case 3: return 1024; case 4: return 2048; case 5: return 3072; case 6: return 5128; case 7: return 6152; default: return 7176; } }

__device__ __forceinline__ void transpose_tile(const float* __restrict__ src, int pitch, bf16_t* __restrict__ dst, LAS float* scr, int tid) {
#pragma unroll
    for (int i = 0; i < 2; ++i) { const int r = (tid >> 4) + 32 * i, c4 = tid & 15; const f32x4 v = *(const f32x4*)(src + (size_t)r * pitch + c4 * 4);
        scr[r * 65 + c4 * 4 + 0] = v[0]; scr[r * 65 + c4 * 4 + 1] = v[1]; scr[r * 65 + c4 * 4 + 2] = v[2]; scr[r * 65 + c4 * 4 + 3] = v[3]; }
    __syncthreads();
    { const int n = tid >> 3, kc = tid & 7; float v[8];
#pragma unroll
      for (int j = 0; j < 8; ++j) v[j] = scr[(kc * 8 + j) * 65 + n];
      u32x4 w; w.x = pk2(v[0], v[1]); w.y = pk2(v[2], v[3]); w.z = pk2(v[4], v[5]); w.w = pk2(v[6], v[7]);
      *(u32x4*)(dst + (size_t)n * 1024 + kc * 8) = w; }
    __syncthreads();
}

__device__ __forceinline__ void phase_prep(const Args& a, int l, LAS unsigned char* lds, int tid) {
    unsigned char* ws = a.ws;
    const float* w_in = a.in[2] + (size_t)l * D * NIN;
    const float* w_br = a.in[10] + (size_t)l * 3 * D * D;
    const float* w_out = a.in[11] + (size_t)l * D * D;
    const float* pool_w = a.in[8] + (size_t)l * 4 * 256 * 256;
    const float* pool_s = a.in[9] + (size_t)l * D;
    LAS float* scr = (LAS float*)lds;
    for (int base = blockIdx.x * 4; base < 17 * 256; base += gridDim.x * 4) {
        f32x4 tv[4][2];
#pragma unroll
        for (int q = 0; q < 4; ++q) {
            const int it = base + q, id = it >> 8, nt = (it & 255) >> 4, kt = it & 15;
            const float* src; int pitch;
            if (id < 9)       { src = w_in + (size_t)(kt * 64) * NIN + g1_srccol(id) + nt * 64; pitch = NIN; }
            else if (id < 13) { const int qq = id - 9; const int col = (qq == 0) ? 10256 : 11280 + (qq - 1) * 1024; src = w_in + (size_t)(kt * 64) * NIN + col + nt * 64; pitch = NIN; }
            else if (id < 16) { const int n = id - 13; src = w_br + (size_t)n * D * D + (size_t)(kt * 64) * D + nt * 64; pitch = D; }
            else              { src = w_out + (size_t)(kt * 64) * D + nt * 64; pitch = D; }
#pragma unroll
            for (int i = 0; i < 2; ++i) { const int r = (tid >> 4) + 32 * i, c4 = tid & 15; tv[q][i] = *(const f32x4*)(src + (size_t)r * pitch + c4 * 4); }
        }
#pragma unroll
        for (int q = 0; q < 4; ++q)
#pragma unroll
            for (int i = 0; i < 2; ++i) { const int r = (tid >> 4) + 32 * i, c4 = tid & 15; LAS float* d = scr + q * 4160 + r * 65 + c4 * 4; d[0] = tv[q][i][0]; d[1] = tv[q][i][1]; d[2] = tv[q][i][2]; d[3] = tv[q][i][3]; }
        __syncthreads();
#pragma unroll
        for (int q = 0; q < 4; ++q) {
            const int it = base + q, id = it >> 8, nt = (it & 255) >> 4, kt = it & 15;
            bf16_t* dst;
            if (id < 9)       dst = (bf16_t*)(ws + OFF_WT1) + (size_t)(id * 1024 + nt * 64) * 1024 + kt * 64;
            else if (id < 13) { const int qq = id - 9; const int prow = (qq == 0) ? 0 : qq + 1; dst = (bf16_t*)(ws + OFF_WT1B) + (size_t)(prow * 1024 + nt * 64) * 1024 + kt * 64; }
            else if (id < 16) { const int n = id - 13; dst = (bf16_t*)(ws + OFF_WT2) + (size_t)(n * 1024 + nt * 64) * 1024 + kt * 64; }
            else              dst = (bf16_t*)(ws + OFF_WT3) + (size_t)(nt * 64) * 1024 + kt * 64;
            const int n = tid >> 3, kc = tid & 7; float v[8];
#pragma unroll
            for (int j = 0; j < 8; ++j) v[j] = scr[q * 4160 + (kc * 8 + j) * 65 + n];
            u32x4 w; w.x = pk2(v[0], v[1]); w.y = pk2(v[2], v[3]); w.z = pk2(v[4], v[5]); w.w = pk2(v[6], v[7]);
            *(u32x4*)(dst + (size_t)n * 1024 + kc * 8) = w;
        }
        __syncthreads();
    }
    for (int it = blockIdx.x; it < 256; it += gridDim.x) {
        const int g = it >> 6, kt = (it & 63) >> 2, dt = it & 3;
        LAS float* As = scr; LAS float* Bs = scr + 64 * 65;
        float acc[8];
#pragma unroll
        for (int j = 0; j < 8; ++j) acc[j] = 0.f;
        for (int cc = 0; cc < 4; ++cc) {
#pragma unroll
            for (int i = 0; i < 2; ++i) { const int r = (tid >> 4) + 32 * i, c4 = tid & 15;
                const f32x4 va = *(const f32x4*)(w_in + (size_t)(kt * 64 + r) * NIN + 9232 + g * 256 + cc * 64 + c4 * 4);
                As[r * 65 + c4 * 4 + 0] = va[0]; As[r * 65 + c4 * 4 + 1] = va[1]; As[r * 65 + c4 * 4 + 2] = va[2]; As[r * 65 + c4 * 4 + 3] = va[3];
                const f32x4 vb = *(const f32x4*)(pool_w + (size_t)(g * 256 + cc * 64 + r) * 256 + dt * 64 + c4 * 4);
                Bs[r * 64 + c4 * 4 + 0] = vb[0]; Bs[r * 64 + c4 * 4 + 1] = vb[1]; Bs[r * 64 + c4 * 4 + 2] = vb[2]; Bs[r * 64 + c4 * 4 + 3] = vb[3]; }
            __syncthreads();
            const int d = tid & 63, kg = tid >> 6;
            for (int c = 0; c < 64; ++c) { const float bv = Bs[c * 64 + d];
#pragma unroll
                for (int j = 0; j < 8; ++j) acc[j] += As[(kg * 8 + j) * 65 + c] * bv; }
            __syncthreads();
        }
        const int d = tid & 63, kg = tid >> 6;
        const float sc = pool_s[g * 256 + dt * 64 + d];
        u32x4 w; w.x = pk2(acc[0] * sc, acc[1] * sc); w.y = pk2(acc[2] * sc, acc[3] * sc); w.z = pk2(acc[4] * sc, acc[5] * sc); w.w = pk2(acc[6] * sc, acc[7] * sc);
        *(u32x4*)((bf16_t*)(ws + OFF_WT1B) + (size_t)(1024 + g * 256 + dt * 64 + d) * 1024 + kt * 64 + kg * 8) = w;
    }
    if (blockIdx.x == 0 && tid < 16) { ((unsigned*)(ws + OFF_KN2))[tid] = 0u; ((unsigned*)(ws + OFF_QCTR))[tid] = 0u; }
    LAS float* gw = (LAS float*)lds;
    __syncthreads();
    for (int e = tid; e < 16 * 1024; e += 512) { const int c = e & 15, k = e >> 4; const int col = (c < 8) ? 5120 + c : 9224 + (c - 8); gw[c * 1024 + k] = w_in[(size_t)k * NIN + col]; }
    __syncthreads();
    {
        const float* xin = (l == 0) ? a.in[0] : a.out;
        const float* ng = a.in[1] + (size_t)l * D;
        bf16_t* hb = (bf16_t*)(ws + 10 * PLANE);
        float* gates = (float*)(ws + OFF_GATES);
        const int wid = tid >> 6, lane = tid & 63;
        f32x4 gg[4];
#pragma unroll
        for (int j = 0; j < 4; ++j) gg[j] = *(const f32x4*)(ng + j * 256 + lane * 4);
        for (int row0 = blockIdx.x * 8 + wid; row0 < M; row0 += gridDim.x * 16) {
            const int row1 = row0 + gridDim.x * 8;
            f32x4 xa[2][4];
#pragma unroll
            for (int j = 0; j < 4; ++j) { xa[0][j] = *(const f32x4*)(xin + (size_t)row0 * D + j * 256 + lane * 4); xa[1][j] = (row1 < M) ? *(const f32x4*)(xin + (size_t)row1 * D + j * 256 + lane * 4) : (f32x4){0.f, 0.f, 0.f, 0.f}; }
#pragma unroll
            for (int rr = 0; rr < 2; ++rr) {
                const int row = rr ? row1 : row0;
                if (row >= M) continue;
                f32x4 xv[4]; float ss = 0.f;
#pragma unroll
                for (int j = 0; j < 4; ++j) { xv[j] = xa[rr][j]; ss += xv[j][0] * xv[j][0] + xv[j][1] * xv[j][1] + xv[j][2] * xv[j][2] + xv[j][3] * xv[j][3]; }
                ss = wave_sum(ss);
                const float r = rsqrtf(ss * (1.f / 1024.f) + EPS);
#pragma unroll
                for (int j = 0; j < 4; ++j) { xv[j] = (xv[j] * r) * gg[j]; u32x2 w; w.x = pk2(xv[j][0], xv[j][1]); w.y = pk2(xv[j][2], xv[j][3]); *(u32x2*)(hb + (size_t)row * D + j * 256 + lane * 4) = w; }
                float ga[16];
#pragma unroll
                for (int c = 0; c < 16; ++c) { float s = 0.f;
#pragma unroll
                    for (int j = 0; j < 4; ++j) { const f32x4 wv = *(const LAS f32x4*)(gw + c * 1024 + j * 256 + lane * 4); s += xv[j][0] * wv[0] + xv[j][1] * wv[1] + xv[j][2] * wv[2] + xv[j][3] * wv[3]; }
                    ga[c] = s; }
                float b8[8], b4[4], b2[2], b1;
#pragma unroll
                for (int i = 0; i < 8; ++i) { const bool hi_ = (lane & 32) != 0; const float send = hi_ ? ga[i] : ga[i + 8], keep = hi_ ? ga[i + 8] : ga[i]; b8[i] = keep + __shfl_xor(send, 32); }
#pragma unroll
                for (int i = 0; i < 4; ++i) { const bool hi_ = (lane & 16) != 0; const float send = hi_ ? b8[i] : b8[i + 4], keep = hi_ ? b8[i + 4] : b8[i]; b4[i] = keep + __shfl_xor(send, 16); }
#pragma unroll
                for (int i = 0; i < 2; ++i) { const bool hi_ = (lane & 8) != 0; const float send = hi_ ? b4[i] : b4[i + 2], keep = hi_ ? b4[i + 2] : b4[i]; b2[i] = keep + __shfl_xor(send, 8); }
                { const bool hi_ = (lane & 4) != 0; const float send = hi_ ? b2[0] : b2[1], keep = hi_ ? b2[1] : b2[0]; b1 = keep + __shfl_xor(send, 4); }
                b1 += __shfl_xor(b1, 2); b1 += __shfl_xor(b1, 1);
                if ((lane & 3) == 0) gates[(size_t)row * 16 + ((lane >> 2) & 15)] = b1;
            }
        }
    }
    __syncthreads();
}

__device__ __forceinline__ float block_excl_scan_add(float tot, LAS float* sm, int tid) {
    const int lane = tid & 63, wid = tid >> 6; float x = tot;
#pragma unroll
    for (int o = 1; o < 64; o <<= 1) { const float v = __shfl_up(x, o); if (lane >= o) x += v; }
    __syncthreads();
    if (lane == 63) sm[wid] = x;
    __syncthreads();
    float base = 0.f;
    for (int w = 0; w < wid; ++w) base += sm[w];
    return base + x - tot;
}
__device__ __forceinline__ float block_excl_scan_max(float tot, LAS float* sm, int tid) {
    const int lane = tid & 63, wid = tid >> 6; float x = tot;
#pragma unroll
    for (int o = 1; o < 64; o <<= 1) { const float v = __shfl_up(x, o); if (lane >= o) x = fmaxf(x, v); }
    __syncthreads();
    if (lane == 63) sm[wid] = x;
    __syncthreads();
    float base = -INFINITY;
    for (int w = 0; w < wid; ++w) base = fmaxf(base, sm[w]);
    const float prev = __shfl_up(x, 1);
    return fmaxf(base, lane ? prev : -INFINITY);
}
__device__ __forceinline__ void phase_scans(const Args& a, int l, LAS unsigned char* lds, int tid) {
    unsigned char* ws = a.ws; const float* gates = (const float*)(ws + OFF_GATES);
    LAS float* sm = (LAS float*)lds;
    LAS float* Fs = sm + 64; LAS float* As = Fs + 8192; LAS float* Ms = As + 8192;
    const int bx = blockIdx.x;
    if (bx < 8) {
        const int b = bx >> 2, h = bx & 3; const float bi = a.in[4][l * 4 + h], bfv = a.in[5][l * 4 + h];
        float run = 0.f;
#pragma unroll 2
        for (int i = 0; i < 16; ++i) { const size_t row = (size_t)b * S + tid * 16 + i; run += logsig(gates[row * 16 + 4 + h] + bfv); Fs[tid * 16 + i] = run; }
        const float pre = block_excl_scan_add(run, sm, tid);
        float mx = -INFINITY;
#pragma unroll 2
        for (int i = 0; i < 16; ++i) { const size_t row = (size_t)b * S + tid * 16 + i; const float F = Fs[tid * 16 + i] + pre; const float av = gates[row * 16 + h] + bi - F;
            Fs[tid * 16 + i] = F; As[tid * 16 + i] = av; mx = fmaxf(mx, av); }
        const float pm = block_excl_scan_max(mx, sm + 16, tid);
        float Mrun = fmaxf(pm, 0.f);
#pragma unroll 2
        for (int i = 0; i < 16; ++i) { Mrun = fmaxf(Mrun, As[tid * 16 + i]); Ms[tid * 16 + i] = Mrun; }
        __syncthreads();
        if ((tid & 31) == 31) sm[32 + (tid >> 5)] = Mrun;
        __syncthreads();
        const float Mend = sm[32 + (tid >> 5)];
        float* A2 = (float*)(ws + OFF_A2) + (size_t)bx * S + tid * 16; float* M2 = (float*)(ws + OFF_M2) + (size_t)bx * S + tid * 16;
        float* EM = (float*)(ws + OFF_EM) + (size_t)bx * S + tid * 16; float* WK = (float*)(ws + OFF_WK) + (size_t)bx * S + tid * 16;
#pragma unroll 2
        for (int i = 0; i < 16; ++i) { const float av = As[tid * 16 + i], Mv = Ms[tid * 16 + i], F = Fs[tid * 16 + i];
            A2[i] = av * LOG2E; M2[i] = Mv * LOG2E; EM[i] = expf(-(F + Mv)); WK[i] = expf(av - Mend); }
        float* MP = (float*)(ws + OFF_MP2) + bx * 32;
        if (tid == 0) MP[0] = 0.f;
        if (tid < 16) MP[tid + 1] = sm[32 + tid] * LOG2E;
        __syncthreads();
    } else if (bx < 24) {
        const int bh = bx - 8, b = bh >> 3, h = bh & 7; const float bfv = a.in[7][l * 8 + h];
        float run = 0.f;
#pragma unroll 2
        for (int i = 0; i < 16; ++i) { const size_t row = (size_t)b * S + tid * 16 + i; run += logsig(gates[row * 16 + 8 + h] + bfv); Fs[tid * 16 + i] = run; }
        const float pre = block_excl_scan_add(run, sm, tid);
        float* F2 = (float*)(ws + OFF_F2) + (size_t)bh * S + tid * 16;
#pragma unroll 2
        for (int i = 0; i < 16; ++i) F2[i] = (Fs[tid * 16 + i] + pre) * LOG2E;
        __syncthreads();
    }
}

__device__ __forceinline__ void phase_conv(const Args& a, int l, LAS unsigned char* lds, int tid) {
    unsigned char* ws = a.ws;
    const float* cw = a.in[3] + (size_t)l * 4 * 2048;
    const bf16_t* halo = (const bf16_t*)(ws + OFF_HALO);
    const float* WK = (const float*)(ws + OFF_WK);
    LAS float* raw = (LAS float*)lds;
    LAS float* tb = raw + 67 * 65 + 3;
    const int r = tid >> 3, c8 = (tid & 7) * 8;
    u32x4 pv = (u32x4){0u, 0u, 0u, 0u}, ph = (u32x4){0u, 0u, 0u, 0u};
    auto issue = [&](int it) {
        const int tt = it >> 5, cs = it & 31;
        const bf16_t* pl = (const bf16_t*)(ws + (size_t)((cs >= 16) ? 4 : 3) * PLANE);
        pv = *(const u32x4*)(pl + (size_t)(tt * 64 + r) * 1024 + (cs & 15) * 64 + c8);
        if (tid < 24 && (tt & 127) != 0) ph = *(const u32x4*)(halo + ((size_t)(tt - 1) * 3 + (tid >> 3)) * 2048 + cs * 64 + c8);
        else ph = (u32x4){0u, 0u, 0u, 0u};
    };
    if (blockIdx.x < 256 * 32) issue(blockIdx.x);
    for (int it = blockIdx.x; it < 256 * 32; it += gridDim.x) {
        const int tt = it >> 5, cs = it & 31;
        const bool isk = cs >= 16;
        bf16_t* pl = (bf16_t*)(ws + (size_t)(isk ? 4 : 3) * PLANE);
        const int c0 = (cs & 15) * 64;
        { const u32x4 v = pv; LAS float* d = raw + (r + 3) * 65 + c8;
          d[0] = bflo(v.x); d[1] = bfhi(v.x); d[2] = bflo(v.y); d[3] = bfhi(v.y); d[4] = bflo(v.z); d[5] = bfhi(v.z); d[6] = bflo(v.w); d[7] = bfhi(v.w); }
        if (tid < 24) { const u32x4 v = ph; LAS float* d = raw + (tid >> 3) * 65 + c8;
            d[0] = bflo(v.x); d[1] = bfhi(v.x); d[2] = bflo(v.y); d[3] = bfhi(v.y); d[4] = bflo(v.z); d[5] = bfhi(v.z); d[6] = bflo(v.w); d[7] = bfhi(v.w); }
        __syncthreads();
        if (it + (int)gridDim.x < 256 * 32) issue(it + gridDim.x);
        float o[8];
        { const int gc = cs * 64 + c8;
#pragma unroll
          for (int j = 0; j < 8; ++j) { float s = 0.f;
#pragma unroll
              for (int kk = 0; kk < 4; ++kk) s += cw[kk * 2048 + gc + j] * raw[(r + kk) * 65 + c8 + j];
              o[j] = silu(s); } }
        if (!isk) {
#pragma unroll
            for (int j = 0; j < 8; ++j) o[j] *= 0.0625f;
        }
        { u32x4 w; w.x = pk2(o[0], o[1]); w.y = pk2(o[2], o[3]); w.z = pk2(o[4], o[5]); w.w = pk2(o[6], o[7]);
          *(u32x4*)(pl + (size_t)(tt * 64 + r) * 1024 + c0 + c8) = w; }
        if (isk) {
            const int b = tt >> 7, t0 = (tt & 127) * 64, hh = c0 >> 8;
            const float wk = WK[(size_t)(b * 4 + hh) * S + t0 + r];
#pragma unroll
            for (int j = 0; j < 8; ++j) tb[(c8 + j) * 65 + r] = o[j] * wk;
            __syncthreads();
            const int c = tid >> 3, t8 = (tid & 7) * 8;
            float v[8];
#pragma unroll
            for (int j = 0; j < 8; ++j) v[j] = tb[c * 65 + t8 + j];
            u32x4 w; w.x = pk2(v[0], v[1]); w.y = pk2(v[2], v[3]); w.z = pk2(v[4], v[5]); w.w = pk2(v[6], v[7]);
            *(u32x4*)((bf16_t*)(ws + 11 * PLANE) + (size_t)(b * 1024 + c0 + c) * 8192 + t0 + t8) = w;
        }
        __syncthreads();
    }
    {
        LAS unsigned* smx = (LAS unsigned*)lds;
        if (tid < 16) smx[tid] = 0u;
        __syncthreads();
        const int wid = tid >> 6, lane = tid & 63;
        const bf16_t* bk = (const bf16_t*)(ws + 8 * PLANE);
        float m0 = 0.f, m1 = 0.f;
        for (int rowb_ = blockIdx.x * 8 + wid; rowb_ < M; rowb_ += gridDim.x * 32) {
          u32x4 kv[4][2];
#pragma unroll
          for (int u = 0; u < 4; ++u) { const int row = rowb_ + u * gridDim.x * 8; if (row < M) { kv[u][0] = *(const u32x4*)(bk + (size_t)row * 1024 + lane * 16); kv[u][1] = *(const u32x4*)(bk + (size_t)row * 1024 + lane * 16 + 8); } else { kv[u][0] = (u32x4){0u,0u,0u,0u}; kv[u][1] = (u32x4){0u,0u,0u,0u}; } }
#pragma unroll
          for (int u = 0; u < 4; ++u) {
            const int row = rowb_ + u * gridDim.x * 8; if (row >= M) continue;
            const u32x4 v0 = kv[u][0], v1 = kv[u][1];
            float s = bflo(v0.x) * bflo(v0.x) + bfhi(v0.x) * bfhi(v0.x) + bflo(v0.y) * bflo(v0.y) + bfhi(v0.y) * bfhi(v0.y) + bflo(v0.z) * bflo(v0.z) + bfhi(v0.z) * bfhi(v0.z) + bflo(v0.w) * bflo(v0.w) + bfhi(v0.w) * bfhi(v0.w)
                    + bflo(v1.x) * bflo(v1.x) + bfhi(v1.x) * bfhi(v1.x) + bflo(v1.y) * bflo(v1.y) + bfhi(v1.y) * bfhi(v1.y) + bflo(v1.z) * bflo(v1.z) + bfhi(v1.z) * bfhi(v1.z) + bflo(v1.w) * bflo(v1.w) + bfhi(v1.w) * bfhi(v1.w);
            s += __shfl_xor(s, 1); s += __shfl_xor(s, 2); s += __shfl_xor(s, 4);
            if (row < S) m0 = fmaxf(m0, s); else m1 = fmaxf(m1, s);
          }
        }
        if ((lane & 7) == 0) { __hip_atomic_fetch_max((unsigned*)(smx + (lane >> 3)), __float_as_uint(m0), __ATOMIC_RELAXED, __HIP_MEMORY_SCOPE_WORKGROUP); __hip_atomic_fetch_max((unsigned*)(smx + 8 + (lane >> 3)), __float_as_uint(m1), __ATOMIC_RELAXED, __HIP_MEMORY_SCOPE_WORKGROUP); }
        __syncthreads();
        if (tid < 16) __hip_atomic_fetch_max((unsigned*)(ws + OFF_KN2) + tid, smx[tid], __ATOMIC_RELAXED, __HIP_MEMORY_SCOPE_AGENT);
        __syncthreads();
    }
}

__device__ __forceinline__ void phase_statescan(const Args& a, int tid) {
    unsigned char* ws = a.ws;
    const float* MP = (const float*)(ws + OFF_MP2);
    bf16_t* Cst = (bf16_t*)(ws + OFF_CST);
    for (int grp = blockIdx.x * 512 + tid; grp < 8 * 16384; grp += gridDim.x * 512) {
        const int bh = grp >> 14, e = (grp & 16383) * 4;
        u32x2 dv[16];
#pragma unroll
        for (int c = 0; c < 16; ++c) dv[c] = *(const u32x2*)(Cst + ((size_t)(bh * 16 + c) * 65536 + e));
        float C0 = 0.f, C1 = 0.f, C2 = 0.f, C3 = 0.f;
#pragma unroll
        for (int c = 0; c < 16; ++c) {
            u32x2 w; w.x = pk2(C0, C1); w.y = pk2(C2, C3); *(u32x2*)(Cst + ((size_t)(bh * 16 + c) * 65536 + e)) = w;
            const float dec = exp2f(MP[bh * 32 + c] - MP[bh * 32 + c + 1]);
            C0 = dec * C0 + bflo(dv[c].x); C1 = dec * C1 + bfhi(dv[c].x); C2 = dec * C2 + bflo(dv[c].y); C3 = dec * C3 + bfhi(dv[c].y);
        }
    }
    const int wid = tid >> 6, lane = tid & 63;
    bf16_t* nst = (bf16_t*)(ws + OFF_NST);
    for (int gwv = blockIdx.x * 8 + wid; gwv < 2048; gwv += gridDim.x * 8) {
        const int bh = gwv >> 8, k = gwv & 255;
        const bf16_t* row = (const bf16_t*)(ws + 11 * PLANE) + (size_t)((bh >> 2) * 1024 + (bh & 3) * 256 + k) * 8192;
        float n = 0.f;
        u32x4 nv[16];
#pragma unroll
        for (int c = 0; c < 16; ++c) nv[c] = *(const u32x4*)(row + c * 512 + lane * 8);
#pragma unroll
        for (int c = 0; c < 16; ++c) {
            const u32x4 v = nv[c];
            float s = bflo(v.x) + bfhi(v.x) + bflo(v.y) + bfhi(v.y) + bflo(v.z) + bfhi(v.z) + bflo(v.w) + bfhi(v.w);
            s = wave_sum(s);
            if (lane == 0) nst[(size_t)(bh * 16 + c) * 256 + k] = (bf16_t)(pk2(n, n) & 0xffff);
            const float dec = exp2f(MP[bh * 32 + c] - MP[bh * 32 + c + 1]);
            n = dec * n + s;
        }
    }
}

#define MFMA32(a, b, c) __builtin_amdgcn_mfma_f32_32x32x16_bf16(a, b, c, 0, 0, 0)
template <int MODE>
__device__ __forceinline__ void attn_unit(const Args& a, int l, int b, int h, int qb, LAS unsigned char* lds, int tid, const bool dry = false) {
    constexpr int DH = MODE ? 256 : 128, KS = DH / 16, QROWS = MODE ? 128 : 256, VROWS = DH, KP = DH * 2 + 16, VP = 136;
    constexpr int KCH = 64 * DH / 8 / 512, VCH = VROWS * 8 / 512;
    unsigned char* ws = a.ws;
    const int wid = __builtin_amdgcn_readfirstlane(tid >> 6), lane = tid & 63, l32 = lane & 31, hi = lane >> 5;
    const int rg = MODE ? (wid & 3) : wid, vh = MODE ? (wid >> 2) : 0;
    const int q0 = qb * QROWS + rg * 32, tq = q0 + l32;
    const bf16_t* Qp = (const bf16_t*)(ws + (size_t)(MODE ? 3 : 7) * PLANE);
    const bf16_t* Kp = (const bf16_t*)(ws + (size_t)(MODE ? 4 : 8) * PLANE);
    const bf16_t* VTp = (const bf16_t*)(ws + (size_t)(MODE ? 5 : 9) * PLANE);
    const int bh = MODE ? (b * 4 + h) : (b * 8 + h);
    const float* biasG = MODE ? ((const float*)(ws + OFF_A2) + (size_t)bh * S) : ((const float*)(ws + OFF_F2) + (size_t)bh * S);
    LAS unsigned char* Ks = lds; LAS unsigned char* Vs = lds + 64 * KP; LAS float* biasK = (LAS float*)(lds + 64 * KP + VROWS * VP); LAS float* red = biasK + 64;

    bf16x8 qf[MODE ? 1 : KS];
    LAS unsigned char* Qs = lds + 64 * KP + VROWS * VP + 256 + 1024;
    if (MODE) {
        __syncthreads();
#pragma unroll
        for (int i = 0; i < 8; ++i) { const int q = tid + i * 512, r = q >> 5, cc = q & 31;
            *(LAS u32x4*)(Qs + r * KP + cc * 16) = *(const u32x4*)(Qp + (size_t)(b * S + qb * QROWS + r) * 1024 + h * DH + cc * 8); }
        __syncthreads();
    } else {
#pragma unroll
        for (int ks = 0; ks < KS; ++ks) qf[ks] = *(const bf16x8*)(Qp + (size_t)(b * S + tq) * 1024 + h * DH + ks * 16 + hi * 8);
    }
#define QF(ks) (MODE ? *(const LAS bf16x8*)(Qs + (rg * 32 + l32) * KP + ((ks) * 16 + hi * 8) * 2) : qf[MODE ? 0 : (ks)])
    f32x16 O[4];
#pragma unroll
    for (int vb = 0; vb < 4; ++vb)
#pragma unroll
        for (int i = 0; i < 16; ++i) O[vb][i] = 0.f;
    float rowb = biasG[tq];
    float m_run = -INFINITY, l_run = 0.f, den_inter = 0.f, M2t = 0.f;
    int j0 = 0, j1 = qb * 4 + 3;
    if (MODE) {
        const int ch = qb >> 2; j0 = ch * 8; j1 = qb * 2 + 1;
        M2t = ((const float*)(ws + OFF_M2))[(size_t)bh * S + tq];
        const bf16_t* Cb = (const bf16_t*)(ws + OFF_CST) + (size_t)(bh * 16 + ch) * 65536;
#pragma unroll
        for (int vb = 0; vb < 4; ++vb)
#pragma unroll
            for (int ks = 0; ks < KS; ++ks) { const bf16x8 af = *(const bf16x8*)(Cb + (size_t)(vh * 128 + vb * 32 + l32) * 256 + ks * 16 + hi * 8); O[vb] = MFMA32(af, QF(ks), O[vb]); }
        f32x16 nacc;
#pragma unroll
        for (int i = 0; i < 16; ++i) nacc[i] = 0.f;
        const bf16_t* nb = (const bf16_t*)(ws + OFF_NST) + (size_t)(bh * 16 + ch) * 256;
#pragma unroll
        for (int ks = 0; ks < KS; ++ks) { bf16x8 af = *(const bf16x8*)(nb + ks * 16 + hi * 8); if (l32 != 0) af = (bf16x8){0, 0, 0, 0, 0, 0, 0, 0}; nacc = MFMA32(af, QF(ks), nacc); }
        const float nq = __shfl(nacc[0], l32);
        const float winter = exp2f(((const float*)(ws + OFF_MP2))[bh * 32 + ch] - M2t);
#pragma unroll
        for (int vb = 0; vb < 4; ++vb)
#pragma unroll
            for (int i = 0; i < 16; ++i) O[vb][i] *= winter;
        den_inter = winter * nq;
    }
    u32x4 kreg[KCH], vreg[VCH]; float breg = 0.f;
    auto gload = [&](int j) {
#pragma unroll
        for (int i = 0; i < KCH; ++i) { const int q = tid + i * 512, r = q / (DH / 8), cc = q % (DH / 8); kreg[i] = *(const u32x4*)(Kp + (size_t)(b * S + j * 64 + r) * 1024 + h * DH + cc * 8); }
#pragma unroll
        for (int i = 0; i < VCH; ++i) { const int q = tid + i * 512, r = q >> 3, cc = q & 7; vreg[i] = *(const u32x4*)(VTp + (size_t)(b * 1024 + h * DH + r) * 8192 + j * 64 + cc * 8); }
        if (tid < 64) breg = biasG[j * 64 + tid];
    };
    float Bt = 0.f;
    LAS int* flags = (LAS int*)red;
    if (!MODE) {
        float qs = 0.f;
#pragma unroll
        for (int ks = 0; ks < (MODE ? 1 : KS); ++ks)
#pragma unroll
            for (int e = 0; e < 8; ++e) { const float f = bf2f((unsigned short)qf[ks][e]); qs += f * f; }
        qs += __shfl_xor(qs, 32);
        const float kn2 = __uint_as_float(((const unsigned*)(ws + OFF_KN2))[bh]);
        Bt = sqrtf(qs * kn2) * 1.01f + rowb;
        gload(j1);
    }
    const int ntile = j1 - j0 + 1;
    for (int jt = 0; jt < ntile; ++jt) {
        const int j = MODE ? (j0 + jt) : (j1 - jt);
        __syncthreads();
        if (!MODE && jt > 0) { const int any = flags[0] | flags[1] | flags[2] | flags[3] | flags[4] | flags[5] | flags[6] | flags[7]; if (!any) break; }
        if (MODE) gload(j);
#pragma unroll
        for (int i = 0; i < KCH; ++i) { const int q = tid + i * 512, r = q / (DH / 8), cc = q % (DH / 8); *(LAS u32x4*)(Ks + r * KP + cc * 16) = kreg[i]; }
#pragma unroll
        for (int i = 0; i < VCH; ++i) { const int q = tid + i * 512, r = q >> 3, cc = q & 7; *(LAS u32x2*)(Vs + r * VP + cc * 16) = (u32x2){vreg[i].x, vreg[i].y}; *(LAS u32x2*)(Vs + r * VP + cc * 16 + 8) = (u32x2){vreg[i].z, vreg[i].w}; }
        if (tid < 64) biasK[tid] = breg;
        __syncthreads();
        if (!MODE && j > 0) gload(j - 1);
        if (j * 64 <= q0 + 31) {
            bf16x8 pb[2][2];
            const bool diag = (j * 64 + 63 > q0);
            if (MODE) {
                float ls = 0.f;
#pragma unroll
                for (int kb = 0; kb < 2; ++kb) {
                    f32x16 s1;
#pragma unroll
                    for (int i = 0; i < 16; ++i) s1[i] = 0.f;
#pragma unroll
                    for (int ks = 0; ks < KS; ++ks) { const bf16x8 af = *(const LAS bf16x8*)(Ks + (kb * 32 + l32) * KP + (ks * 16 + hi * 8) * 2); s1 = MFMA32(af, QF(ks), s1); }
#pragma unroll
                    for (int i4 = 0; i4 < 4; ++i4) { const f32x4 bk = *(const LAS f32x4*)(biasK + kb * 32 + 8 * i4 + 4 * hi);
#pragma unroll
                        for (int r = 0; r < 4; ++r) { const int i = i4 * 4 + r; const int key = j * 64 + kb * 32 + 8 * i4 + 4 * hi + r;
                            float w = exp2f(bk[r] - M2t); if (diag && key > tq) w = 0.f;
                            const float p = s1[i] * w; s1[i] = p; ls += p; } }
#pragma unroll
                    for (int jj = 0; jj < 2; ++jj) {
                        u32x4 w; w.x = pk2(s1[8 * jj + 0], s1[8 * jj + 1]); w.y = pk2(s1[8 * jj + 2], s1[8 * jj + 3]);
                        w.z = pk2(s1[8 * jj + 4], s1[8 * jj + 5]); w.w = pk2(s1[8 * jj + 6], s1[8 * jj + 7]);
                        pb[kb][jj] = __builtin_bit_cast(bf16x8, w);
                    }
                }
                l_run += ls;
            } else {
            f32x16 s[2];
#pragma unroll
            for (int kb = 0; kb < 2; ++kb) {
#pragma unroll
                for (int i4 = 0; i4 < 4; ++i4) { const f32x4 bk = *(const LAS f32x4*)(biasK + kb * 32 + 8 * i4 + 4 * hi);
#pragma unroll
                    for (int r = 0; r < 4; ++r) s[kb][i4 * 4 + r] = rowb - bk[r]; }
#pragma unroll
                for (int ks = 0; ks < KS; ++ks) { const bf16x8 af = *(const LAS bf16x8*)(Ks + (kb * 32 + l32) * KP + (ks * 16 + hi * 8) * 2); s[kb] = MFMA32(af, QF(ks), s[kb]); }
            }
            {
                if (diag) {
#pragma unroll
                    for (int kb = 0; kb < 2; ++kb)
#pragma unroll
                        for (int i = 0; i < 16; ++i) { const int key = j * 64 + kb * 32 + crow(i, hi); if (key > tq) s[kb][i] = -INFINITY; }
                }
                float mx = -INFINITY;
#pragma unroll
                for (int kb = 0; kb < 2; ++kb)
#pragma unroll
                    for (int i = 0; i < 16; ++i) mx = fmaxf(mx, s[kb][i]);
                mx = fmaxf(mx, __shfl_xor(mx, 32));
                const float m_new = fmaxf(m_run, mx);
                const float alpha = exp2f(m_run - m_new);
                float ls = 0.f;
#pragma unroll
                for (int kb = 0; kb < 2; ++kb)
#pragma unroll
                    for (int i = 0; i < 16; ++i) { const float p = exp2f(s[kb][i] - m_new); s[kb][i] = p; ls += p; }
                l_run = l_run * alpha + ls; m_run = m_new;
#pragma unroll
                for (int vb = 0; vb < 4; ++vb)
#pragma unroll
                    for (int i = 0; i < 16; ++i) O[vb][i] *= alpha;
            }
#pragma unroll
            for (int kb = 0; kb < 2; ++kb)
#pragma unroll
                for (int jj = 0; jj < 2; ++jj) {
                    u32x4 w; w.x = pk2(s[kb][8 * jj + 0], s[kb][8 * jj + 1]); w.y = pk2(s[kb][8 * jj + 2], s[kb][8 * jj + 3]);
                    w.z = pk2(s[kb][8 * jj + 4], s[kb][8 * jj + 5]); w.w = pk2(s[kb][8 * jj + 6], s[kb][8 * jj + 7]);
                    pb[kb][jj] = __builtin_bit_cast(bf16x8, w);
                }
            }
#pragma unroll
            for (int vb = 0; vb < 4; ++vb)
#pragma unroll
                for (int kb = 0; kb < 2; ++kb)
#pragma unroll
                    for (int jj = 0; jj < 2; ++jj) {
                        const LAS unsigned char* vp = Vs + (vh * 128 + vb * 32 + l32) * VP + (kb * 32 + 16 * jj + 4 * hi) * 2;
                        const u32x2 lo = *(const LAS u32x2*)vp, hi2 = *(const LAS u32x2*)(vp + 16);
                        const u32x4 w = (u32x4){lo.x, lo.y, hi2.x, hi2.y};
                        O[vb] = MFMA32(__builtin_bit_cast(bf16x8, w), pb[kb][jj], O[vb]);
                    }
        }
        if (!MODE && j > 0) {
            const float fk_last = biasG[(j - 1) * 64 + 63];
            const bool need = !((Bt - fk_last) - m_run < -160.f);
            const unsigned long long bal = __ballot(need);
            if (lane == 0) flags[wid] = (bal != 0ull) ? 1 : 0;
        }
    }
    const size_t rowoff = (size_t)(b * S + tq) * 1024;
    if (!MODE) {
        const float lt = l_run + __shfl_xor(l_run, 32);
        const float inv = 1.f / lt;
        bf16_t* bz = (bf16_t*)(ws + 1 * PLANE) + rowoff + h * 128;
#pragma unroll
        for (int vb = 0; vb < 4; ++vb)
#pragma unroll
            for (int i4 = 0; i4 < 4; ++i4) {
                bf16_t* p = bz + vb * 32 + 8 * i4 + 4 * hi;
                const u32x2 z = *(const u32x2*)p;
                u32x2 w; w.x = pk2(O[vb][i4 * 4 + 0] * inv * silu(bflo(z.x)), O[vb][i4 * 4 + 1] * inv * silu(bfhi(z.x)));
                w.y = pk2(O[vb][i4 * 4 + 2] * inv * silu(bflo(z.y)), O[vb][i4 * 4 + 3] * inv * silu(bfhi(z.y)));
                if (!dry) *(u32x2*)p = w;
            }
    } else {
        const float den = l_run + __shfl_xor(l_run, 32) + den_inter;
        const float em = ((const float*)(ws + OFF_EM))[(size_t)bh * S + tq];
        const float invd = 1.f / fmaxf(fabsf(den), em);
        float ssq = 0.f;
#pragma unroll
        for (int vb = 0; vb < 4; ++vb)
#pragma unroll
            for (int i = 0; i < 16; ++i) { O[vb][i] *= invd; ssq += O[vb][i] * O[vb][i]; }
        ssq += __shfl_xor(ssq, 32);
        if (hi == 0) red[(vh * 4 + rg) * 32 + l32] = ssq;
        __syncthreads();
        const float tot = red[rg * 32 + l32] + red[(4 + rg) * 32 + l32];
        const float rs = rsqrtf(tot * (1.f / 256.f) + EPS);
        const float* ng = a.in[6] + (size_t)l * D + h * 256 + vh * 128;
        bf16_t* az = (bf16_t*)(ws) + rowoff + h * 256 + vh * 128;
        const bf16_t* ao = (const bf16_t*)(ws + 6 * PLANE) + rowoff + h * 256 + vh * 128;
#pragma unroll
        for (int vb = 0; vb < 4; ++vb)
#pragma unroll
            for (int i4 = 0; i4 < 4; ++i4) {
                const int v = vb * 32 + 8 * i4 + 4 * hi;
                const u32x2 z = *(const u32x2*)(az + v), o = *(const u32x2*)(ao + v);
                const f32x4 g = *(const f32x4*)(ng + v);
                u32x2 w;
                w.x = pk2(O[vb][i4 * 4 + 0] * rs * g[0] * sigm(bflo(o.x)) * silu(bflo(z.x)), O[vb][i4 * 4 + 1] * rs * g[1] * sigm(bfhi(o.x)) * silu(bfhi(z.x)));
                w.y = pk2(O[vb][i4 * 4 + 2] * rs * g[2] * sigm(bflo(o.y)) * silu(bflo(z.y)), O[vb][i4 * 4 + 3] * rs * g[3] * sigm(bfhi(o.y)) * silu(bfhi(z.y)));
                if (!dry) *(u32x2*)(az + v) = w;
            }
    }
}

__device__ __forceinline__ void phase_attn(const Args& a, int l, LAS unsigned char* lds, int tid, const bool dry = false) {
    LAS int* slot = (LAS int*)(lds + LDS_BYTES - 16);
    unsigned* ctr = (unsigned*)(a.ws + OFF_QCTR) + (dry ? 2 : 0);
    if (ATTNMASK & 1) {
        for (;;) {
            __syncthreads();
            if (tid == 0) *slot = (int)__hip_atomic_fetch_add(ctr, 1u, __ATOMIC_RELAXED, __HIP_MEMORY_SCOPE_AGENT);
            __syncthreads();
            const int idx = *slot;
            if (idx >= 512) break;
            const int h = 7 - (idx >> 6), r = idx & 63;
            attn_unit<0>(a, l, r & 1, h, 31 - (r >> 1), lds, tid, dry);
        }
    }
    __syncthreads();
    if (ATTNMASK & 2) {
        int t2 = tid; asm volatile("" : "+v"(t2));
        for (;;) {
            __syncthreads();
            if (t2 == 0) *slot = (int)__hip_atomic_fetch_add(ctr + 1, 1u, __ATOMIC_RELAXED, __HIP_MEMORY_SCOPE_AGENT);
            __syncthreads();
            const int idx = *slot;
            if (idx >= 512) break;
            const int qm = 3 - (idx >> 7), r = idx & 127, bh = r & 7, ch = r >> 3;
            attn_unit<1>(a, l, bh >> 2, bh & 3, ch * 4 + qm, lds, t2, dry);
        }
    }
    __syncthreads();
}

__device__ __forceinline__ void phase_pool(const Args& a, int tid) {
    unsigned char* ws = a.ws;
    const bf16_t* cu = (const bf16_t*)(ws + 3 * PLANE); bf16_t* cz = (bf16_t*)(ws + 2 * PLANE);
    for (int idx = blockIdx.x * 512 + tid; idx < M * 128; idx += gridDim.x * 512) {
        const int r = idx >> 7, c = (idx & 127) * 8, g = c >> 8, W = 2 << g, t = r & 8191, cnt = (t + 1 < W) ? t + 1 : W;
        float s[8], cur[8];
#pragma unroll
        for (int j = 0; j < 8; ++j) s[j] = 0.f;
        u32x4 wv[16];
#pragma unroll
        for (int k = 0; k < 16; ++k) wv[k] = (k < cnt) ? *(const u32x4*)(cu + (size_t)(r - k) * 1024 + c) : (u32x4){0u, 0u, 0u, 0u};
#pragma unroll
        for (int k = 0; k < 16; ++k) {
            const u32x4 v = wv[k];
            const float f[8] = {bflo(v.x), bfhi(v.x), bflo(v.y), bfhi(v.y), bflo(v.z), bfhi(v.z), bflo(v.w), bfhi(v.w)};
#pragma unroll
            for (int j = 0; j < 8; ++j) { s[j] += f[j]; if (k == 0) cur[j] = f[j]; }
        }
        const float ic = 1.f / (float)cnt;
        const u32x4 z = *(const u32x4*)(cz + (size_t)r * 1024 + c);
        const float zf[8] = {bflo(z.x), bfhi(z.x), bflo(z.y), bfhi(z.y), bflo(z.z), bfhi(z.z), bflo(z.w), bfhi(z.w)};
        float o[8];
#pragma unroll
        for (int j = 0; j < 8; ++j) o[j] = (s[j] * ic - cur[j]) * silu(zf[j]);
        u32x4 w; w.x = pk2(o[0], o[1]); w.y = pk2(o[2], o[3]); w.z = pk2(o[4], o[5]); w.w = pk2(o[6], o[7]);
        *(u32x4*)(cz + (size_t)r * 1024 + c) = w;
    }
}

__device__ __forceinline__ void phase_final(const Args& a, int tid) {
    const float* fg = a.in[12]; float* out = a.out;
    const int wid = tid >> 6, lane = tid & 63;
    f32x4 gg[4];
#pragma unroll
    for (int j = 0; j < 4; ++j) gg[j] = *(const f32x4*)(fg + j * 256 + lane * 4);
    for (int row = blockIdx.x * 8 + wid; row < M; row += gridDim.x * 8) {
        f32x4 xv[4]; float ss = 0.f;
#pragma unroll
        for (int j = 0; j < 4; ++j) { xv[j] = *(const f32x4*)(out + (size_t)row * D + j * 256 + lane * 4); ss += xv[j][0] * xv[j][0] + xv[j][1] * xv[j][1] + xv[j][2] * xv[j][2] + xv[j][3] * xv[j][3]; }
        ss = wave_sum(ss);
        const float r = rsqrtf(ss * (1.f / 1024.f) + EPS);
#pragma unroll
        for (int j = 0; j < 4; ++j) *(f32x4*)(out + (size_t)row * D + j * 256 + lane * 4) = (xv[j] * r) * gg[j];
    }
}

__global__ void __launch_bounds__(512) mega(Args a0) {
    extern __shared__ __attribute__((aligned(16))) unsigned char lds_raw[];
    LAS unsigned char* lds = (LAS unsigned char*)lds_raw;
    for (int ph = a0.ph_lo; ph < a0.ph_hi; ++ph) {
        Args a = a0; asm volatile("" : "+s"(a.ws), "+s"(a.out));
        unsigned char* ws = a.ws; int G = gridDim.x, cb = blockIdx.x; asm volatile("" : "+s"(G), "+s"(cb));
        int tid = threadIdx.x; asm volatile("" : "+v"(tid));
        const int l = ph / 10, k = (ph == 20) ? 10 : ph % 10;
        if (k == 0 && (PHMASK & 1)) phase_prep(a, l, lds, tid);
        else if (k == 1 && (PHMASK >> 1 & 1)) {
            phase_scans(a, l, lds, tid);
            pg8::Gemm g{(const bf16_t*)(ws + 10 * PLANE), (const bf16_t*)(ws + OFF_WT1), 1024, 1024, 1024};
            SchedStd Sd; Sd.init(64, 36, G, cb, 1024, 1024);
            EpiG1 E{ws};
            pg8::gemm_phase<EpiG1, SchedStd, true, true>(lds, g, Sd, E, tid);
        }
        else if (k == 2 && (PHMASK >> 2 & 1)) phase_conv(a, l, lds, tid);
        else if (k == 3 && (PHMASK >> 3 & 1)) {
            pg8::Gemm g{(const bf16_t*)(ws + 5 * PLANE), (const bf16_t*)(ws + 11 * PLANE), 8192, 8192, 512};
            SchedA1 Sd{G, cb};
            EpiPlain E{(bf16_t*)(ws + OFF_CST), 256, (size_t)65536, 0};
            pg8::gemm_phase<EpiPlain, SchedA1, true, true>(lds, g, Sd, E, tid);
        }
        else if (k == 4 && (PHMASK >> 4 & 1)) phase_statescan(a, tid);
        else if (k == 5 && (PHMASK >> 5 & 1)) phase_attn(a, l, lds, tid, PROBE_RPT ? (a.dry != 0) : false);
        else if (k == 6 && (PHMASK >> 6 & 1)) {
            pg8::Gemm g{(const bf16_t*)(ws + 10 * PLANE), (const bf16_t*)(ws + OFF_WT1B), 1024, 1024, 1024};
            SchedStd Sd; Sd.init(64, 20, G, cb, 1024, 1024);
            EpiPlain E{(bf16_t*)(ws + 2 * PLANE), 1024, (size_t)0, 1};
            pg8::gemm_phase<EpiPlain, SchedStd, true, true>(lds, g, Sd, E, tid);
        }
        else if (k == 7 && (PHMASK >> 7 & 1)) phase_pool(a, tid);
        else if (k == 8 && (PHMASK >> 8 & 1)) {
            pg8::Gemm g{(const bf16_t*)(ws), (const bf16_t*)(ws + OFF_WT2), 1024, 1024, 1024};
            SchedG2 Sd{G, cb};
            EpiG2 E{(const bf16_t*)(ws + 4 * PLANE), (float*)(ws + 7 * PLANE), (bf16_t*)(ws + 9 * PLANE)};
            pg8::gemm_phase<EpiG2, SchedG2, true, true>(lds, g, Sd, E, tid);
        }
        else if (k == 9 && (PHMASK >> 9 & 1)) {
            pg8::Gemm g{(const bf16_t*)(ws + 9 * PLANE), (const bf16_t*)(ws + OFF_WT3), 1024, 1024, 1024};
            SchedStd Sd; Sd.init(64, 4, G, cb, 1024, 1024);
            EpiG3 E{(l == 0) ? a.in[0] : a.out, a.out};
            pg8::gemm_phase<EpiG3, SchedStd, true, true>(lds, g, Sd, E, tid);
        }
        else if (k == 10 && (PHMASK >> 10 & 1)) phase_final(a, tid);
        if (ph + 1 < a0.ph_hi) { __syncthreads(); cg::this_grid().sync(); }
    }
}

extern "C" void kernel_launch(void* const* d_in, const int* in_sizes, int n_in, void* d_out, int out_size, void* d_ws, size_t ws_size, hipStream_t stream) {
    static int grid_blocks = 0;
    if (!grid_blocks) {
        hipFuncSetAttribute((const void*)mega, hipFuncAttributeMaxDynamicSharedMemorySize, LDS_BYTES);
        int dev = 0, cus = 0, per_cu = 0;
        hipGetDevice(&dev);
        hipDeviceGetAttribute(&cus, hipDeviceAttributeMultiprocessorCount, dev);
        hipOccupancyMaxActiveBlocksPerMultiprocessor(&per_cu, mega, 512, LDS_BYTES);
        if (per_cu < 1) per_cu = 1;
        grid_blocks = cus * per_cu; if (grid_blocks > 256) grid_blocks = 256;
    }
    if (ws_size < OFF_END) { fprintf(stderr, "workspace too small: %zu < %zu\n", ws_size, (size_t)OFF_END); return; }
    Args a{};
    for (int i = 0; i < 13; ++i) a.in[i] = (const float*)d_in[i];
    a.out = (float*)d_out; a.ws = (unsigned char*)d_ws;
#if MK_MULTI
    for (int ph = 0; ph < NPH; ++ph) {
        const int k = (ph == 20) ? 10 : ph % 10;
        const int reps = ((PROBE_RPT >> k) & 1) ? 2 : 1;
        for (int rep = 0; rep < reps; ++rep) { a.ph_lo = ph; a.ph_hi = ph + 1; a.dry = (k == 5 && reps == 2 && rep == 0) ? 1 : 0;
            hipLaunchKernelGGL(mega, dim3(grid_blocks), dim3(512), LDS_BYTES, stream, a); }
    }
#else
    a.ph_lo = 0; a.ph_hi = NPH;
    void* args[] = {&a};
    hipError_t e = hipLaunchCooperativeKernel((void*)mega, dim3(grid_blocks), dim3(512), args, LDS_BYTES, stream);
    if (e != hipSuccess) fprintf(stderr, "cooperative launch failed: %s (grid %d)\n", hipGetErrorString(e), grid_blocks);
#endif
}
```

```cpp
#include <hip/hip_runtime.h>
#include <hip/hip_cooperative_groups.h>
#include <cstdio>
#include <cstdint>
namespace cg = cooperative_groups;

#ifndef MK_MULTI
#define MK_MULTI 0
#endif

namespace pg8 {
#define PG8_LAS __attribute__((address_space(3)))
typedef unsigned short bf16_t;
typedef short bf16x8 __attribute__((ext_vector_type(8)));
typedef float f32x4 __attribute__((ext_vector_type(4)));
typedef unsigned u32x4 __attribute__((ext_vector_type(4)));
constexpr int BM = 256, BK = 64, HALF = 128, HTB = HALF * BK * 2  , STAGE_BYTES = 8 * HTB, NXCD = 8, WGM = 8;

__host__ __device__ __forceinline__ int lds_byte(int r, int c) { const int st = (r >> 4) * 2 + (c >> 5), rr = r & 15, cc = c & 31, ob = rr * 64 + cc * 2; return st * 1024 + (ob ^ (((ob >> 9) & 1) << 5)); }
__host__ __device__ __forceinline__ void stage_rc(int b, int& R, int& C) { const int st = b / 1024, sb = b % 1024, swz = sb ^ (((sb >> 9) & 1) << 5); R = (st >> 1) * 16 + swz / 64; C = (st & 1) * 32 + (swz % 64) / 2; }
__host__ __device__ __forceinline__ int perm32(int rho) { const int n = rho >> 4, i = rho & 15; return 8 * (i >> 2) + 4 * n + (i & 3); }

struct Unit { int pm, pn, z; };
struct Gemm { const bf16_t* A; const bf16_t* Bt; int lda, ldb, K; };

__device__ __forceinline__ unsigned cvt_pk_bf16(float lo, float hi) { unsigned r; asm volatile("v_cvt_pk_bf16_f32 %0, %1, %2" : "=v"(r) : "v"(lo), "v"(hi)); return r; }

template <class Epi, class Sched, bool ALIGN_EPI = false, bool SP2 = false>
__device__ __forceinline__ void gemm_phase(PG8_LAS unsigned char* lds, const Gemm g, const Sched& S, const Epi& E, const int tid) {
    const int wid = __builtin_amdgcn_readfirstlane(tid >> 6), lane = tid & 63, wr = wid >> 2, wc = wid & 3, fr = lane & 15, fq = lane >> 4;
    const int K = g.K, nt = K / BK;
    unsigned voffA[2], voffB[2];
#pragma unroll
    for (int i = 0; i < 2; ++i) { int R, C; stage_rc(tid * 16 + i * 8192, R, C); const int Rb = Epi::PERM ? ((R & ~31) + perm32(R & 31)) : R;
        voffA[i] = (unsigned)(R * g.lda + C) * 2u; voffB[i] = (unsigned)(Rb * g.ldb + C) * 2u; }
    const size_t kstep = (size_t)(BK * 2);
    const size_t hstepA = (size_t)HALF * g.lda * 2, hstepB = (size_t)HALF * g.ldb * 2;
    const unsigned ldsw = (unsigned)wid * 1024u;
    const int aoff = lds_byte(wr * 64 + fr, fq * 8), boff = lds_byte(wc * 32 + fr, fq * 8);
#define PG8_SA(b, h) (((b) * 2 + (h)) * HTB)
#define PG8_SB(b, h) ((4 + (b) * 2 + (h)) * HTB)
#define PG8_STAGE(bufoff, gbase, voff) do { _Pragma("unroll") for (int _i = 0; _i < 2; ++_i) \
        __builtin_amdgcn_global_load_lds((const unsigned*)((const char*)(gbase) + (voff)[_i]), (PG8_LAS unsigned*)(lds + (bufoff) + ldsw + _i * 8192), 16, 0, 0); } while (0)
#define PG8_LDA(dst, b, h) do { _Pragma("unroll") for (int m = 0; m < 4; ++m) _Pragma("unroll") for (int k = 0; k < 2; ++k) dst[m][k] = *(const PG8_LAS bf16x8*)(lds + PG8_SA(b, h) + aoff + m * 2048 + k * 1024); } while (0)
#define PG8_LDB(dst, b, h) do { _Pragma("unroll") for (int n = 0; n < 2; ++n) _Pragma("unroll") for (int k = 0; k < 2; ++k) dst[n][k] = *(const PG8_LAS bf16x8*)(lds + PG8_SB(b, h) + boff + n * 2048 + k * 1024); } while (0)
#define PG8_MMA(ai, bj, At, Bt) do { __builtin_amdgcn_s_setprio(1); _Pragma("unroll") for (int m = 0; m < 4; ++m) _Pragma("unroll") for (int n = 0; n < 2; ++n) _Pragma("unroll") for (int k = 0; k < 2; ++k) \
        acc[ai][bj][m][n] = __builtin_amdgcn_mfma_f32_16x16x32_bf16(Bt[n][k], At[m][k], acc[ai][bj][m][n], 0, 0, 0); __builtin_amdgcn_s_setprio(0); } while (0)
#define PG8_WAIT_V(n) asm volatile("s_waitcnt vmcnt(" #n ")" ::: "memory")
#define PG8_WAIT_L(n) asm volatile("s_waitcnt lgkmcnt(" #n ")" ::: "memory")
#define PG8_BAR __builtin_amdgcn_s_barrier()
#define PG8_SCHED __builtin_amdgcn_sched_barrier(0)
    Unit cur, nxt; int ui = 0;
    if (!S.next(0, cur)) return;
    f32x4 acc[2][2][4][2];
#pragma unroll
    for (int a = 0; a < 2; ++a)
#pragma unroll
        for (int b = 0; b < 2; ++b)
#pragma unroll
            for (int m = 0; m < 4; ++m)
#pragma unroll
                for (int n = 0; n < 2; ++n) acc[a][b][m][n] = (f32x4){0.f, 0.f, 0.f, 0.f};
    bf16x8 At[4][2], B0[2][2], B1[2][2];
    const char* cA = (const char*)g.A + S.a_off(cur); const char* cB = (const char*)g.Bt + S.b_off(cur);
    S.a_ready(cur);
    if constexpr (SP2) {
        PG8_STAGE(PG8_SB(0, 0), cB, voffB); PG8_STAGE(PG8_SB(0, 1), cB + hstepB, voffB); PG8_STAGE(PG8_SA(0, 0), cA, voffA); PG8_STAGE(PG8_SA(0, 1), cA + hstepA, voffA);
        if (wr == 1) PG8_BAR;
        PG8_WAIT_V(2); PG8_BAR;
        PG8_STAGE(PG8_SB(1, 0), cB + kstep, voffB); PG8_STAGE(PG8_SA(1, 0), cA + kstep, voffA); PG8_STAGE(PG8_SB(1, 1), cB + hstepB + kstep, voffB);
        PG8_WAIT_V(6); PG8_BAR;
    } else {
        PG8_STAGE(PG8_SB(0, 0), cB, voffB); PG8_STAGE(PG8_SA(0, 0), cA, voffA); PG8_STAGE(PG8_SB(0, 1), cB + hstepB, voffB); PG8_STAGE(PG8_SA(0, 1), cA + hstepA, voffA);
        if (wr == 1) PG8_BAR;
        PG8_WAIT_V(4); PG8_BAR;
        PG8_STAGE(PG8_SB(1, 0), cB + kstep, voffB); PG8_STAGE(PG8_SA(1, 0), cA + kstep, voffA); PG8_STAGE(PG8_SB(1, 1), cB + hstepB + kstep, voffB);
        PG8_WAIT_V(6); PG8_BAR;
    }
    for (;;) {
        const bool has_next = S.next(ui + 1, nxt);
        const char* nA = has_next ? (const char*)g.A + S.a_off(nxt) : cA; const char* nB = has_next ? (const char*)g.Bt + S.b_off(nxt) : cB;
        for (int t = 0; t < nt; t += 2) {
            const bool last = (t == nt - 2);
            const char* a1 = cA + (size_t)(t + 1) * kstep;
            const char* a2 = last ? nA : cA + (size_t)(t + 2) * kstep; const char* b2 = last ? nB : cB + (size_t)(t + 2) * kstep;
            const char* a3 = a2 + kstep; const char* b3 = b2 + kstep;
            if (last && has_next) S.a_ready(nxt);
            if constexpr (SP2) {
            PG8_LDB(B0, 0, 0); PG8_LDB(B1, 0, 1); PG8_SCHED; PG8_LDA(At, 0, 0); PG8_STAGE(PG8_SA(1, 1), a1 + hstepA, voffA);
            PG8_WAIT_V(8); PG8_WAIT_L(0); PG8_BAR; PG8_MMA(0, 0, At, B0); PG8_MMA(0, 1, At, B1); PG8_BAR; PG8_SCHED;
            PG8_LDA(At, 0, 1); PG8_STAGE(PG8_SB(0, 0), b2, voffB); PG8_STAGE(PG8_SB(0, 1), b2 + hstepB, voffB); PG8_STAGE(PG8_SA(0, 0), a2, voffA);
            PG8_WAIT_V(8); PG8_WAIT_L(0); PG8_BAR; PG8_MMA(1, 0, At, B0); PG8_MMA(1, 1, At, B1); PG8_BAR; PG8_SCHED;
            PG8_LDB(B0, 1, 0); PG8_LDB(B1, 1, 1); PG8_SCHED; PG8_LDA(At, 1, 0); PG8_STAGE(PG8_SA(0, 1), a2 + hstepA, voffA);
            PG8_WAIT_V(8); PG8_WAIT_L(0); PG8_BAR; PG8_MMA(0, 0, At, B0); PG8_MMA(0, 1, At, B1); PG8_BAR; PG8_SCHED;
            PG8_LDA(At, 1, 1); PG8_STAGE(PG8_SB(1, 0), b3, voffB); PG8_STAGE(PG8_SB(1, 1), b3 + hstepB, voffB); PG8_STAGE(PG8_SA(1, 0), a3, voffA);
            PG8_WAIT_V(8); PG8_WAIT_L(0); PG8_BAR; PG8_MMA(1, 0, At, B0); PG8_MMA(1, 1, At, B1); PG8_BAR; PG8_SCHED;
            } else {
            PG8_LDB(B0, 0, 0); PG8_SCHED; PG8_LDA(At, 0, 0); PG8_STAGE(PG8_SA(1, 1), a1 + hstepA, voffA);
            PG8_WAIT_L(8); PG8_BAR; PG8_WAIT_L(0); PG8_MMA(0, 0, At, B0); PG8_BAR; PG8_SCHED;
            PG8_LDB(B1, 0, 1); PG8_STAGE(PG8_SB(0, 0), b2, voffB);
            PG8_BAR; PG8_WAIT_L(0); PG8_MMA(0, 1, At, B1); PG8_BAR;
            PG8_LDA(At, 0, 1); PG8_STAGE(PG8_SA(0, 0), a2, voffA);
            PG8_BAR; PG8_WAIT_L(0); PG8_MMA(1, 0, At, B0); PG8_BAR; PG8_SCHED;
            PG8_STAGE(PG8_SB(0, 1), b2 + hstepB, voffB);
            PG8_WAIT_V(6); PG8_BAR; PG8_MMA(1, 1, At, B1); PG8_BAR;
            PG8_LDB(B0, 1, 0); PG8_SCHED; PG8_LDA(At, 1, 0); PG8_STAGE(PG8_SA(0, 1), a2 + hstepA, voffA);
            PG8_WAIT_L(8); PG8_BAR; PG8_WAIT_L(0); PG8_MMA(0, 0, At, B0); PG8_BAR; PG8_SCHED;
            PG8_LDB(B1, 1, 1); PG8_STAGE(PG8_SB(1, 0), b3, voffB);
            PG8_BAR; PG8_WAIT_L(0); PG8_MMA(0, 1, At, B1); PG8_BAR;
            PG8_LDA(At, 1, 1); PG8_STAGE(PG8_SA(1, 0), a3, voffA);
            PG8_BAR; PG8_WAIT_L(0); PG8_MMA(1, 0, At, B0); PG8_BAR; PG8_SCHED;
            PG8_STAGE(PG8_SB(1, 1), b3 + hstepB, voffB);
            PG8_WAIT_V(6); PG8_BAR; PG8_MMA(1, 1, At, B1); PG8_BAR;
            }
        }
        if constexpr (ALIGN_EPI) { if (wr == 0) PG8_BAR; }
        if constexpr (!Epi::AFTER_DRAIN) { E(acc, cur, wr, wc, fr, fq); S.done(cur); }
        if (!has_next) break;
#pragma unroll
        for (int a = 0; a < 2; ++a)
#pragma unroll
            for (int b = 0; b < 2; ++b)
#pragma unroll
                for (int m = 0; m < 4; ++m)
#pragma unroll
                    for (int n = 0; n < 2; ++n) acc[a][b][m][n] = (f32x4){0.f, 0.f, 0.f, 0.f};
        cur = nxt; cA = nA; cB = nB; ++ui;
        if constexpr (ALIGN_EPI) { if (wr == 1) PG8_BAR; }
    }
    PG8_WAIT_V(0);
    if constexpr (!ALIGN_EPI) { if (wr == 0) PG8_BAR; }
    PG8_BAR;
    if constexpr (Epi::AFTER_DRAIN) { E.fused(acc, cur, wr, wc, fr, fq, lds, wid, lane); S.done(cur); }
#undef PG8_SA
#undef PG8_SB
#undef PG8_STAGE
#undef PG8_LDA
#undef PG8_LDB
#undef PG8_MMA
#undef PG8_WAIT_V
#undef PG8_WAIT_L
#undef PG8_BAR
#undef PG8_SCHED
}
}

#ifndef PG8_SP2
#define PG8_SP2 true
#endif
#ifndef PG8_ALIGN
#define PG8_ALIGN true
#endif

using pg8::bf16_t; using pg8::bf16x8; using pg8::f32x4; using pg8::u32x4;
typedef float f32x16 __attribute__((ext_vector_type(16)));
typedef unsigned u32x2 __attribute__((ext_vector_type(2)));
#define LAS __attribute__((address_space(3)))

constexpr int M = 16384, S = 8192, D = 1024, NIN = 14352;
constexpr size_t PLANE = (size_t)M * D * 2;
constexpr float EPS = 1e-6f, LOG2E = 1.4426950408889634f;
constexpr size_t MiB = 1048576;
constexpr size_t OFF_WT1 = 12 * PLANE, OFF_WT1B = OFF_WT1 + 18 * MiB, OFF_WT2 = OFF_WT1B + 10 * MiB, OFF_WT3 = OFF_WT2 + 6 * MiB,
    OFF_HALO = OFF_WT3 + 2 * MiB, OFF_GATES = OFF_HALO + 3 * MiB, OFF_A2 = OFF_GATES + MiB, OFF_M2 = OFF_A2 + 262144, OFF_EM = OFF_M2 + 262144,
    OFF_WK = OFF_EM + 262144, OFF_F2 = OFF_WK + 262144, OFF_MP2 = OFF_F2 + 524288, OFF_NST = OFF_MP2 + 4096, OFF_KN2 = OFF_NST + 65536, OFF_QCTR = OFF_KN2 + 256, OFF_END = OFF_QCTR + 256;
constexpr size_t OFF_CST = OFF_WT1;
constexpr int LDS_BYTES = 143360;
constexpr int NPH = 21;
#ifndef ATTNMASK
#define ATTNMASK 3
#endif
#ifndef PROBE_RPT
#define PROBE_RPT 0
#endif
#ifndef PROBE_DRYMASK
#define PROBE_DRYMASK 3
#endif
#ifndef PHMASK
#define PHMASK 0x7ff
#endif

struct Args { const float* in[13]; float* out; unsigned char* ws; int ph_lo, ph_hi, dry, pad; };

__device__ __forceinline__ float bf2f(unsigned b) { return __uint_as_float(b << 16); }
__device__ __forceinline__ float bflo(unsigned w) { return __uint_as_float(w << 16); }
__device__ __forceinline__ float bfhi(unsigned w) { return __uint_as_float(w & 0xffff0000u); }
__device__ __forceinline__ unsigned pk2(float lo, float hi) { return pg8::cvt_pk_bf16(lo, hi); }
__device__ __forceinline__ float wave_sum(float v) {
#pragma unroll
    for (int o = 32; o; o >>= 1) v += __shfl_xor(v, o);
    return v; }
__device__ __forceinline__ float sigm(float x) { return 1.f / (1.f + __expf(-x)); }
__device__ __forceinline__ float silu(float x) { return x / (1.f + __expf(-x)); }
__device__ __forceinline__ float logsig(float x) { return fminf(x, 0.f) - log1pf(expf(-fabsf(x))); }
__device__ __forceinline__ int crow(int r, int hi) { return (r & 3) + 8 * (r >> 2) + 4 * hi; }

struct SchedStd {
    int nM, nN, nwg, G, c, lda, ldb;
    __device__ void init(int nM_, int nN_, int G_, int c_, int lda_, int ldb_) { nM = nM_; nN = nN_; nwg = nM * nN; G = G_; c = c_; lda = lda_; ldb = ldb_; }
    __device__ bool next(int i, pg8::Unit& u) const {
        const long L = (long)i * G + c; if (L >= nwg) return false;
        int wgid = (int)L; { const int q = nwg / 8, r = nwg % 8, xcd = wgid % 8, off = wgid / 8; wgid = (xcd < r ? xcd * (q + 1) : r * (q + 1) + (xcd - r) * q) + off; }
        const int nig = 8 * nN, gid = wgid / nig, fm = gid * 8, gsz = (nM - fm) < 8 ? (nM - fm) : 8;
        u.pm = fm + ((wgid % nig) % gsz); u.pn = (wgid % nig) / gsz; u.z = 0; return true;
    }
    __device__ __forceinline__ size_t a_off(const pg8::Unit& u) const { return (size_t)u.pm * 256 * lda * 2; }
    __device__ __forceinline__ size_t b_off(const pg8::Unit& u) const { return (size_t)u.pn * 256 * ldb * 2; }
    __device__ __forceinline__ void a_ready(const pg8::Unit&) const {}
    __device__ __forceinline__ void done(const pg8::Unit&) const {}
};
struct SchedG2 {
    int G, c;
    __device__ bool next(int i, pg8::Unit& u) const {
        const int t = (i / 3) * G + c; if (t >= 256) return false;
        const int x = t & 7, q = t >> 3; u.pm = x * 8 + (q >> 2); u.pn = q & 3; u.z = i % 3; return true;
    }
    __device__ __forceinline__ size_t a_off(const pg8::Unit& u) const { return (size_t)u.z * PLANE + (size_t)u.pm * 256 * 1024 * 2; }
    __device__ __forceinline__ size_t b_off(const pg8::Unit& u) const { return ((size_t)u.z * 1024 + (size_t)u.pn * 256) * 1024 * 2; }
    __device__ __forceinline__ void a_ready(const pg8::Unit&) const {}
    __device__ __forceinline__ void done(const pg8::Unit&) const {}
};
struct SchedA1 {
    int G, c;
    __device__ bool next(int i, pg8::Unit& u) const { const int L = i * G + c; if (L >= 128) return false; u.pm = 0; u.pn = 0; u.z = L; return true; }
    __device__ __forceinline__ size_t a_off(const pg8::Unit& u) const { const int bh = u.z >> 4, ch = u.z & 15; return ((size_t)((bh >> 2) * 1024 + (bh & 3) * 256) * 8192 + (size_t)ch * 512) * 2; }
    __device__ __forceinline__ size_t b_off(const pg8::Unit& u) const { return a_off(u); }
    __device__ __forceinline__ void a_ready(const pg8::Unit&) const {}
    __device__ __forceinline__ void done(const pg8::Unit&) const {}
};

struct EpiG1 {
    static constexpr bool PERM = true, AFTER_DRAIN = false;
    unsigned char* ws;
    __device__ __forceinline__ void operator()(const f32x4 (&acc)[2][2][4][2], const pg8::Unit& u, int wr, int wc, int fr, int fq) const {
        asm volatile("" : "+v"(fr), "+v"(fq));
        const int p9 = u.pn >> 2;
        const int dpl = (p9 < 2) ? p9 : p9 + 1;
        bf16_t* base = (bf16_t*)(ws + (size_t)dpl * PLANE);
        bf16_t* halo = (bf16_t*)(ws + OFF_HALO);
        const int cc0 = (u.pn & 3) * 256 + wc * 32 + 8 * fq;
        const int row0 = u.pm * 256 + wr * 64 + fr;
        const bool transposed = (p9 == 4 || p9 == 8), hal = (p9 == 2 || p9 == 3);
        const float sc = (p9 == 6) ? (0.08838834764831845f * LOG2E) : 1.f;
#pragma unroll
        for (int ai = 0; ai < 2; ++ai)
#pragma unroll
            for (int m = 0; m < 4; ++m) {
                const int r = row0 + ai * 128 + m * 16;
#pragma unroll
                for (int bj = 0; bj < 2; ++bj) {
                    const int c = cc0 + bj * 128;
                    const f32x4 v0 = acc[ai][bj][m][0] * sc, v1 = acc[ai][bj][m][1] * sc;
                    u32x4 w; w.x = pk2(v0[0], v0[1]); w.y = pk2(v0[2], v0[3]); w.z = pk2(v1[0], v1[1]); w.w = pk2(v1[2], v1[3]);
                    if (!transposed) {
                        *(u32x4*)(base + (size_t)r * 1024 + c) = w;
                        if (hal && m == 3 && fr >= 13) *(u32x4*)(halo + ((size_t)(r >> 6) * 3 + (fr - 13)) * 2048 + (p9 == 3 ? 1024 : 0) + c) = w;
                    } else {
                        const int b = r >> 13, t = r & 8191;
                        bf16_t* p = base + ((size_t)(b * 1024 + c)) * 8192 + t;
                        p[0] = (bf16_t)(w.x & 0xffff); p[8192] = (bf16_t)(w.x >> 16); p[2 * 8192] = (bf16_t)(w.y & 0xffff); p[3 * 8192] = (bf16_t)(w.y >> 16);
                        p[4 * 8192] = (bf16_t)(w.z & 0xffff); p[5 * 8192] = (bf16_t)(w.z >> 16); p[6 * 8192] = (bf16_t)(w.w & 0xffff); p[7 * 8192] = (bf16_t)(w.w >> 16);
                    }
                }
            }
    }
};
struct EpiPlain {
    static constexpr bool PERM = true, AFTER_DRAIN = false;
    bf16_t* base; int ldc; size_t zstride; int split;
    __device__ __forceinline__ void operator()(const f32x4 (&acc)[2][2][4][2], const pg8::Unit& u, int wr, int wc, int fr, int fq) const {
        asm volatile("" : "+v"(fr), "+v"(fq));
        bf16_t* bp = base + (size_t)u.z * zstride;
        int colt = u.pn * 256;
        if (split) { bp += (size_t)(u.pn >> 2) * (PLANE / 2); colt = (u.pn & 3) * 256; }
        const int cc0 = colt + wc * 32 + 8 * fq, row0 = u.pm * 256 + wr * 64 + fr;
#pragma unroll
        for (int ai = 0; ai < 2; ++ai)
#pragma unroll
            for (int m = 0; m < 4; ++m) {
                bf16_t* rowp = bp + (size_t)(row0 + ai * 128 + m * 16) * ldc + cc0;
#pragma unroll
                for (int bj = 0; bj < 2; ++bj) {
                    const f32x4 v0 = acc[ai][bj][m][0], v1 = acc[ai][bj][m][1];
                    u32x4 w; w.x = pk2(v0[0], v0[1]); w.y = pk2(v0[2], v0[3]); w.z = pk2(v1[0], v1[1]); w.w = pk2(v1[2], v1[3]);
                    *(u32x4*)(rowp + bj * 128) = w;
                }
            }
    }
};
struct EpiG2 {
    static constexpr bool PERM = true, AFTER_DRAIN = false;
    const bf16_t* gates; bf16_t* tmp; bf16_t* outp;
    __device__ __forceinline__ void operator()(const f32x4 (&acc)[2][2][4][2], const pg8::Unit& u, int wr, int wc, int fr, int fq) const {
        asm volatile("" : "+v"(fr), "+v"(fq));
        const bf16_t* gp = gates + (size_t)u.z * (PLANE / 2);
        bf16_t* dst = (u.z == 2) ? outp : tmp;
        const int cc0 = u.pn * 256 + wc * 32 + 8 * fq, row0 = u.pm * 256 + wr * 64 + fr;
#pragma unroll
        for (int ai = 0; ai < 2; ++ai) {
            u32x4 gv[4][2], tv[4][2];
#pragma unroll
            for (int m = 0; m < 4; ++m)
#pragma unroll
                for (int bj = 0; bj < 2; ++bj) { const size_t o = (size_t)(row0 + ai * 128 + m * 16) * 1024 + cc0 + bj * 128;
                    gv[m][bj] = *(const u32x4*)(gp + o); tv[m][bj] = (u.z != 0) ? *(const u32x4*)(tmp + o) : (u32x4){0u, 0u, 0u, 0u}; }
#pragma unroll
            for (int m = 0; m < 4; ++m)
#pragma unroll
                for (int bj = 0; bj < 2; ++bj) { const size_t o = (size_t)(row0 + ai * 128 + m * 16) * 1024 + cc0 + bj * 128;
                    const u32x4 g = gv[m][bj], p = tv[m][bj];
                    f32x4 v0 = acc[ai][bj][m][0], v1 = acc[ai][bj][m][1];
                    v0[0] = v0[0] * sigm(bflo(g.x)) + bflo(p.x); v0[1] = v0[1] * sigm(bfhi(g.x)) + bfhi(p.x); v0[2] = v0[2] * sigm(bflo(g.y)) + bflo(p.y); v0[3] = v0[3] * sigm(bfhi(g.y)) + bfhi(p.y);
                    v1[0] = v1[0] * sigm(bflo(g.z)) + bflo(p.z); v1[1] = v1[1] * sigm(bfhi(g.z)) + bfhi(p.z); v1[2] = v1[2] * sigm(bflo(g.w)) + bflo(p.w); v1[3] = v1[3] * sigm(bfhi(g.w)) + bfhi(p.w);
                    u32x4 w; w.x = pk2(v0[0], v0[1]); w.y = pk2(v0[2], v0[3]); w.z = pk2(v1[0], v1[1]); w.w = pk2(v1[2], v1[3]);
                    *(u32x4*)(dst + o) = w; }
        }
    }
};
struct EpiG3 {
    static constexpr bool PERM = true, AFTER_DRAIN = false;
    const float* xin; float* out;
    __device__ __forceinline__ void operator()(const f32x4 (&acc)[2][2][4][2], const pg8::Unit& u, int wr, int wc, int fr, int fq) const {
        asm volatile("" : "+v"(fr), "+v"(fq));
        const int cc0 = u.pn * 256 + wc * 32 + 8 * fq, row0 = u.pm * 256 + wr * 64 + fr;
#pragma unroll
        for (int ai = 0; ai < 2; ++ai) {
            f32x4 xv[4][2][2];
#pragma unroll
            for (int m = 0; m < 4; ++m)
#pragma unroll
                for (int bj = 0; bj < 2; ++bj) { const size_t o = (size_t)(row0 + ai * 128 + m * 16) * 1024 + cc0 + bj * 128; xv[m][bj][0] = *(const f32x4*)(xin + o); xv[m][bj][1] = *(const f32x4*)(xin + o + 4); }
#pragma unroll
            for (int m = 0; m < 4; ++m)
#pragma unroll
                for (int bj = 0; bj < 2; ++bj) { const size_t o = (size_t)(row0 + ai * 128 + m * 16) * 1024 + cc0 + bj * 128;
                    *(f32x4*)(out + o) = xv[m][bj][0] + acc[ai][bj][m][0]; *(f32x4*)(out + o + 4) = xv[m][bj][1] + acc[ai][bj][m][1]; }
        }
    }
};

__device__ __forceinline__ int g1_srccol(int p) {
    switch (p) { case 0: return 4096; case 1: return 8200; case 2: return 0; case 3: return 1024; case 4: return 2048; case 5: return 3072; case 6: return 5128; case 7: return 6152; default: return 7176; } }

__device__ __forceinline__ void transpose_tile(const float* __restrict__ src, int pitch, bf16_t* __restrict__ dst, LAS float* scr, int tid) {
#pragma unroll
    for (int i = 0; i < 2; ++i) { const int r = (tid >> 4) + 32 * i, c4 = tid & 15; const f32x4 v = *(const f32x4*)(src + (size_t)r * pitch + c4 * 4);
        scr[r * 65 + c4 * 4 + 0] = v[0]; scr[r * 65 + c4 * 4 + 1] = v[1]; scr[r * 65 + c4 * 4 + 2] = v[2]; scr[r * 65 + c4 * 4 + 3] = v[3]; }
    __syncthreads();
    { const int n = tid >> 3, kc = tid & 7; float v[8];
#pragma unroll
      for (int j = 0; j < 8; ++j) v[j] = scr[(kc * 8 + j) * 65 + n];
      u32x4 w; w.x = pk2(v[0], v[1]); w.y = pk2(v[2], v[3]); w.z = pk2(v[4], v[5]); w.w = pk2(v[6], v[7]);
      *(u32x4*)(dst + (size_t)n * 1024 + kc * 8) = w; }
    __syncthreads();
}

__device__ __forceinline__ void phase_prep(const Args& a, int l, LAS unsigned char* lds, int tid) {
    unsigned char* ws = a.ws;
    const float* w_in = a.in[2] + (size_t)l * D * NIN;
    const float* w_br = a.in[10] + (size_t)l * 3 * D * D;
    const float* w_out = a.in[11] + (size_t)l * D * D;
    const float* pool_w = a.in[8] + (size_t)l * 4 * 256 * 256;
    const float* pool_s = a.in[9] + (size_t)l * D;
    LAS float* scr = (LAS float*)lds;
    for (int base = blockIdx.x * 4; base < 17 * 256; base += gridDim.x * 4) {
        f32x4 tv[4][2];
#pragma unroll
        for (int q = 0; q < 4; ++q) {
            const int it = base + q, id = it >> 8, nt = (it & 255) >> 4, kt = it & 15;
            const float* src; int pitch;
            if (id < 9)       { src = w_in + (size_t)(kt * 64) * NIN + g1_srccol(id) + nt * 64; pitch = NIN; }
            else if (id < 13) { const int qq = id - 9; const int col = (qq == 0) ? 10256 : 11280 + (qq - 1) * 1024; src = w_in + (size_t)(kt * 64) * NIN + col + nt * 64; pitch = NIN; }
            else if (id < 16) { const int n = id - 13; src = w_br + (size_t)n * D * D + (size_t)(kt * 64) * D + nt * 64; pitch = D; }
            else              { src = w_out + (size_t)(kt * 64) * D + nt * 64; pitch = D; }
#pragma unroll
            for (int i = 0; i < 2; ++i) { const int r = (tid >> 4) + 32 * i, c4 = tid & 15; tv[q][i] = *(const f32x4*)(src + (size_t)r * pitch + c4 * 4); }
        }
#pragma unroll
        for (int q = 0; q < 4; ++q)
#pragma unroll
            for (int i = 0; i < 2; ++i) { const int r = (tid >> 4) + 32 * i, c4 = tid & 15; LAS float* d = scr + q * 4160 + r * 65 + c4 * 4; d[0] = tv[q][i][0]; d[1] = tv[q][i][1]; d[2] = tv[q][i][2]; d[3] = tv[q][i][3]; }
        __syncthreads();
#pragma unroll
        for (int q = 0; q < 4; ++q) {
            const int it = base + q, id = it >> 8, nt = (it & 255) >> 4, kt = it & 15;
            bf16_t* dst;
            if (id < 9)       dst = (bf16_t*)(ws + OFF_WT1) + (size_t)(id * 1024 + nt * 64) * 1024 + kt * 64;
            else if (id < 13) { const int qq = id - 9; const int prow = (qq == 0) ? 0 : qq + 1; dst = (bf16_t*)(ws + OFF_WT1B) + (size_t)(prow * 1024 + nt * 64) * 1024 + kt * 64; }
            else if (id < 16) { const int n = id - 13; dst = (bf16_t*)(ws + OFF_WT2) + (size_t)(n * 1024 + nt * 64) * 1024 + kt * 64; }
            else              dst = (bf16_t*)(ws + OFF_WT3) + (size_t)(nt * 64) * 1024 + kt * 64;
            const int n = tid >> 3, kc = tid & 7; float v[8];
#pragma unroll
            for (int j = 0; j < 8; ++j) v[j] = scr[q * 4160 + (kc * 8 + j) * 65 + n];
            u32x4 w; w.x = pk2(v[0], v[1]); w.y = pk2(v[2], v[3]); w.z = pk2(v[4], v[5]); w.w = pk2(v[6], v[7]);
            *(u32x4*)(dst + (size_t)n * 1024 + kc * 8) = w;
        }
        __syncthreads();
    }
    for (int it = blockIdx.x; it < 256; it += gridDim.x) {
        const int g = it >> 6, kt = (it & 63) >> 2, dt = it & 3;
        LAS float* As = scr; LAS float* Bs = scr + 64 * 65;
        float acc[8];
#pragma unroll
        for (int j = 0; j < 8; ++j) acc[j] = 0.f;
        for (int cc = 0; cc < 4; ++cc) {
#pragma unroll
            for (int i = 0; i < 2; ++i) { const int r = (tid >> 4) + 32 * i, c4 = tid & 15;
                const f32x4 va = *(const f32x4*)(w_in + (size_t)(kt * 64 + r) * NIN + 9232 + g * 256 + cc * 64 + c4 * 4);
                As[r * 65 + c4 * 4 + 0] = va[0]; As[r * 65 + c4 * 4 + 1] = va[1]; As[r * 65 + c4 * 4 + 2] = va[2]; As[r * 65 + c4 * 4 + 3] = va[3];
                const f32x4 vb = *(const f32x4*)(pool_w + (size_t)(g * 256 + cc * 64 + r) * 256 + dt * 64 + c4 * 4);
                Bs[r * 64 + c4 * 4 + 0] = vb[0]; Bs[r * 64 + c4 * 4 + 1] = vb[1]; Bs[r * 64 + c4 * 4 + 2] = vb[2]; Bs[r * 64 + c4 * 4 + 3] = vb[3]; }
            __syncthreads();
            const int d = tid & 63, kg = tid >> 6;
            for (int c = 0; c < 64; ++c) { const float bv = Bs[c * 64 + d];
#pragma unroll
                for (int j = 0; j < 8; ++j) acc[j] += As[(kg * 8 + j) * 65 + c] * bv; }
            __syncthreads();
        }
        const int d = tid & 63, kg = tid >> 6;
        const float sc = pool_s[g * 256 + dt * 64 + d];
        u32x4 w; w.x = pk2(acc[0] * sc, acc[1] * sc); w.y = pk2(acc[2] * sc, acc[3] * sc); w.z = pk2(acc[4] * sc, acc[5] * sc); w.w = pk2(acc[6] * sc, acc[7] * sc);
        *(u32x4*)((bf16_t*)(ws + OFF_WT1B) + (size_t)(1024 + g * 256 + dt * 64 + d) * 1024 + kt * 64 + kg * 8) = w;
    }
    if (blockIdx.x == 0 && tid < 16) { ((unsigned*)(ws + OFF_KN2))[tid] = 0u; ((unsigned*)(ws + OFF_QCTR))[tid] = 0u; }
    LAS float* gw = (LAS float*)lds;
    __syncthreads();
    for (int e = tid; e < 16 * 1024; e += 512) { const int c = e & 15, k = e >> 4; const int col = (c < 8) ? 5120 + c : 9224 + (c - 8); gw[c * 1024 + k] = w_in[(size_t)k * NIN + col]; }
    __syncthreads();
    {
        const float* xin = (l == 0) ? a.in[0] : a.out;
        const float* ng = a.in[1] + (size_t)l * D;
        bf16_t* hb = (bf16_t*)(ws + 10 * PLANE);
        float* gates = (float*)(ws + OFF_GATES);
        const int wid = tid >> 6, lane = tid & 63;
        f32x4 gg[4];
#pragma unroll
        for (int j = 0; j < 4; ++j) gg[j] = *(const f32x4*)(ng + j * 256 + lane * 4);
        for (int row0 = blockIdx.x * 8 + wid; row0 < M; row0 += gridDim.x * 16) {
            const int row1 = row0 + gridDim.x * 8;
            f32x4 xa[2][4];
#pragma unroll
            for (int j = 0; j < 4; ++j) { xa[0][j] = *(const f32x4*)(xin + (size_t)row0 * D + j * 256 + lane * 4); xa[1][j] = (row1 < M) ? *(const f32x4*)(xin + (size_t)row1 * D + j * 256 + lane * 4) : (f32x4){0.f, 0.f, 0.f, 0.f}; }
#pragma unroll
            for (int rr = 0; rr < 2; ++rr) {
                const int row = rr ? row1 : row0;
                if (row >= M) continue;
                f32x4 xv[4]; float ss = 0.f;
#pragma unroll
                for (int j = 0; j < 4; ++j) { xv[j] = xa[rr][j]; ss += xv[j][0] * xv[j][0] + xv[j][1] * xv[j][1] + xv[j][2] * xv[j][2] + xv[j][3] * xv[j][3]; }
                ss = wave_sum(ss);
                const float r = rsqrtf(ss * (1.f / 1024.f) + EPS);
#pragma unroll
                for (int j = 0; j < 4; ++j) { xv[j] = (xv[j] * r) * gg[j]; u32x2 w; w.x = pk2(xv[j][0], xv[j][1]); w.y = pk2(xv[j][2], xv[j][3]); *(u32x2*)(hb + (size_t)row * D + j * 256 + lane * 4) = w; }
                float ga[16];
#pragma unroll
                for (int c = 0; c < 16; ++c) { float s = 0.f;
#pragma unroll
                    for (int j = 0; j < 4; ++j) { const f32x4 wv = *(const LAS f32x4*)(gw + c * 1024 + j * 256 + lane * 4); s += xv[j][0] * wv[0] + xv[j][1] * wv[1] + xv[j][2] * wv[2] + xv[j][3] * wv[3]; }
                    ga[c] = s; }
                float b8[8], b4[4], b2[2], b1;
#pragma unroll
                for (int i = 0; i < 8; ++i) { const bool hi_ = (lane & 32) != 0; const float send = hi_ ? ga[i] : ga[i + 8], keep = hi_ ? ga[i + 8] : ga[i]; b8[i] = keep + __shfl_xor(send, 32); }
#pragma unroll
                for (int i = 0; i < 4; ++i) { const bool hi_ = (lane & 16) != 0; const float send = hi_ ? b8[i] : b8[i + 4], keep = hi_ ? b8[i + 4] : b8[i]; b4[i] = keep + __shfl_xor(send, 16); }
#pragma unroll
                for (int i = 0; i < 2; ++i) { const bool hi_ = (lane & 8) != 0; const float send = hi_ ? b4[i] : b4[i + 2], keep = hi_ ? b4[i + 2] : b4[i]; b2[i] = keep + __shfl_xor(send, 8); }
                { const bool hi_ = (lane & 4) != 0; const float send = hi_ ? b2[0] : b2[1], keep = hi_ ? b2[1] : b2[0]; b1 = keep + __shfl_xor(send, 4); }
                b1 += __shfl_xor(b1, 2); b1 += __shfl_xor(b1, 1);
                if ((lane & 3) == 0) gates[(size_t)row * 16 + ((lane >> 2) & 15)] = b1;
            }
        }
    }
    __syncthreads();
}

__device__ __forceinline__ float block_excl_scan_add(float tot, LAS float* sm, int tid) {
    const int lane = tid & 63, wid = tid >> 6; float x = tot;
#pragma unroll
    for (int o = 1; o < 64; o <<= 1) { const float v = __shfl_up(x, o); if (lane >= o) x += v; }
    __syncthreads();
    if (lane == 63) sm[wid] = x;
    __syncthreads();
    float base = 0.f;
    for (int w = 0; w < wid; ++w) base += sm[w];
    return base + x - tot;
}
__device__ __forceinline__ float block_excl_scan_max(float tot, LAS float* sm, int tid) {
    const int lane = tid & 63, wid = tid >> 6; float x = tot;
#pragma unroll
    for (int o = 1; o < 64; o <<= 1) { const float v = __shfl_up(x, o); if (lane >= o) x = fmaxf(x, v); }
    __syncthreads();
    if (lane == 63) sm[wid] = x;
    __syncthreads();
    float base = -INFINITY;
    for (int w = 0; w < wid; ++w) base = fmaxf(base, sm[w]);
    const float prev = __shfl_up(x, 1);
    return fmaxf(base, lane ? prev : -INFINITY);
}
__device__ __forceinline__ void phase_scans(const Args& a, int l, LAS unsigned char* lds, int tid) {
    unsigned char* ws = a.ws; const float* gates = (const float*)(ws + OFF_GATES);
    LAS float* sm = (LAS float*)lds;
    LAS float* Fs = sm + 64; LAS float* As = Fs + 8192; LAS float* Ms = As + 8192;
    const int bx = blockIdx.x;
    if (bx < 8) {
        const int b = bx >> 2, h = bx & 3; const float bi = a.in[4][l * 4 + h], bfv = a.in[5][l * 4 + h];
        float run = 0.f;
#pragma unroll 2
        for (int i = 0; i < 16; ++i) { const size_t row = (size_t)b * S + tid * 16 + i; run += logsig(gates[row * 16 + 4 + h] + bfv); Fs[tid * 16 + i] = run; }
        const float pre = block_excl_scan_add(run, sm, tid);
        float mx = -INFINITY;
#pragma unroll 2
        for (int i = 0; i < 16; ++i) { const size_t row = (size_t)b * S + tid * 16 + i; const float F = Fs[tid * 16 + i] + pre; const float av = gates[row * 16 + h] + bi - F;
            Fs[tid * 16 + i] = F; As[tid * 16 + i] = av; mx = fmaxf(mx, av); }
        const float pm = block_excl_scan_max(mx, sm + 16, tid);
        float Mrun = fmaxf(pm, 0.f);
#pragma unroll 2
        for (int i = 0; i < 16; ++i) { Mrun = fmaxf(Mrun, As[tid * 16 + i]); Ms[tid * 16 + i] = Mrun; }
        __syncthreads();
        if ((tid & 31) == 31) sm[32 + (tid >> 5)] = Mrun;
        __syncthreads();
        const float Mend = sm[32 + (tid >> 5)];
        float* A2 = (float*)(ws + OFF_A2) + (size_t)bx * S + tid * 16; float* M2 = (float*)(ws + OFF_M2) + (size_t)bx * S + tid * 16;
        float* EM = (float*)(ws + OFF_EM) + (size_t)bx * S + tid * 16; float* WK = (float*)(ws + OFF_WK) + (size_t)bx * S + tid * 16;
#pragma unroll 2
        for (int i = 0; i < 16; ++i) { const float av = As[tid * 16 + i], Mv = Ms[tid * 16 + i], F = Fs[tid * 16 + i];
            A2[i] = av * LOG2E; M2[i] = Mv * LOG2E; EM[i] = expf(-(F + Mv)); WK[i] = expf(av - Mend); }
        float* MP = (float*)(ws + OFF_MP2) + bx * 32;
        if (tid == 0) MP[0] = 0.f;
        if (tid < 16) MP[tid + 1] = sm[32 + tid] * LOG2E;
        __syncthreads();
    } else if (bx < 24) {
        const int bh = bx - 8, b = bh >> 3, h = bh & 7; const float bfv = a.in[7][l * 8 + h];
        float run = 0.f;
#pragma unroll 2
        for (int i = 0; i < 16; ++i) { const size_t row = (size_t)b * S + tid * 16 + i; run += logsig(gates[row * 16 + 8 + h] + bfv); Fs[tid * 16 + i] = run; }
        const float pre = block_excl_scan_add(run, sm, tid);
        float* F2 = (float*)(ws + OFF_F2) + (size_t)bh * S + tid * 16;
#pragma unroll 2
        for (int i = 0; i < 16; ++i) F2[i] = (Fs[tid * 16 + i] + pre) * LOG2E;
        __syncthreads();
    }
}

__device__ __forceinline__ void phase_conv(const Args& a, int l, LAS unsigned char* lds, int tid) {
    const bool dry = PROBE_RPT ? (a.dry != 0) : false;
    unsigned char* ws = a.ws;
    const float* cw = a.in[3] + (size_t)l * 4 * 2048;
    const bf16_t* halo = (const bf16_t*)(ws + OFF_HALO);
    const float* WK = (const float*)(ws + OFF_WK);
    LAS float* raw = (LAS float*)lds;
    LAS float* tb = raw + 67 * 65 + 3;
    const int r = tid >> 3, c8 = (tid & 7) * 8;
    u32x4 pv = (u32x4){0u, 0u, 0u, 0u}, ph = (u32x4){0u, 0u, 0u, 0u};
    auto issue = [&](int it) {
        const int tt = it >> 5, cs = it & 31;
        const bf16_t* pl = (const bf16_t*)(ws + (size_t)((cs >= 16) ? 4 : 3) * PLANE);
        pv = *(const u32x4*)(pl + (size_t)(tt * 64 + r) * 1024 + (cs & 15) * 64 + c8);
        if (tid < 24 && (tt & 127) != 0) ph = *(const u32x4*)(halo + ((size_t)(tt - 1) * 3 + (tid >> 3)) * 2048 + cs * 64 + c8);
        else ph = (u32x4){0u, 0u, 0u, 0u};
    };
    if (blockIdx.x < 256 * 32) issue(blockIdx.x);
    for (int it = blockIdx.x; it < 256 * 32; it += gridDim.x) {
        const int tt = it >> 5, cs = it & 31;
        const bool isk = cs >= 16;
        bf16_t* pl = (bf16_t*)(ws + (size_t)(isk ? 4 : 3) * PLANE);
        const int c0 = (cs & 15) * 64;
        { const u32x4 v = pv; LAS float* d = raw + (r + 3) * 65 + c8;
          d[0] = bflo(v.x); d[1] = bfhi(v.x); d[2] = bflo(v.y); d[3] = bfhi(v.y); d[4] = bflo(v.z); d[5] = bfhi(v.z); d[6] = bflo(v.w); d[7] = bfhi(v.w); }
        if (tid < 24) { const u32x4 v = ph; LAS float* d = raw + (tid >> 3) * 65 + c8;
            d[0] = bflo(v.x); d[1] = bfhi(v.x); d[2] = bflo(v.y); d[3] = bfhi(v.y); d[4] = bflo(v.z); d[5] = bfhi(v.z); d[6] = bflo(v.w); d[7] = bfhi(v.w); }
        __syncthreads();
        if (it + (int)gridDim.x < 256 * 32) issue(it + gridDim.x);
        float o[8];
        { const int gc = cs * 64 + c8;
#pragma unroll
          for (int j = 0; j < 8; ++j) { float s = 0.f;
#pragma unroll
              for (int kk = 0; kk < 4; ++kk) s += cw[kk * 2048 + gc + j] * raw[(r + kk) * 65 + c8 + j];
              o[j] = silu(s); } }
        if (!isk) {
#pragma unroll
            for (int j = 0; j < 8; ++j) o[j] *= 0.0625f;
        }
        { u32x4 w; w.x = pk2(o[0], o[1]); w.y = pk2(o[2], o[3]); w.z = pk2(o[4], o[5]); w.w = pk2(o[6], o[7]);
          if (!dry) *(u32x4*)(pl + (size_t)(tt * 64 + r) * 1024 + c0 + c8) = w; }
        if (isk) {
            const int b = tt >> 7, t0 = (tt & 127) * 64, hh = c0 >> 8;
            const float wk = WK[(size_t)(b * 4 + hh) * S + t0 + r];
#pragma unroll
            for (int j = 0; j < 8; ++j) tb[(c8 + j) * 65 + r] = o[j] * wk;
            __syncthreads();
            const int c = tid >> 3, t8 = (tid & 7) * 8;
            float v[8];
#pragma unroll
            for (int j = 0; j < 8; ++j) v[j] = tb[c * 65 + t8 + j];
            u32x4 w; w.x = pk2(v[0], v[1]); w.y = pk2(v[2], v[3]); w.z = pk2(v[4], v[5]); w.w = pk2(v[6], v[7]);
            if (!dry) *(u32x4*)((bf16_t*)(ws + 11 * PLANE) + (size_t)(b * 1024 + c0 + c) * 8192 + t0 + t8) = w;
        }
        __syncthreads();
    }
    {
        LAS unsigned* smx = (LAS unsigned*)lds;
        if (tid < 16) smx[tid] = 0u;
        __syncthreads();
        const int wid = tid >> 6, lane = tid & 63;
        const bf16_t* bk = (const bf16_t*)(ws + 8 * PLANE);
        float m0 = 0.f, m1 = 0.f;
        for (int rowb_ = blockIdx.x * 8 + wid; rowb_ < M; rowb_ += gridDim.x * 32) {
          u32x4 kv[4][2];
#pragma unroll
          for (int u = 0; u < 4; ++u) { const int row = rowb_ + u * gridDim.x * 8; if (row < M) { kv[u][0] = *(const u32x4*)(bk + (size_t)row * 1024 + lane * 16); kv[u][1] = *(const u32x4*)(bk + (size_t)row * 1024 + lane * 16 + 8); } else { kv[u][0] = (u32x4){0u,0u,0u,0u}; kv[u][1] = (u32x4){0u,0u,0u,0u}; } }
#pragma unroll
          for (int u = 0; u < 4; ++u) {
            const int row = rowb_ + u * gridDim.x * 8; if (row >= M) continue;
            const u32x4 v0 = kv[u][0], v1 = kv[u][1];
            float s = bflo(v0.x) * bflo(v0.x) + bfhi(v0.x) * bfhi(v0.x) + bflo(v0.y) * bflo(v0.y) + bfhi(v0.y) * bfhi(v0.y) + bflo(v0.z) * bflo(v0.z) + bfhi(v0.z) * bfhi(v0.z) + bflo(v0.w) * bflo(v0.w) + bfhi(v0.w) * bfhi(v0.w)
                    + bflo(v1.x) * bflo(v1.x) + bfhi(v1.x) * bfhi(v1.x) + bflo(v1.y) * bflo(v1.y) + bfhi(v1.y) * bfhi(v1.y) + bflo(v1.z) * bflo(v1.z) + bfhi(v1.z) * bfhi(v1.z) + bflo(v1.w) * bflo(v1.w) + bfhi(v1.w) * bfhi(v1.w);
            s += __shfl_xor(s, 1); s += __shfl_xor(s, 2); s += __shfl_xor(s, 4);
            if (row < S) m0 = fmaxf(m0, s); else m1 = fmaxf(m1, s);
          }
        }
        if ((lane & 7) == 0) { __hip_atomic_fetch_max((unsigned*)(smx + (lane >> 3)), __float_as_uint(m0), __ATOMIC_RELAXED, __HIP_MEMORY_SCOPE_WORKGROUP); __hip_atomic_fetch_max((unsigned*)(smx + 8 + (lane >> 3)), __float_as_uint(m1), __ATOMIC_RELAXED, __HIP_MEMORY_SCOPE_WORKGROUP); }
        __syncthreads();
        if (tid < 16) __hip_atomic_fetch_max((unsigned*)(ws + OFF_KN2) + tid, smx[tid], __ATOMIC_RELAXED, __HIP_MEMORY_SCOPE_AGENT);
        __syncthreads();
    }
}

__device__ __forceinline__ void phase_statescan(const Args& a, int tid) {
    const bool dry = PROBE_RPT ? (a.dry != 0) : false;
    unsigned char* ws = a.ws;
    const float* MP = (const float*)(ws + OFF_MP2);
    bf16_t* Cst = (bf16_t*)(ws + OFF_CST);
    for (int grp = blockIdx.x * 512 + tid; grp < 8 * 16384; grp += gridDim.x * 512) {
        const int bh = grp >> 14, e = (grp & 16383) * 4;
        u32x2 dv[16];
#pragma unroll
        for (int c = 0; c < 16; ++c) dv[c] = *(const u32x2*)(Cst + ((size_t)(bh * 16 + c) * 65536 + e));
        float C0 = 0.f, C1 = 0.f, C2 = 0.f, C3 = 0.f;
#pragma unroll
        for (int c = 0; c < 16; ++c) {
            u32x2 w; w.x = pk2(C0, C1); w.y = pk2(C2, C3); if (!dry) *(u32x2*)(Cst + ((size_t)(bh * 16 + c) * 65536 + e)) = w;
            const float dec = exp2f(MP[bh * 32 + c] - MP[bh * 32 + c + 1]);
            C0 = dec * C0 + bflo(dv[c].x); C1 = dec * C1 + bfhi(dv[c].x); C2 = dec * C2 + bflo(dv[c].y); C3 = dec * C3 + bfhi(dv[c].y);
        }
    }
    const int wid = tid >> 6, lane = tid & 63;
    bf16_t* nst = (bf16_t*)(ws + OFF_NST);
    for (int gwv = blockIdx.x * 8 + wid; gwv < 2048; gwv += gridDim.x * 8) {
        const int bh = gwv >> 8, k = gwv & 255;
        const bf16_t* row = (const bf16_t*)(ws + 11 * PLANE) + (size_t)((bh >> 2) * 1024 + (bh & 3) * 256 + k) * 8192;
        float n = 0.f;
        u32x4 nv[16];
#pragma unroll
        for (int c = 0; c < 16; ++c) nv[c] = *(const u32x4*)(row + c * 512 + lane * 8);
#pragma unroll
        for (int c = 0; c < 16; ++c) {
            const u32x4 v = nv[c];
            float s = bflo(v.x) + bfhi(v.x) + bflo(v.y) + bfhi(v.y) + bflo(v.z) + bfhi(v.z) + bflo(v.w) + bfhi(v.w);
            s = wave_sum(s);
            if (lane == 0) nst[(size_t)(bh * 16 + c) * 256 + k] = (bf16_t)(pk2(n, n) & 0xffff);
            const float dec = exp2f(MP[bh * 32 + c] - MP[bh * 32 + c + 1]);
            n = dec * n + s;
        }
    }
}

#define MFMA32(a, b, c) __builtin_amdgcn_mfma_f32_32x32x16_bf16(a, b, c, 0, 0, 0)
template <int MODE>
__device__ __forceinline__ void attn_unit(const Args& a, int l, int b, int h, int qb, LAS unsigned char* lds, int tid, const bool dry = false) {
    constexpr int DH = MODE ? 256 : 128, KS = DH / 16, QROWS = MODE ? 128 : 256, VROWS = DH, KP = DH * 2 + 16, VP = 136;
    constexpr int KCH = 64 * DH / 8 / 512, VCH = VROWS * 8 / 512;
    unsigned char* ws = a.ws;
    const int wid = __builtin_amdgcn_readfirstlane(tid >> 6), lane = tid & 63, l32 = lane & 31, hi = lane >> 5;
    const int rg = MODE ? (wid & 3) : wid, vh = MODE ? (wid >> 2) : 0;
    const int q0 = qb * QROWS + rg * 32, tq = q0 + l32;
    const bf16_t* Qp = (const bf16_t*)(ws + (size_t)(MODE ? 3 : 7) * PLANE);
    const bf16_t* Kp = (const bf16_t*)(ws + (size_t)(MODE ? 4 : 8) * PLANE);
    const bf16_t* VTp = (const bf16_t*)(ws + (size_t)(MODE ? 5 : 9) * PLANE);
    const int bh = MODE ? (b * 4 + h) : (b * 8 + h);
    const float* biasG = MODE ? ((const float*)(ws + OFF_A2) + (size_t)bh * S) : ((const float*)(ws + OFF_F2) + (size_t)bh * S);
    LAS unsigned char* Ks = lds; LAS unsigned char* Vs = lds + 64 * KP; LAS float* biasK = (LAS float*)(lds + 64 * KP + VROWS * VP); LAS float* red = biasK + 64;

    bf16x8 qf[MODE ? 1 : KS];
    LAS unsigned char* Qs = lds + 64 * KP + VROWS * VP + 256 + 1024;
    if (MODE) {
        __syncthreads();
#pragma unroll
        for (int i = 0; i < 8; ++i) { const int q = tid + i * 512, r = q >> 5, cc = q & 31;
            *(LAS u32x4*)(Qs + r * KP + cc * 16) = *(const u32x4*)(Qp + (size_t)(b * S + qb * QROWS + r) * 1024 + h * DH + cc * 8); }
        __syncthreads();
    } else {
#pragma unroll
        for (int ks = 0; ks < KS; ++ks) qf[ks] = *(const bf16x8*)(Qp + (size_t)(b * S + tq) * 1024 + h * DH + ks * 16 + hi * 8);
    }
#define QF(ks) (MODE ? *(const LAS bf16x8*)(Qs + (rg * 32 + l32) * KP + ((ks) * 16 + hi * 8) * 2) : qf[MODE ? 0 : (ks)])
    f32x16 O[4];
#pragma unroll
    for (int vb = 0; vb < 4; ++vb)
#pragma unroll
        for (int i = 0; i < 16; ++i) O[vb][i] = 0.f;
    float rowb = biasG[tq];
    float m_run = -INFINITY, l_run = 0.f, den_inter = 0.f, M2t = 0.f;
    int j0 = 0, j1 = qb * 4 + 3;
    if (MODE) {
        const int ch = qb >> 2; j0 = ch * 8; j1 = qb * 2 + 1;
        M2t = ((const float*)(ws + OFF_M2))[(size_t)bh * S + tq];
        const bf16_t* Cb = (const bf16_t*)(ws + OFF_CST) + (size_t)(bh * 16 + ch) * 65536;
#pragma unroll
        for (int vb = 0; vb < 4; ++vb)
#pragma unroll
            for (int ks = 0; ks < KS; ++ks) { const bf16x8 af = *(const bf16x8*)(Cb + (size_t)(vh * 128 + vb * 32 + l32) * 256 + ks * 16 + hi * 8); O[vb] = MFMA32(af, QF(ks), O[vb]); }
        f32x16 nacc;
#pragma unroll
        for (int i = 0; i < 16; ++i) nacc[i] = 0.f;
        const bf16_t* nb = (const bf16_t*)(ws + OFF_NST) + (size_t)(bh * 16 + ch) * 256;
#pragma unroll
        for (int ks = 0; ks < KS; ++ks) { bf16x8 af = *(const bf16x8*)(nb + ks * 16 + hi * 8); if (l32 != 0) af = (bf16x8){0, 0, 0, 0, 0, 0, 0, 0}; nacc = MFMA32(af, QF(ks), nacc); }
        const float nq = __shfl(nacc[0], l32);
        const float winter = exp2f(((const float*)(ws + OFF_MP2))[bh * 32 + ch] - M2t);
#pragma unroll
        for (int vb = 0; vb < 4; ++vb)
#pragma unroll
            for (int i = 0; i < 16; ++i) O[vb][i] *= winter;
        den_inter = winter * nq;
    }
    u32x4 kreg[KCH], vreg[VCH]; float breg = 0.f;
    auto gload = [&](int j) {
#pragma unroll
        for (int i = 0; i < KCH; ++i) { const int q = tid + i * 512, r = q / (DH / 8), cc = q % (DH / 8); kreg[i] = *(const u32x4*)(Kp + (size_t)(b * S + j * 64 + r) * 1024 + h * DH + cc * 8); }
#pragma unroll
        for (int i = 0; i < VCH; ++i) { const int q = tid + i * 512, r = q >> 3, cc = q & 7; vreg[i] = *(const u32x4*)(VTp + (size_t)(b * 1024 + h * DH + r) * 8192 + j * 64 + cc * 8); }
        if (tid < 64) breg = biasG[j * 64 + tid];
    };
    float Bt = 0.f;
    LAS int* flags = (LAS int*)red;
    if (!MODE) {
        float qs = 0.f;
#pragma unroll
        for (int ks = 0; ks < (MODE ? 1 : KS); ++ks)
#pragma unroll
            for (int e = 0; e < 8; ++e) { const float f = bf2f((unsigned short)qf[ks][e]); qs += f * f; }
        qs += __shfl_xor(qs, 32);
        const float kn2 = __uint_as_float(((const unsigned*)(ws + OFF_KN2))[bh]);
        Bt = sqrtf(qs * kn2) * 1.01f + rowb;
        gload(j1);
    }
    const int ntile = j1 - j0 + 1;
    for (int jt = 0; jt < ntile; ++jt) {
        const int j = MODE ? (j0 + jt) : (j1 - jt);
        __syncthreads();
        if (!MODE && jt > 0) { const int any = flags[0] | flags[1] | flags[2] | flags[3] | flags[4] | flags[5] | flags[6] | flags[7]; if (!any) break; }
        if (MODE) gload(j);
#pragma unroll
        for (int i = 0; i < KCH; ++i) { const int q = tid + i * 512, r = q / (DH / 8), cc = q % (DH / 8); *(LAS u32x4*)(Ks + r * KP + cc * 16) = kreg[i]; }
#pragma unroll
        for (int i = 0; i < VCH; ++i) { const int q = tid + i * 512, r = q >> 3, cc = q & 7; *(LAS u32x2*)(Vs + r * VP + cc * 16) = (u32x2){vreg[i].x, vreg[i].y}; *(LAS u32x2*)(Vs + r * VP + cc * 16 + 8) = (u32x2){vreg[i].z, vreg[i].w}; }
        if (tid < 64) biasK[tid] = breg;
        __syncthreads();
        if (!MODE && j > 0) gload(j - 1);
        if (j * 64 <= q0 + 31) {
            bf16x8 pb[2][2];
            const bool diag = (j * 64 + 63 > q0);
            if (MODE) {
                float ls = 0.f;
#pragma unroll
                for (int kb = 0; kb < 2; ++kb) {
                    f32x16 s1;
#pragma unroll
                    for (int i = 0; i < 16; ++i) s1[i] = 0.f;
#pragma unroll
                    for (int ks = 0; ks < KS; ++ks) { const bf16x8 af = *(const LAS bf16x8*)(Ks + (kb * 32 + l32) * KP + (ks * 16 + hi * 8) * 2); s1 = MFMA32(af, QF(ks), s1); }
#pragma unroll
                    for (int i4 = 0; i4 < 4; ++i4) { const f32x4 bk = *(const LAS f32x4*)(biasK + kb * 32 + 8 * i4 + 4 * hi);
#pragma unroll
                        for (int r = 0; r < 4; ++r) { const int i = i4 * 4 + r; const int key = j * 64 + kb * 32 + 8 * i4 + 4 * hi + r;
                            float w = exp2f(bk[r] - M2t); if (diag && key > tq) w = 0.f;
                            const float p = s1[i] * w; s1[i] = p; ls += p; } }
#pragma unroll
                    for (int jj = 0; jj < 2; ++jj) {
                        u32x4 w; w.x = pk2(s1[8 * jj + 0], s1[8 * jj + 1]); w.y = pk2(s1[8 * jj + 2], s1[8 * jj + 3]);
                        w.z = pk2(s1[8 * jj + 4], s1[8 * jj + 5]); w.w = pk2(s1[8 * jj + 6], s1[8 * jj + 7]);
                        pb[kb][jj] = __builtin_bit_cast(bf16x8, w);
                    }
                }
                l_run += ls;
            } else {
            f32x16 s[2];
#pragma unroll
            for (int kb = 0; kb < 2; ++kb) {
#pragma unroll
                for (int i4 = 0; i4 < 4; ++i4) { const f32x4 bk = *(const LAS f32x4*)(biasK + kb * 32 + 8 * i4 + 4 * hi);
#pragma unroll
                    for (int r = 0; r < 4; ++r) s[kb][i4 * 4 + r] = rowb - bk[r]; }
#pragma unroll
                for (int ks = 0; ks < KS; ++ks) { const bf16x8 af = *(const LAS bf16x8*)(Ks + (kb * 32 + l32) * KP + (ks * 16 + hi * 8) * 2); s[kb] = MFMA32(af, QF(ks), s[kb]); }
            }
            {
                if (diag) {
#pragma unroll
                    for (int kb = 0; kb < 2; ++kb)
#pragma unroll
                        for (int i = 0; i < 16; ++i) { const int key = j * 64 + kb * 32 + crow(i, hi); if (key > tq) s[kb][i] = -INFINITY; }
                }
                float mx = -INFINITY;
#pragma unroll
                for (int kb = 0; kb < 2; ++kb)
#pragma unroll
                    for (int i = 0; i < 16; ++i) mx = fmaxf(mx, s[kb][i]);
                mx = fmaxf(mx, __shfl_xor(mx, 32));
                const float m_new = fmaxf(m_run, mx);
                const float alpha = exp2f(m_run - m_new);
                float ls = 0.f;
#pragma unroll
                for (int kb = 0; kb < 2; ++kb)
#pragma unroll
                    for (int i = 0; i < 16; ++i) { const float p = exp2f(s[kb][i] - m_new); s[kb][i] = p; ls += p; }
                l_run = l_run * alpha + ls; m_run = m_new;
#pragma unroll
                for (int vb = 0; vb < 4; ++vb)
#pragma unroll
                    for (int i = 0; i < 16; ++i) O[vb][i] *= alpha;
            }
#pragma unroll
            for (int kb = 0; kb < 2; ++kb)
#pragma unroll
                for (int jj = 0; jj < 2; ++jj) {
                    u32x4 w; w.x = pk2(s[kb][8 * jj + 0], s[kb][8 * jj + 1]); w.y = pk2(s[kb][8 * jj + 2], s[kb][8 * jj + 3]);
                    w.z = pk2(s[kb][8 * jj + 4], s[kb][8 * jj + 5]); w.w = pk2(s[kb][8 * jj + 6], s[kb][8 * jj + 7]);
                    pb[kb][jj] = __builtin_bit_cast(bf16x8, w);
                }
            }
#pragma unroll
            for (int vb = 0; vb < 4; ++vb)
#pragma unroll
                for (int kb = 0; kb < 2; ++kb)
#pragma unroll
                    for (int jj = 0; jj < 2; ++jj) {
                        const LAS unsigned char* vp = Vs + (vh * 128 + vb * 32 + l32) * VP + (kb * 32 + 16 * jj + 4 * hi) * 2;
                        const u32x2 lo = *(const LAS u32x2*)vp, hi2 = *(const LAS u32x2*)(vp + 16);
                        const u32x4 w = (u32x4){lo.x, lo.y, hi2.x, hi2.y};
                        O[vb] = MFMA32(__builtin_bit_cast(bf16x8, w), pb[kb][jj], O[vb]);
                    }
        }
        if (!MODE && j > 0) {
            const float fk_last = biasG[(j - 1) * 64 + 63];
            const bool need = !((Bt - fk_last) - m_run < -160.f);
            const unsigned long long bal = __ballot(need);
            if (lane == 0) flags[wid] = (bal != 0ull) ? 1 : 0;
        }
    }
    const size_t rowoff = (size_t)(b * S + tq) * 1024;
    if (!MODE) {
        const float lt = l_run + __shfl_xor(l_run, 32);
        const float inv = 1.f / lt;
        bf16_t* bz = (bf16_t*)(ws + 1 * PLANE) + rowoff + h * 128;
#pragma unroll
        for (int vb = 0; vb < 4; ++vb)
#pragma unroll
            for (int i4 = 0; i4 < 4; ++i4) {
                bf16_t* p = bz + vb * 32 + 8 * i4 + 4 * hi;
                const u32x2 z = *(const u32x2*)p;
                u32x2 w; w.x = pk2(O[vb][i4 * 4 + 0] * inv * silu(bflo(z.x)), O[vb][i4 * 4 + 1] * inv * silu(bfhi(z.x)));
                w.y = pk2(O[vb][i4 * 4 + 2] * inv * silu(bflo(z.y)), O[vb][i4 * 4 + 3] * inv * silu(bfhi(z.y)));
                if (!dry) *(u32x2*)p = w;
            }
    } else {
        const float den = l_run + __shfl_xor(l_run, 32) + den_inter;
        const float em = ((const float*)(ws + OFF_EM))[(size_t)bh * S + tq];
        const float invd = 1.f / fmaxf(fabsf(den), em);
        float ssq = 0.f;
#pragma unroll
        for (int vb = 0; vb < 4; ++vb)
#pragma unroll
            for (int i = 0; i < 16; ++i) { O[vb][i] *= invd; ssq += O[vb][i] * O[vb][i]; }
        ssq += __shfl_xor(ssq, 32);
        if (hi == 0) red[(vh * 4 + rg) * 32 + l32] = ssq;
        __syncthreads();
        const float tot = red[rg * 32 + l32] + red[(4 + rg) * 32 + l32];
        const float rs = rsqrtf(tot * (1.f / 256.f) + EPS);
        const float* ng = a.in[6] + (size_t)l * D + h * 256 + vh * 128;
        bf16_t* az = (bf16_t*)(ws) + rowoff + h * 256 + vh * 128;
        const bf16_t* ao = (const bf16_t*)(ws + 6 * PLANE) + rowoff + h * 256 + vh * 128;
#pragma unroll
        for (int vb = 0; vb < 4; ++vb)
#pragma unroll
            for (int i4 = 0; i4 < 4; ++i4) {
                const int v = vb * 32 + 8 * i4 + 4 * hi;
                const u32x2 z = *(const u32x2*)(az + v), o = *(const u32x2*)(ao + v);
                const f32x4 g = *(const f32x4*)(ng + v);
                u32x2 w;
                w.x = pk2(O[vb][i4 * 4 + 0] * rs * g[0] * sigm(bflo(o.x)) * silu(bflo(z.x)), O[vb][i4 * 4 + 1] * rs * g[1] * sigm(bfhi(o.x)) * silu(bfhi(z.x)));
                w.y = pk2(O[vb][i4 * 4 + 2] * rs * g[2] * sigm(bflo(o.y)) * silu(bflo(z.y)), O[vb][i4 * 4 + 3] * rs * g[3] * sigm(bfhi(o.y)) * silu(bfhi(z.y)));
                if (!dry) *(u32x2*)(az + v) = w;
            }
    }
}

__device__ __forceinline__ void phase_attn(const Args& a, int l, LAS unsigned char* lds, int tid, const bool dry = false) {
    LAS int* slot = (LAS int*)(lds + LDS_BYTES - 16);
    unsigned* ctr = (unsigned*)(a.ws + OFF_QCTR) + (dry ? 2 : 0);
    if ((ATTNMASK & 1) && (!dry || (PROBE_DRYMASK & 1))) {
        for (;;) {
            __syncthreads();
            if (tid == 0) *slot = (int)__hip_atomic_fetch_add(ctr, 1u, __ATOMIC_RELAXED, __HIP_MEMORY_SCOPE_AGENT);
            __syncthreads();
            const int idx = *slot;
            if (idx >= 512) break;
            const int h = 7 - (idx >> 6), r = idx & 63;
            attn_unit<0>(a, l, r & 1, h, 31 - (r >> 1), lds, tid, dry);
        }
    }
    __syncthreads();
    if ((ATTNMASK & 2) && (!dry || (PROBE_DRYMASK & 2))) {
        int t2 = tid; asm volatile("" : "+v"(t2));
        for (;;) {
            __syncthreads();
            if (t2 == 0) *slot = (int)__hip_atomic_fetch_add(ctr + 1, 1u, __ATOMIC_RELAXED, __HIP_MEMORY_SCOPE_AGENT);
            __syncthreads();
            const int idx = *slot;
            if (idx >= 512) break;
            const int qm = 3 - (idx >> 7), r = idx & 127, bh = r & 7, ch = r >> 3;
            attn_unit<1>(a, l, bh >> 2, bh & 3, ch * 4 + qm, lds, t2, dry);
        }
    }
    __syncthreads();
}

__device__ __forceinline__ void phase_pool(const Args& a, int tid) {
    const bool dry = PROBE_RPT ? (a.dry != 0) : false;
    unsigned char* ws = a.ws;
    const bf16_t* cu = (const bf16_t*)(ws + 3 * PLANE); bf16_t* cz = (bf16_t*)(ws + 2 * PLANE);
    for (int idx = blockIdx.x * 512 + tid; idx < (M / 4) * 128; idx += gridDim.x * 512) {
        const int r0 = (idx >> 7) * 4, c = (idx & 127) * 8, g = c >> 8, W = 2 << g, t0 = r0 & 8191;
        u32x4 xv[19], zv[4];
#pragma unroll
        for (int i = 0; i < 19; ++i) { const int dt = i - 15; xv[i] = (dt >= 1 - W && t0 + dt >= 0) ? *(const u32x4*)(cu + (size_t)(r0 + dt) * 1024 + c) : (u32x4){0u, 0u, 0u, 0u}; }
#pragma unroll
        for (int q = 0; q < 4; ++q) zv[q] = *(const u32x4*)(cz + (size_t)(r0 + q) * 1024 + c);
#pragma unroll
        for (int q = 0; q < 4; ++q) {
            const int t = t0 + q, cnt = (t + 1 < W) ? t + 1 : W;
            float s[8];
#pragma unroll
            for (int j = 0; j < 8; ++j) s[j] = 0.f;
#pragma unroll
            for (int k = 0; k < 16; ++k) { if (k < cnt) { const u32x4 v = xv[15 + q - k];
                s[0] += bflo(v.x); s[1] += bfhi(v.x); s[2] += bflo(v.y); s[3] += bfhi(v.y); s[4] += bflo(v.z); s[5] += bfhi(v.z); s[6] += bflo(v.w); s[7] += bfhi(v.w); } }
            const float ic = 1.f / (float)cnt;
            const u32x4 cv = xv[15 + q], z = zv[q];
            const float cur[8] = {bflo(cv.x), bfhi(cv.x), bflo(cv.y), bfhi(cv.y), bflo(cv.z), bfhi(cv.z), bflo(cv.w), bfhi(cv.w)};
            const float zf[8] = {bflo(z.x), bfhi(z.x), bflo(z.y), bfhi(z.y), bflo(z.z), bfhi(z.z), bflo(z.w), bfhi(z.w)};
            float o[8];
#pragma unroll
            for (int j = 0; j < 8; ++j) o[j] = (s[j] * ic - cur[j]) * silu(zf[j]);
            u32x4 w; w.x = pk2(o[0], o[1]); w.y = pk2(o[2], o[3]); w.z = pk2(o[4], o[5]); w.w = pk2(o[6], o[7]);
            if (!dry) *(u32x4*)(cz + (size_t)(r0 + q) * 1024 + c) = w;
        }
    }
}

__device__ __forceinline__ void phase_final(const Args& a, int tid) {
    const float* fg = a.in[12]; float* out = a.out;
    const int wid = tid >> 6, lane = tid & 63;
    f32x4 gg[4];
#pragma unroll
    for (int j = 0; j < 4; ++j) gg[j] = *(const f32x4*)(fg + j * 256 + lane * 4);
    for (int row = blockIdx.x * 8 + wid; row < M; row += gridDim.x * 8) {
        f32x4 xv[4]; float ss = 0.f;
#pragma unroll
        for (int j = 0; j < 4; ++j) { xv[j] = *(const f32x4*)(out + (size_t)row * D + j * 256 + lane * 4); ss += xv[j][0] * xv[j][0] + xv[j][1] * xv[j][1] + xv[j][2] * xv[j][2] + xv[j][3] * xv[j][3]; }
        ss = wave_sum(ss);
        const float r = rsqrtf(ss * (1.f / 1024.f) + EPS);
#pragma unroll
        for (int j = 0; j < 4; ++j) *(f32x4*)(out + (size_t)row * D + j * 256 + lane * 4) = (xv[j] * r) * gg[j];
    }
}

__global__ void __launch_bounds__(512) mega(Args a0) {
    extern __shared__ __attribute__((aligned(16))) unsigned char lds_raw[];
    LAS unsigned char* lds = (LAS unsigned char*)lds_raw;
    for (int ph = a0.ph_lo; ph < a0.ph_hi; ++ph) {
        Args a = a0; asm volatile("" : "+s"(a.ws), "+s"(a.out));
        unsigned char* ws = a.ws; int G = gridDim.x, cb = blockIdx.x; asm volatile("" : "+s"(G), "+s"(cb));
        int tid = threadIdx.x; asm volatile("" : "+v"(tid));
        const int l = ph / 10, k = (ph == 20) ? 10 : ph % 10;
        if (k == 0 && (PHMASK & 1)) phase_prep(a, l, lds, tid);
        else if (k == 1 && (PHMASK >> 1 & 1)) {
            phase_scans(a, l, lds, tid);
            pg8::Gemm g{(const bf16_t*)(ws + 10 * PLANE), (const bf16_t*)(ws + OFF_WT1), 1024, 1024, 1024};
            SchedStd Sd; Sd.init(64, 36, G, cb, 1024, 1024);
            EpiG1 E{ws};
            pg8::gemm_phase<EpiG1, SchedStd, true, true>(lds, g, Sd, E, tid);
        }
        else if (k == 2 && (PHMASK >> 2 & 1)) phase_conv(a, l, lds, tid);
        else if (k == 3 && (PHMASK >> 3 & 1)) {
            pg8::Gemm g{(const bf16_t*)(ws + 5 * PLANE), (const bf16_t*)(ws + 11 * PLANE), 8192, 8192, 512};
            SchedA1 Sd{G, cb};
            EpiPlain E{(bf16_t*)(ws + OFF_CST), 256, (size_t)65536, 0};
            pg8::gemm_phase<EpiPlain, SchedA1, true, true>(lds, g, Sd, E, tid);
        }
        else if (k == 4 && (PHMASK >> 4 & 1)) phase_statescan(a, tid);
        else if (k == 5 && (PHMASK >> 5 & 1)) phase_attn(a, l, lds, tid, PROBE_RPT ? (a.dry != 0) : false);
        else if (k == 6 && (PHMASK >> 6 & 1)) {
            pg8::Gemm g{(const bf16_t*)(ws + 10 * PLANE), (const bf16_t*)(ws + OFF_WT1B), 1024, 1024, 1024};
            SchedStd Sd; Sd.init(64, 20, G, cb, 1024, 1024);
            EpiPlain E{(bf16_t*)(ws + 2 * PLANE), 1024, (size_t)0, 1};
            pg8::gemm_phase<EpiPlain, SchedStd, true, true>(lds, g, Sd, E, tid);
        }
        else if (k == 7 && (PHMASK >> 7 & 1)) phase_pool(a, tid);
        else if (k == 8 && (PHMASK >> 8 & 1)) {
            pg8::Gemm g{(const bf16_t*)(ws), (const bf16_t*)(ws + OFF_WT2), 1024, 1024, 1024};
            SchedG2 Sd{G, cb};
            EpiG2 E{(const bf16_t*)(ws + 4 * PLANE), (bf16_t*)(ws + 7 * PLANE), (bf16_t*)(ws + 9 * PLANE)};
            pg8::gemm_phase<EpiG2, SchedG2, true, true>(lds, g, Sd, E, tid);
        }
        else if (k == 9 && (PHMASK >> 9 & 1)) {
            pg8::Gemm g{(const bf16_t*)(ws + 9 * PLANE), (const bf16_t*)(ws + OFF_WT3), 1024, 1024, 1024};
            SchedStd Sd; Sd.init(64, 4, G, cb, 1024, 1024);
            EpiG3 E{(l == 0) ? a.in[0] : a.out, a.out};
            pg8::gemm_phase<EpiG3, SchedStd, true, true>(lds, g, Sd, E, tid);
        }
        else if (k == 10 && (PHMASK >> 10 & 1)) phase_final(a, tid);
        if (ph + 1 < a0.ph_hi) { __syncthreads(); cg::this_grid().sync(); }
    }
}

extern "C" void kernel_launch(void* const* d_in, const int* in_sizes, int n_in, void* d_out, int out_size, void* d_ws, size_t ws_size, hipStream_t stream) {
    static int grid_blocks = 0;
    if (!grid_blocks) {
        hipFuncSetAttribute((const void*)mega, hipFuncAttributeMaxDynamicSharedMemorySize, LDS_BYTES);
        int dev = 0, cus = 0, per_cu = 0;
        hipGetDevice(&dev);
        hipDeviceGetAttribute(&cus, hipDeviceAttributeMultiprocessorCount, dev);
        hipOccupancyMaxActiveBlocksPerMultiprocessor(&per_cu, mega, 512, LDS_BYTES);
        if (per_cu < 1) per_cu = 1;
        grid_blocks = cus * per_cu; if (grid_blocks > 256) grid_blocks = 256;
    }
    if (ws_size < OFF_END) { fprintf(stderr, "workspace too small: %zu < %zu\n", ws_size, (size_t)OFF_END); return; }
    Args a{};
    for (int i = 0; i < 13; ++i) a.in[i] = (const float*)d_in[i];
    a.out = (float*)d_out; a.ws = (unsigned char*)d_ws;
#if MK_MULTI
    for (int ph = 0; ph < NPH; ++ph) {
        const int k = (ph == 20) ? 10 : ph % 10;
        const int reps = ((PROBE_RPT >> k) & 1) ? 2 : 1;
        for (int rep = 0; rep < reps; ++rep) { a.ph_lo = ph; a.ph_hi = ph + 1; a.dry = (reps == 2 && rep == 0) ? 1 : 0;
            hipLaunchKernelGGL(mega, dim3(grid_blocks), dim3(512), LDS_BYTES, stream, a); }
    }
#else
    a.ph_lo = 0; a.ph_hi = NPH;
    void* args[] = {&a};
    hipError_t e = hipLaunchCooperativeKernel((void*)mega, dim3(grid_blocks), dim3(512), args, LDS_BYTES, stream);
    if (e != hipSuccess) fprintf(stderr, "cooperative launch failed: %s (grid %d)\n", hipGetErrorString(e), grid_blocks);
#endif
}
```

```cpp
#include <hip/hip_runtime.h>
#include <hip/hip_cooperative_groups.h>
#include <cstdio>
#include <cstdint>
namespace cg = cooperative_groups;

#ifndef MK_MULTI
#define MK_MULTI 0
#endif

namespace pg8 {
#define PG8_LAS __attribute__((address_space(3)))
typedef unsigned short bf16_t;
typedef short bf16x8 __attribute__((ext_vector_type(8)));
typedef float f32x4 __attribute__((ext_vector_type(4)));
typedef unsigned u32x4 __attribute__((ext_vector_type(4)));
constexpr int BM = 256, BK = 64, HALF = 128, HTB = HALF * BK * 2  , STAGE_BYTES = 8 * HTB, NXCD = 8, WGM = 8;

__host__ __device__ __forceinline__ int lds_byte(int r, int c) { const int st = (r >> 4) * 2 + (c >> 5), rr = r & 15, cc = c & 31, ob = rr * 64 + cc * 2; return st * 1024 + (ob ^ (((ob >> 9) & 1) << 5)); }
__host__ __device__ __forceinline__ void stage_rc(int b, int& R, int& C) { const int st = b / 1024, sb = b % 1024, swz = sb ^ (((sb >> 9) & 1) << 5); R = (st >> 1) * 16 + swz / 64; C = (st & 1) * 32 + (swz % 64) / 2; }
__host__ __device__ __forceinline__ int perm32(int rho) { const int n = rho >> 4, i = rho & 15; return 8 * (i >> 2) + 4 * n + (i & 3); }

struct Unit { int pm, pn, z; };
struct Gemm { const bf16_t* A; const bf16_t* Bt; int lda, ldb, K; };

__device__ __forceinline__ unsigned cvt_pk_bf16(float lo, float hi) { unsigned r; asm volatile("v_cvt_pk_bf16_f32 %0, %1, %2" : "=v"(r) : "v"(lo), "v"(hi)); return r; }

template <class Epi, class Sched, bool ALIGN_EPI = false, bool SP2 = false>
__device__ __forceinline__ void gemm_phase(PG8_LAS unsigned char* lds, const Gemm g, const Sched& S, const Epi& E, const int tid) {
    const int wid = __builtin_amdgcn_readfirstlane(tid >> 6), lane = tid & 63, wr = wid >> 2, wc = wid & 3, fr = lane & 15, fq = lane >> 4;
    const int K = g.K, nt = K / BK;
    unsigned voffA[2], voffB[2];
#pragma unroll
    for (int i = 0; i < 2; ++i) { int R, C; stage_rc(tid * 16 + i * 8192, R, C); const int Rb = Epi::PERM ? ((R & ~31) + perm32(R & 31)) : R;
        voffA[i] = (unsigned)(R * g.lda + C) * 2u; voffB[i] = (unsigned)(Rb * g.ldb + C) * 2u; }
    const size_t kstep = (size_t)(BK * 2);
    const size_t hstepA = (size_t)HALF * g.lda * 2, hstepB = (size_t)HALF * g.ldb * 2;
    const unsigned ldsw = (unsigned)wid * 1024u;
    const int aoff = lds_byte(wr * 64 + fr, fq * 8), boff = lds_byte(wc * 32 + fr, fq * 8);
#define PG8_SA(b, h) (((b) * 2 + (h)) * HTB)
#define PG8_SB(b, h) ((4 + (b) * 2 + (h)) * HTB)
#define PG8_STAGE(bufoff, gbase, voff) do { _Pragma("unroll") for (int _i = 0; _i < 2; ++_i) \
        __builtin_amdgcn_global_load_lds((const unsigned*)((const char*)(gbase) + (voff)[_i]), (PG8_LAS unsigned*)(lds + (bufoff) + ldsw + _i * 8192), 16, 0, 0); } while (0)
#define PG8_LDA(dst, b, h) do { _Pragma("unroll") for (int m = 0; m < 4; ++m) _Pragma("unroll") for (int k = 0; k < 2; ++k) dst[m][k] = *(const PG8_LAS bf16x8*)(lds + PG8_SA(b, h) + aoff + m * 2048 + k * 1024); } while (0)
#define PG8_LDB(dst, b, h) do { _Pragma("unroll") for (int n = 0; n < 2; ++n) _Pragma("unroll") for (int k = 0; k < 2; ++k) dst[n][k] = *(const PG8_LAS bf16x8*)(lds + PG8_SB(b, h) + boff + n * 2048 + k * 1024); } while (0)
#define PG8_MMA(ai, bj, At, Bt) do { __builtin_amdgcn_s_setprio(1); _Pragma("unroll") for (int m = 0; m < 4; ++m) _Pragma("unroll") for (int n = 0; n < 2; ++n) _Pragma("unroll") for (int k = 0; k < 2; ++k) \
        acc[ai][bj][m][n] = __builtin_amdgcn_mfma_f32_16x16x32_bf16(Bt[n][k], At[m][k], acc[ai][bj][m][n], 0, 0, 0); __builtin_amdgcn_s_setprio(0); } while (0)
#define PG8_WAIT_V(n) asm volatile("s_waitcnt vmcnt(" #n ")" ::: "memory")
#define PG8_WAIT_L(n) asm volatile("s_waitcnt lgkmcnt(" #n ")" ::: "memory")
#define PG8_BAR __builtin_amdgcn_s_barrier()
#define PG8_SCHED __builtin_amdgcn_sched_barrier(0)
    Unit cur, nxt; int ui = 0;
    if (!S.next(0, cur)) return;
    f32x4 acc[2][2][4][2];
#pragma unroll
    for (int a = 0; a < 2; ++a)
#pragma unroll
        for (int b = 0; b < 2; ++b)
#pragma unroll
            for (int m = 0; m < 4; ++m)
#pragma unroll
                for (int n = 0; n < 2; ++n) acc[a][b][m][n] = (f32x4){0.f, 0.f, 0.f, 0.f};
    bf16x8 At[4][2], B0[2][2], B1[2][2];
    const char* cA = (const char*)g.A + S.a_off(cur); const char* cB = (const char*)g.Bt + S.b_off(cur);
    S.a_ready(cur);
    if constexpr (SP2) {
        PG8_STAGE(PG8_SB(0, 0), cB, voffB); PG8_STAGE(PG8_SB(0, 1), cB + hstepB, voffB); PG8_STAGE(PG8_SA(0, 0), cA, voffA); PG8_STAGE(PG8_SA(0, 1), cA + hstepA, voffA);
        if (wr == 1) PG8_BAR;
        PG8_WAIT_V(2); PG8_BAR;
        PG8_STAGE(PG8_SB(1, 0), cB + kstep, voffB); PG8_STAGE(PG8_SA(1, 0), cA + kstep, voffA); PG8_STAGE(PG8_SB(1, 1), cB + hstepB + kstep, voffB);
        PG8_WAIT_V(6); PG8_BAR;
    } else {
        PG8_STAGE(PG8_SB(0, 0), cB, voffB); PG8_STAGE(PG8_SA(0, 0), cA, voffA); PG8_STAGE(PG8_SB(0, 1), cB + hstepB, voffB); PG8_STAGE(PG8_SA(0, 1), cA + hstepA, voffA);
        if (wr == 1) PG8_BAR;
        PG8_WAIT_V(4); PG8_BAR;
        PG8_STAGE(PG8_SB(1, 0), cB + kstep, voffB); PG8_STAGE(PG8_SA(1, 0), cA + kstep, voffA); PG8_STAGE(PG8_SB(1, 1), cB + hstepB + kstep, voffB);
        PG8_WAIT_V(6); PG8_BAR;
    }
    for (;;) {
        const bool has_next = S.next(ui + 1, nxt);
        const char* nA = has_next ? (const char*)g.A + S.a_off(nxt) : cA; const char* nB = has_next ? (const char*)g.Bt + S.b_off(nxt) : cB;
        for (int t = 0; t < nt; t += 2) {
            const bool last = (t == nt - 2);
            const char* a1 = cA + (size_t)(t + 1) * kstep;
            const char* a2 = last ? nA : cA + (size_t)(t + 2) * kstep; const char* b2 = last ? nB : cB + (size_t)(t + 2) * kstep;
            const char* a3 = a2 + kstep; const char* b3 = b2 + kstep;
            if (last && has_next) S.a_ready(nxt);
            if constexpr (SP2) {
            PG8_LDB(B0, 0, 0); PG8_LDB(B1, 0, 1); PG8_SCHED; PG8_LDA(At, 0, 0); PG8_STAGE(PG8_SA(1, 1), a1 + hstepA, voffA);
            PG8_WAIT_V(8); PG8_WAIT_L(0); PG8_BAR; PG8_MMA(0, 0, At, B0); PG8_MMA(0, 1, At, B1); PG8_BAR; PG8_SCHED;
            PG8_LDA(At, 0, 1); PG8_STAGE(PG8_SB(0, 0), b2, voffB); PG8_STAGE(PG8_SB(0, 1), b2 + hstepB, voffB); PG8_STAGE(PG8_SA(0, 0), a2, voffA);
            PG8_WAIT_V(8); PG8_WAIT_L(0); PG8_BAR; PG8_MMA(1, 0, At, B0); PG8_MMA(1, 1, At, B1); PG8_BAR; PG8_SCHED;
            PG8_LDB(B0, 1, 0); PG8_LDB(B1, 1, 1); PG8_SCHED; PG8_LDA(At, 1, 0); PG8_STAGE(PG8_SA(0, 1), a2 + hstepA, voffA);
            PG8_WAIT_V(8); PG8_WAIT_L(0); PG8_BAR; PG8_MMA(0, 0, At, B0); PG8_MMA(0, 1, At, B1); PG8_BAR; PG8_SCHED;
            PG8_LDA(At, 1, 1); PG8_STAGE(PG8_SB(1, 0), b3, voffB); PG8_STAGE(PG8_SB(1, 1), b3 + hstepB, voffB); PG8_STAGE(PG8_SA(1, 0), a3, voffA);
            PG8_WAIT_V(8); PG8_WAIT_L(0); PG8_BAR; PG8_MMA(1, 0, At, B0); PG8_MMA(1, 1, At, B1); PG8_BAR; PG8_SCHED;
            } else {
            PG8_LDB(B0, 0, 0); PG8_SCHED; PG8_LDA(At, 0, 0); PG8_STAGE(PG8_SA(1, 1), a1 + hstepA, voffA);
            PG8_WAIT_L(8); PG8_BAR; PG8_WAIT_L(0); PG8_MMA(0, 0, At, B0); PG8_BAR; PG8_SCHED;
            PG8_LDB(B1, 0, 1); PG8_STAGE(PG8_SB(0, 0), b2, voffB);
            PG8_BAR; PG8_WAIT_L(0); PG8_MMA(0, 1, At, B1); PG8_BAR;
            PG8_LDA(At, 0, 1); PG8_STAGE(PG8_SA(0, 0), a2, voffA);
            PG8_BAR; PG8_WAIT_L(0); PG8_MMA(1, 0, At, B0); PG8_BAR; PG8_SCHED;
            PG8_STAGE(PG8_SB(0, 1), b2 + hstepB, voffB);
            PG8_WAIT_V(6); PG8_BAR; PG8_MMA(1, 1, At, B1); PG8_BAR;
            PG8_LDB(B0, 1, 0); PG8_SCHED; PG8_LDA(At, 1, 0); PG8_STAGE(PG8_SA(0, 1), a2 + hstepA, voffA);
            PG8_WAIT_L(8); PG8_BAR; PG8_WAIT_L(0); PG8_MMA(0, 0, At, B0); PG8_BAR; PG8_SCHED;
            PG8_LDB(B1, 1, 1); PG8_STAGE(PG8_SB(1, 0), b3, voffB);
            PG8_BAR; PG8_WAIT_L(0); PG8_MMA(0, 1, At, B1); PG8_BAR;
            PG8_LDA(At, 1, 1); PG8_STAGE(PG8_SA(1, 0), a3, voffA);
            PG8_BAR; PG8_WAIT_L(0); PG8_MMA(1, 0, At, B0); PG8_BAR; PG8_SCHED;
            PG8_STAGE(PG8_SB(1, 1), b3 + hstepB, voffB);
            PG8_WAIT_V(6); PG8_BAR; PG8_MMA(1, 1, At, B1); PG8_BAR;
            }
        }
        if constexpr (ALIGN_EPI) { if (wr == 0) PG8_BAR; }
        if constexpr (!Epi::AFTER_DRAIN) { E(acc, cur, wr, wc, fr, fq); S.done(cur); }
        if (!has_next) break;
#pragma unroll
        for (int a = 0; a < 2; ++a)
#pragma unroll
            for (int b = 0; b < 2; ++b)
#pragma unroll
                for (int m = 0; m < 4; ++m)
#pragma unroll
                    for (int n = 0; n < 2; ++n) acc[a][b][m][n] = (f32x4){0.f, 0.f, 0.f, 0.f};
        cur = nxt; cA = nA; cB = nB; ++ui;
        if constexpr (ALIGN_EPI) { if (wr == 1) PG8_BAR; }
    }
    PG8_WAIT_V(0);
    if constexpr (!ALIGN_EPI) { if (wr == 0) PG8_BAR; }
    PG8_BAR;
    if constexpr (Epi::AFTER_DRAIN) { E.fused(acc, cur, wr, wc, fr, fq, lds, wid, lane); S.done(cur); }
#undef PG8_SA
#undef PG8_SB
#undef PG8_STAGE
#undef PG8_LDA
#undef PG8_LDB
#undef PG8_MMA
#undef PG8_WAIT_V
#undef PG8_WAIT_L
#undef PG8_BAR
#undef PG8_SCHED
}
}

#ifndef PG8_SP2
#define PG8_SP2 true
#endif
#ifndef PG8_ALIGN
#define PG8_ALIGN true
#endif

using pg8::bf16_t; using pg8::bf16x8; using pg8::f32x4; using pg8::u32x4;
typedef float f32x16 __attribute__((ext_vector_type(16)));
typedef unsigned u32x2 __attribute__((ext_vector_type(2)));
#define LAS __attribute__((address_space(3)))

constexpr int M = 16384, S = 8192, D = 1024, NIN = 14352;
constexpr size_t PLANE = (size_t)M * D * 2;
constexpr float EPS = 1e-6f, LOG2E = 1.4426950408889634f;
constexpr size_t MiB = 1048576;
constexpr size_t OFF_WT1 = 12 * PLANE, OFF_WT1B = OFF_WT1 + 18 * MiB, OFF_WT2 = OFF_WT1B + 10 * MiB, OFF_WT3 = OFF_WT2 + 6 * MiB,
    OFF_HALO = OFF_WT3 + 2 * MiB, OFF_GATES = OFF_HALO + 3 * MiB, OFF_A2 = OFF_GATES + MiB, OFF_M2 = OFF_A2 + 262144, OFF_EM = OFF_M2 + 262144,
    OFF_WK = OFF_EM + 262144, OFF_F2 = OFF_WK + 262144, OFF_MP2 = OFF_F2 + 524288, OFF_NST = OFF_MP2 + 4096, OFF_KN2 = OFF_NST + 65536, OFF_QCTR = OFF_KN2 + 256, OFF_END = OFF_QCTR + 256;
constexpr size_t OFF_CST = OFF_WT1;
constexpr int LDS_BYTES = 143360;
constexpr int NPH = 21;
#ifndef ATTNMASK
#define ATTNMASK 3
#endif
#ifndef PROBE_RPT
#define PROBE_RPT 0
#endif
#ifndef PROBE_DRYMASK
#define PROBE_DRYMASK 3
#endif
#ifndef PHMASK
#define PHMASK 0x7ff
#endif

struct Args { const float* in[13]; float* out; unsigned char* ws; int ph_lo, ph_hi, dry, pad; };

__device__ __forceinline__ float bf2f(unsigned b) { return __uint_as_float(b << 16); }
__device__ __forceinline__ float bflo(unsigned w) { return __uint_as_float(w << 16); }
__device__ __forceinline__ float bfhi(unsigned w) { return __uint_as_float(w & 0xffff0000u); }
__device__ __forceinline__ unsigned pk2(float lo, float hi) { return pg8::cvt_pk_bf16(lo, hi); }
__device__ __forceinline__ float wave_sum(float v) {
#pragma unroll
    for (int o = 32; o; o >>= 1) v += __shfl_xor(v, o);
    return v; }
__device__ __forceinline__ float sigm(float x) { return 1.f / (1.f + __expf(-x)); }
__device__ __forceinline__ float silu(float x) { return x / (1.f + __expf(-x)); }
__device__ __forceinline__ float logsig(float x) { return fminf(x, 0.f) - log1pf(expf(-fabsf(x))); }
__device__ __forceinline__ int crow(int r, int hi) { return (r & 3) + 8 * (r >> 2) + 4 * hi; }

struct SchedStd {
    int nM, nN, nwg, G, c, lda, ldb;
    __device__ void init(int nM_, int nN_, int G_, int c_, int lda_, int ldb_) { nM = nM_; nN = nN_; nwg = nM * nN; G = G_; c = c_; lda = lda_; ldb = ldb_; }
    __device__ bool next(int i, pg8::Unit& u) const {
        const long L = (long)i * G + c; if (L >= nwg) return false;
        int wgid = (int)L; { const int q = nwg / 8, r = nwg % 8, xcd = wgid % 8, off = wgid / 8; wgid = (xcd < r ? xcd * (q + 1) : r * (q + 1) + (xcd - r) * q) + off; }
        const int nig = 8 * nN, gid = wgid / nig, fm = gid * 8, gsz = (nM - fm) < 8 ? (nM - fm) : 8;
        u.pm = fm + ((wgid % nig) % gsz); u.pn = (wgid % nig) / gsz; u.z = 0; return true;
    }
    __device__ __forceinline__ size_t a_off(const pg8::Unit& u) const { return (size_t)u.pm * 256 * lda * 2; }
    __device__ __forceinline__ size_t b_off(const pg8::Unit& u) const { return (size_t)u.pn * 256 * ldb * 2; }
    __device__ __forceinline__ void a_ready(const pg8::Unit&) const {}
    __device__ __forceinline__ void done(const pg8::Unit&) const {}
};
struct SchedG2 {
    int G, c;
    __device__ bool next(int i, pg8::Unit& u) const {
        const int t = (i / 3) * G + c; if (t >= 256) return false;
        const int x = t & 7, q = t >> 3; u.pm = x * 8 + (q >> 2); u.pn = q & 3; u.z = i % 3; return true;
    }
    __device__ __forceinline__ size_t a_off(const pg8::Unit& u) const { return (size_t)u.z * PLANE + (size_t)u.pm * 256 * 1024 * 2; }
    __device__ __forceinline__ size_t b_off(const pg8::Unit& u) const { return ((size_t)u.z * 1024 + (size_t)u.pn * 256) * 1024 * 2; }
    __device__ __forceinline__ void a_ready(const pg8::Unit&) const {}
    __device__ __forceinline__ void done(const pg8::Unit&) const {}
};
struct SchedA1 {
    int G, c;
    __device__ bool next(int i, pg8::Unit& u) const { const int L = i * G + c; if (L >= 128) return false; u.pm = 0; u.pn = 0; u.z = L; return true; }
    __device__ __forceinline__ size_t a_off(const pg8::Unit& u) const { const int bh = u.z >> 4, ch = u.z & 15; return ((size_t)((bh >> 2) * 1024 + (bh & 3) * 256) * 8192 + (size_t)ch * 512) * 2; }
    __device__ __forceinline__ size_t b_off(const pg8::Unit& u) const { return a_off(u); }
    __device__ __forceinline__ void a_ready(const pg8::Unit&) const {}
    __device__ __forceinline__ void done(const pg8::Unit&) const {}
};

struct EpiG1 {
    static constexpr bool PERM = true, AFTER_DRAIN = false;
    unsigned char* ws;
    __device__ __forceinline__ void operator()(const f32x4 (&acc)[2][2][4][2], const pg8::Unit& u, int wr, int wc, int fr, int fq) const {
        asm volatile("" : "+v"(fr), "+v"(fq));
        const int p9 = u.pn >> 2;
        const int dpl = (p9 < 2) ? p9 : p9 + 1;
        bf16_t* base = (bf16_t*)(ws + (size_t)dpl * PLANE);
        bf16_t* halo = (bf16_t*)(ws + OFF_HALO);
        const int cc0 = (u.pn & 3) * 256 + wc * 32 + 8 * fq;
        const int row0 = u.pm * 256 + wr * 64 + fr;
        const bool transposed = (p9 == 4 || p9 == 8), hal = (p9 == 2 || p9 == 3);
        const float sc = (p9 == 6) ? (0.08838834764831845f * LOG2E) : 1.f;
#pragma unroll
        for (int ai = 0; ai < 2; ++ai)
#pragma unroll
            for (int m = 0; m < 4; ++m) {
                const int r = row0 + ai * 128 + m * 16;
#pragma unroll
                for (int bj = 0; bj < 2; ++bj) {
                    const int c = cc0 + bj * 128;
                    const f32x4 v0 = acc[ai][bj][m][0] * sc, v1 = acc[ai][bj][m][1] * sc;
                    u32x4 w; w.x = pk2(v0[0], v0[1]); w.y = pk2(v0[2], v0[3]); w.z = pk2(v1[0], v1[1]); w.w = pk2(v1[2], v1[3]);
                    if (!transposed) {
                        *(u32x4*)(base + (size_t)r * 1024 + c) = w;
                        if (hal && m == 3 && fr >= 13) *(u32x4*)(halo + ((size_t)(r >> 6) * 3 + (fr - 13)) * 2048 + (p9 == 3 ? 1024 : 0) + c) = w;
                    } else {
                        const int b = r >> 13, t = r & 8191;
                        bf16_t* p = base + ((size_t)(b * 1024 + c)) * 8192 + t;
                        p[0] = (bf16_t)(w.x & 0xffff); p[8192] = (bf16_t)(w.x >> 16); p[2 * 8192] = (bf16_t)(w.y & 0xffff); p[3 * 8192] = (bf16_t)(w.y >> 16);
                        p[4 * 8192] = (bf16_t)(w.z & 0xffff); p[5 * 8192] = (bf16_t)(w.z >> 16); p[6 * 8192] = (bf16_t)(w.w & 0xffff); p[7 * 8192] = (bf16_t)(w.w >> 16);
                    }
                }
            }
    }
};
struct EpiPlain {
    static constexpr bool PERM = true, AFTER_DRAIN = false;
    bf16_t* base; int ldc; size_t zstride; int split;
    __device__ __forceinline__ void operator()(const f32x4 (&acc)[2][2][4][2], const pg8::Unit& u, int wr, int wc, int fr, int fq) const {
        asm volatile("" : "+v"(fr), "+v"(fq));
        bf16_t* bp = base + (size_t)u.z * zstride;
        int colt = u.pn * 256;
        if (split) { bp += (size_t)(u.pn >> 2) * (PLANE / 2); colt = (u.pn & 3) * 256; }
        const int cc0 = colt + wc * 32 + 8 * fq, row0 = u.pm * 256 + wr * 64 + fr;
#pragma unroll
        for (int ai = 0; ai < 2; ++ai)
#pragma unroll
            for (int m = 0; m < 4; ++m) {
                bf16_t* rowp = bp + (size_t)(row0 + ai * 128 + m * 16) * ldc + cc0;
#pragma unroll
                for (int bj = 0; bj < 2; ++bj) {
                    const f32x4 v0 = acc[ai][bj][m][0], v1 = acc[ai][bj][m][1];
                    u32x4 w; w.x = pk2(v0[0], v0[1]); w.y = pk2(v0[2], v0[3]); w.z = pk2(v1[0], v1[1]); w.w = pk2(v1[2], v1[3]);
                    *(u32x4*)(rowp + bj * 128) = w;
                }
            }
    }
};
struct EpiG2 {
    static constexpr bool PERM = true, AFTER_DRAIN = false;
    const bf16_t* gates; bf16_t* tmp; bf16_t* outp;
    __device__ __forceinline__ void operator()(const f32x4 (&acc)[2][2][4][2], const pg8::Unit& u, int wr, int wc, int fr, int fq) const {
        asm volatile("" : "+v"(fr), "+v"(fq));
        const bf16_t* gp = gates + (size_t)u.z * (PLANE / 2);
        bf16_t* dst = (u.z == 2) ? outp : tmp;
        const int cc0 = u.pn * 256 + wc * 32 + 8 * fq, row0 = u.pm * 256 + wr * 64 + fr;
#pragma unroll
        for (int ai = 0; ai < 2; ++ai) {
            u32x4 gv[4][2], tv[4][2];
#pragma unroll
            for (int m = 0; m < 4; ++m)
#pragma unroll
                for (int bj = 0; bj < 2; ++bj) { const size_t o = (size_t)(row0 + ai * 128 + m * 16) * 1024 + cc0 + bj * 128;
                    gv[m][bj] = *(const u32x4*)(gp + o); tv[m][bj] = (u.z != 0) ? *(const u32x4*)(tmp + o) : (u32x4){0u, 0u, 0u, 0u}; }
#pragma unroll
            for (int m = 0; m < 4; ++m)
#pragma unroll
                for (int bj = 0; bj < 2; ++bj) { const size_t o = (size_t)(row0 + ai * 128 + m * 16) * 1024 + cc0 + bj * 128;
                    const u32x4 g = gv[m][bj], p = tv[m][bj];
                    f32x4 v0 = acc[ai][bj][m][0], v1 = acc[ai][bj][m][1];
                    v0[0] = v0[0] * sigm(bflo(g.x)) + bflo(p.x); v0[1] = v0[1] * sigm(bfhi(g.x)) + bfhi(p.x); v0[2] = v0[2] * sigm(bflo(g.y)) + bflo(p.y); v0[3] = v0[3] * sigm(bfhi(g.y)) + bfhi(p.y);
                    v1[0] = v1[0] * sigm(bflo(g.z)) + bflo(p.z); v1[1] = v1[1] * sigm(bfhi(g.z)) + bfhi(p.z); v1[2] = v1[2] * sigm(bflo(g.w)) + bflo(p.w); v1[3] = v1[3] * sigm(bfhi(g.w)) + bfhi(p.w);
                    u32x4 w; w.x = pk2(v0[0], v0[1]); w.y = pk2(v0[2], v0[3]); w.z = pk2(v1[0], v1[1]); w.w = pk2(v1[2], v1[3]);
                    *(u32x4*)(dst + o) = w; }
        }
    }
};
struct EpiG3 {
    static constexpr bool PERM = true, AFTER_DRAIN = false;
    const float* xin; float* out;
    __device__ __forceinline__ void operator()(const f32x4 (&acc)[2][2][4][2], const pg8::Unit& u, int wr, int wc, int fr, int fq) const {
        asm volatile("" : "+v"(fr), "+v"(fq));
        const int cc0 = u.pn * 256 + wc * 32 + 8 * fq, row0 = u.pm * 256 + wr * 64 + fr;
#pragma unroll
        for (int ai = 0; ai < 2; ++ai) {
            f32x4 xv[4][2][2];
#pragma unroll
            for (int m = 0; m < 4; ++m)
#pragma unroll
                for (int bj = 0; bj < 2; ++bj) { const size_t o = (size_t)(row0 + ai * 128 + m * 16) * 1024 + cc0 + bj * 128; xv[m][bj][0] = *(const f32x4*)(xin + o); xv[m][bj][1] = *(const f32x4*)(xin + o + 4); }
#pragma unroll
            for (int m = 0; m < 4; ++m)
#pragma unroll
                for (int bj = 0; bj < 2; ++bj) { const size_t o = (size_t)(row0 + ai * 128 + m * 16) * 1024 + cc0 + bj * 128;
                    *(f32x4*)(out + o) = xv[m][bj][0] + acc[ai][bj][m][0]; *(f32x4*)(out + o + 4) = xv[m][bj][1] + acc[ai][bj][m][1]; }
        }
    }
};

__device__ __forceinline__ int g1_srccol(int p) {
    switch (p) { case 0: return 4096; case 1: return 8200; case 2: return 0; case 3: return 1024; case 4: return 2048; case 5: return 3072; case 6: return 5128; case 7: return 6152; default: return 7176; } }

__device__ __forceinline__ void transpose_tile(const float* __restrict__ src, int pitch, bf16_t* __restrict__ dst, LAS float* scr, int tid) {
#pragma unroll
    for (int i = 0; i < 2; ++i) { const int r = (tid >> 4) + 32 * i, c4 = tid & 15; const f32x4 v = *(const f32x4*)(src + (size_t)r * pitch + c4 * 4);
        scr[r * 65 + c4 * 4 + 0] = v[0]; scr[r * 65 + c4 * 4 + 1] = v[1]; scr[r * 65 + c4 * 4 + 2] = v[2]; scr[r * 65 + c4 * 4 + 3] = v[3]; }
    __syncthreads();
    { const int n = tid >> 3, kc = tid & 7; float v[8];
#pragma unroll
      for (int j = 0; j < 8; ++j) v[j] = scr[(kc * 8 + j) * 65 + n];
      u32x4 w; w.x = pk2(v[0], v[1]); w.y = pk2(v[2], v[3]); w.z = pk2(v[4], v[5]); w.w = pk2(v[6], v[7]);
      *(u32x4*)(dst + (size_t)n * 1024 + kc * 8) = w; }
    __syncthreads();
}

__device__ __forceinline__ void phase_prep(const Args& a, int l, LAS unsigned char* lds, int tid) {
    unsigned char* ws = a.ws;
    const float* w_in = a.in[2] + (size_t)l * D * NIN;
    const float* w_br = a.in[10] + (size_t)l * 3 * D * D;
    const float* w_out = a.in[11] + (size_t)l * D * D;
    const float* pool_w = a.in[8] + (size_t)l * 4 * 256 * 256;
    const float* pool_s = a.in[9] + (size_t)l * D;
    LAS float* scr = (LAS float*)lds;
    for (int base = blockIdx.x * 4; base < 17 * 256; base += gridDim.x * 4) {
        f32x4 tv[4][2];
#pragma unroll
        for (int q = 0; q < 4; ++q) {
            const int it = base + q, id = it >> 8, nt = (it & 255) >> 4, kt = it & 15;
            const float* src; int pitch;
            if (id < 9)       { src = w_in + (size_t)(kt * 64) * NIN + g1_srccol(id) + nt * 64; pitch = NIN; }
            else if (id < 13) { const int qq = id - 9; const int col = (qq == 0) ? 10256 : 11280 + (qq - 1) * 1024; src = w_in + (size_t)(kt * 64) * NIN + col + nt * 64; pitch = NIN; }
            else if (id < 16) { const int n = id - 13; src = w_br + (size_t)n * D * D + (size_t)(kt * 64) * D + nt * 64; pitch = D; }
            else              { src = w_out + (size_t)(kt * 64) * D + nt * 64; pitch = D; }
#pragma unroll
            for (int i = 0; i < 2; ++i) { const int r = (tid >> 4) + 32 * i, c4 = tid & 15; tv[q][i] = *(const f32x4*)(src + (size_t)r * pitch + c4 * 4); }
        }
#pragma unroll
        for (int q = 0; q < 4; ++q)
#pragma unroll
            for (int i = 0; i < 2; ++i) { const int r = (tid >> 4) + 32 * i, c4 = tid & 15; LAS float* d = scr + q * 4160 + r * 65 + c4 * 4; d[0] = tv[q][i][0]; d[1] = tv[q][i][1]; d[2] = tv[q][i][2]; d[3] = tv[q][i][3]; }
        __syncthreads();
#pragma unroll
        for (int q = 0; q < 4; ++q) {
            const int it = base + q, id = it >> 8, nt = (it & 255) >> 4, kt = it & 15;
            bf16_t* dst;
            if (id < 9)       dst = (bf16_t*)(ws + OFF_WT1) + (size_t)(id * 1024 + nt * 64) * 1024 + kt * 64;
            else if (id < 13) { const int qq = id - 9; const int prow = (qq == 0) ? 0 : qq + 1; dst = (bf16_t*)(ws + OFF_WT1B) + (size_t)(prow * 1024 + nt * 64) * 1024 + kt * 64; }
            else if (id < 16) { const int n = id - 13; dst = (bf16_t*)(ws + OFF_WT2) + (size_t)(n * 1024 + nt * 64) * 1024 + kt * 64; }
            else              dst = (bf16_t*)(ws + OFF_WT3) + (size_t)(nt * 64) * 1024 + kt * 64;
            const int n = tid >> 3, kc = tid & 7; float v[8];
#pragma unroll
            for (int j = 0; j < 8; ++j) v[j] = scr[q * 4160 + (kc * 8 + j) * 65 + n];
            u32x4 w; w.x = pk2(v[0], v[1]); w.y = pk2(v[2], v[3]); w.z = pk2(v[4], v[5]); w.w = pk2(v[6], v[7]);
            *(u32x4*)(dst + (size_t)n * 1024 + kc * 8) = w;
        }
        __syncthreads();
    }
    for (int it = blockIdx.x; it < 256; it += gridDim.x) {
        const int g = it >> 6, kt = (it & 63) >> 2, dt = it & 3;
        LAS float* As = scr; LAS float* Bs = scr + 64 * 65;
        float acc[8];
#pragma unroll
        for (int j = 0; j < 8; ++j) acc[j] = 0.f;
        for (int cc = 0; cc < 4; ++cc) {
#pragma unroll
            for (int i = 0; i < 2; ++i) { const int r = (tid >> 4) + 32 * i, c4 = tid & 15;
                const f32x4 va = *(const f32x4*)(w_in + (size_t)(kt * 64 + r) * NIN + 9232 + g * 256 + cc * 64 + c4 * 4);
                As[r * 65 + c4 * 4 + 0] = va[0]; As[r * 65 + c4 * 4 + 1] = va[1]; As[r * 65 + c4 * 4 + 2] = va[2]; As[r * 65 + c4 * 4 + 3] = va[3];
                const f32x4 vb = *(const f32x4*)(pool_w + (size_t)(g * 256 + cc * 64 + r) * 256 + dt * 64 + c4 * 4);
                Bs[r * 64 + c4 * 4 + 0] = vb[0]; Bs[r * 64 + c4 * 4 + 1] = vb[1]; Bs[r * 64 + c4 * 4 + 2] = vb[2]; Bs[r * 64 + c4 * 4 + 3] = vb[3]; }
            __syncthreads();
            const int d = tid & 63, kg = tid >> 6;
            for (int c = 0; c < 64; ++c) { const float bv = Bs[c * 64 + d];
#pragma unroll
                for (int j = 0; j < 8; ++j) acc[j] += As[(kg * 8 + j) * 65 + c] * bv; }
            __syncthreads();
        }
        const int d = tid & 63, kg = tid >> 6;
        const float sc = pool_s[g * 256 + dt * 64 + d];
        u32x4 w; w.x = pk2(acc[0] * sc, acc[1] * sc); w.y = pk2(acc[2] * sc, acc[3] * sc); w.z = pk2(acc[4] * sc, acc[5] * sc); w.w = pk2(acc[6] * sc, acc[7] * sc);
        *(u32x4*)((bf16_t*)(ws + OFF_WT1B) + (size_t)(1024 + g * 256 + dt * 64 + d) * 1024 + kt * 64 + kg * 8) = w;
    }
    if (blockIdx.x == 0 && tid < 16) { ((unsigned*)(ws + OFF_KN2))[tid] = 0u; ((unsigned*)(ws + OFF_QCTR))[tid] = 0u; }
    LAS float* gw = (LAS float*)lds;
    __syncthreads();
    for (int e = tid; e < 16 * 1024; e += 512) { const int c = e & 15, k = e >> 4; const int col = (c < 8) ? 5120 + c : 9224 + (c - 8); gw[c * 1024 + k] = w_in[(size_t)k * NIN + col]; }
    __syncthreads();
    {
        const float* xin = (l == 0) ? a.in[0] : a.out;
        const float* ng = a.in[1] + (size_t)l * D;
        bf16_t* hb = (bf16_t*)(ws + 10 * PLANE);
        float* gates = (float*)(ws + OFF_GATES);
        const int wid = tid >> 6, lane = tid & 63;
        f32x4 gg[4];
#pragma unroll
        for (int j = 0; j < 4; ++j) gg[j] = *(const f32x4*)(ng + j * 256 + lane * 4);
        for (int row0 = blockIdx.x * 8 + wid; row0 < M; row0 += gridDim.x * 16) {
            const int row1 = row0 + gridDim.x * 8;
            f32x4 xa[2][4];
#pragma unroll
            for (int j = 0; j < 4; ++j) { xa[0][j] = *(const f32x4*)(xin + (size_t)row0 * D + j * 256 + lane * 4); xa[1][j] = (row1 < M) ? *(const f32x4*)(xin + (size_t)row1 * D + j * 256 + lane * 4) : (f32x4){0.f, 0.f, 0.f, 0.f}; }
#pragma unroll
            for (int rr = 0; rr < 2; ++rr) {
                const int row = rr ? row1 : row0;
                if (row >= M) continue;
                f32x4 xv[4]; float ss = 0.f;
#pragma unroll
                for (int j = 0; j < 4; ++j) { xv[j] = xa[rr][j]; ss += xv[j][0] * xv[j][0] + xv[j][1] * xv[j][1] + xv[j][2] * xv[j][2] + xv[j][3] * xv[j][3]; }
                ss = wave_sum(ss);
                const float r = rsqrtf(ss * (1.f / 1024.f) + EPS);
#pragma unroll
                for (int j = 0; j < 4; ++j) { xv[j] = (xv[j] * r) * gg[j]; u32x2 w; w.x = pk2(xv[j][0], xv[j][1]); w.y = pk2(xv[j][2], xv[j][3]); *(u32x2*)(hb + (size_t)row * D + j * 256 + lane * 4) = w; }
                float ga[16];
#pragma unroll
                for (int c = 0; c < 16; ++c) { float s = 0.f;
#pragma unroll
                    for (int j = 0; j < 4; ++j) { const f32x4 wv = *(const LAS f32x4*)(gw + c * 1024 + j * 256 + lane * 4); s += xv[j][0] * wv[0] + xv[j][1] * wv[1] + xv[j][2] * wv[2] + xv[j][3] * wv[3]; }
                    ga[c] = s; }
                float b8[8], b4[4], b2[2], b1;
#pragma unroll
                for (int i = 0; i < 8; ++i) { const bool hi_ = (lane & 32) != 0; const float send = hi_ ? ga[i] : ga[i + 8], keep = hi_ ? ga[i + 8] : ga[i]; b8[i] = keep + __shfl_xor(send, 32); }
#pragma unroll
                for (int i = 0; i < 4; ++i) { const bool hi_ = (lane & 16) != 0; const float send = hi_ ? b8[i] : b8[i + 4], keep = hi_ ? b8[i + 4] : b8[i]; b4[i] = keep + __shfl_xor(send, 16); }
#pragma unroll
                for (int i = 0; i < 2; ++i) { const bool hi_ = (lane & 8) != 0; const float send = hi_ ? b4[i] : b4[i + 2], keep = hi_ ? b4[i + 2] : b4[i]; b2[i] = keep + __shfl_xor(send, 8); }
                { const bool hi_ = (lane & 4) != 0; const float send = hi_ ? b2[0] : b2[1], keep = hi_ ? b2[1] : b2[0]; b1 = keep + __shfl_xor(send, 4); }
                b1 += __shfl_xor(b1, 2); b1 += __shfl_xor(b1, 1);
                if ((lane & 3) == 0) gates[(size_t)row * 16 + ((lane >> 2) & 15)] = b1;
            }
        }
    }
    __syncthreads();
}

__device__ __forceinline__ float block_excl_scan_add(float tot, LAS float* sm, int tid) {
    const int lane = tid & 63, wid = tid >> 6; float x = tot;
#pragma unroll
    for (int o = 1; o < 64; o <<= 1) { const float v = __shfl_up(x, o); if (lane >= o) x += v; }
    __syncthreads();
    if (lane == 63) sm[wid] = x;
    __syncthreads();
    float base = 0.f;
    for (int w = 0; w < wid; ++w) base += sm[w];
    return base + x - tot;
}
__device__ __forceinline__ float block_excl_scan_max(float tot, LAS float* sm, int tid) {
    const int lane = tid & 63, wid = tid >> 6; float x = tot;
#pragma unroll
    for (int o = 1; o < 64; o <<= 1) { const float v = __shfl_up(x, o); if (lane >= o) x = fmaxf(x, v); }
    __syncthreads();
    if (lane == 63) sm[wid] = x;
    __syncthreads();
    float base = -INFINITY;
    for (int w = 0; w < wid; ++w) base = fmaxf(base, sm[w]);
    const float prev = __shfl_up(x, 1);
    return fmaxf(base, lane ? prev : -INFINITY);
}
__device__ __forceinline__ void phase_scans(const Args& a, int l, LAS unsigned char* lds, int tid) {
    unsigned char* ws = a.ws; const float* gates = (const float*)(ws + OFF_GATES);
    LAS float* sm = (LAS float*)lds;
    LAS float* Fs = sm + 64; LAS float* As = Fs + 8192; LAS float* Ms = As + 8192;
    const int bx = blockIdx.x;
    if (bx < 8) {
        const int b = bx >> 2, h = bx & 3; const float bi = a.in[4][l * 4 + h], bfv = a.in[5][l * 4 + h];
        float run = 0.f;
#pragma unroll 2
        for (int i = 0; i < 16; ++i) { const size_t row = (size_t)b * S + tid * 16 + i; run += logsig(gates[row * 16 + 4 + h] + bfv); Fs[tid * 16 + i] = run; }
        const float pre = block_excl_scan_add(run, sm, tid);
        float mx = -INFINITY;
#pragma unroll 2
        for (int i = 0; i < 16; ++i) { const size_t row = (size_t)b * S + tid * 16 + i; const float F = Fs[tid * 16 + i] + pre; const float av = gates[row * 16 + h] + bi - F;
            Fs[tid * 16 + i] = F; As[tid * 16 + i] = av; mx = fmaxf(mx, av); }
        const float pm = block_excl_scan_max(mx, sm + 16, tid);
        float Mrun = fmaxf(pm, 0.f);
#pragma unroll 2
        for (int i = 0; i < 16; ++i) { Mrun = fmaxf(Mrun, As[tid * 16 + i]); Ms[tid * 16 + i] = Mrun; }
        __syncthreads();
        if ((tid & 31) == 31) sm[32 + (tid >> 5)] = Mrun;
        __syncthreads();
        const float Mend = sm[32 + (tid >> 5)];
        float* A2 = (float*)(ws + OFF_A2) + (size_t)bx * S + tid * 16; float* M2 = (float*)(ws + OFF_M2) + (size_t)bx * S + tid * 16;
        float* EM = (float*)(ws + OFF_EM) + (size_t)bx * S + tid * 16; float* WK = (float*)(ws + OFF_WK) + (size_t)bx * S + tid * 16;
#pragma unroll 2
        for (int i = 0; i < 16; ++i) { const float av = As[tid * 16 + i], Mv = Ms[tid * 16 + i], F = Fs[tid * 16 + i];
            A2[i] = av * LOG2E; M2[i] = Mv * LOG2E; EM[i] = expf(-(F + Mv)); WK[i] = expf(av - Mend); }
        float* MP = (float*)(ws + OFF_MP2) + bx * 32;
        if (tid == 0) MP[0] = 0.f;
        if (tid < 16) MP[tid + 1] = sm[32 + tid] * LOG2E;
        __syncthreads();
    } else if (bx < 24) {
        const int bh = bx - 8, b = bh >> 3, h = bh & 7; const float bfv = a.in[7][l * 8 + h];
        float run = 0.f;
#pragma unroll 2
        for (int i = 0; i < 16; ++i) { const size_t row = (size_t)b * S + tid * 16 + i; run += logsig(gates[row * 16 + 8 + h] + bfv); Fs[tid * 16 + i] = run; }
        const float pre = block_excl_scan_add(run, sm, tid);
        float* F2 = (float*)(ws + OFF_F2) + (size_t)bh * S + tid * 16;
#pragma unroll 2
        for (int i = 0; i < 16; ++i) F2[i] = (Fs[tid * 16 + i] + pre) * LOG2E;
        __syncthreads();
    }
}

__device__ __forceinline__ void phase_conv(const Args& a, int l, LAS unsigned char* lds, int tid) {
    const bool dry = PROBE_RPT ? (a.dry != 0) : false;
    unsigned char* ws = a.ws;
    const float* cw = a.in[3] + (size_t)l * 4 * 2048;
    const bf16_t* halo = (const bf16_t*)(ws + OFF_HALO);
    const float* WK = (const float*)(ws + OFF_WK);
    LAS float* raw = (LAS float*)lds;
    LAS float* tb = raw + 67 * 65 + 3;
    const int r = tid >> 3, c8 = (tid & 7) * 8;
    u32x4 pv = (u32x4){0u, 0u, 0u, 0u}, ph = (u32x4){0u, 0u, 0u, 0u};
    auto issue = [&](int it) {
        const int tt = it >> 5, cs = it & 31;
        const bf16_t* pl = (const bf16_t*)(ws + (size_t)((cs >= 16) ? 4 : 3) * PLANE);
        pv = *(const u32x4*)(pl + (size_t)(tt * 64 + r) * 1024 + (cs & 15) * 64 + c8);
        if (tid < 24 && (tt & 127) != 0) ph = *(const u32x4*)(halo + ((size_t)(tt - 1) * 3 + (tid >> 3)) * 2048 + cs * 64 + c8);
        else ph = (u32x4){0u, 0u, 0u, 0u};
    };
    if (blockIdx.x < 256 * 32) issue(blockIdx.x);
    for (int it = blockIdx.x; it < 256 * 32; it += gridDim.x) {
        const int tt = it >> 5, cs = it & 31;
        const bool isk = cs >= 16;
        bf16_t* pl = (bf16_t*)(ws + (size_t)(isk ? 4 : 3) * PLANE);
        const int c0 = (cs & 15) * 64;
        { const u32x4 v = pv; LAS float* d = raw + (r + 3) * 65 + c8;
          d[0] = bflo(v.x); d[1] = bfhi(v.x); d[2] = bflo(v.y); d[3] = bfhi(v.y); d[4] = bflo(v.z); d[5] = bfhi(v.z); d[6] = bflo(v.w); d[7] = bfhi(v.w); }
        if (tid < 24) { const u32x4 v = ph; LAS float* d = raw + (tid >> 3) * 65 + c8;
            d[0] = bflo(v.x); d[1] = bfhi(v.x); d[2] = bflo(v.y); d[3] = bfhi(v.y); d[4] = bflo(v.z); d[5] = bfhi(v.z); d[6] = bflo(v.w); d[7] = bfhi(v.w); }
        __syncthreads();
        if (it + (int)gridDim.x < 256 * 32) issue(it + gridDim.x);
        float o[8];
        { const int gc = cs * 64 + c8;
#pragma unroll
          for (int j = 0; j < 8; ++j) { float s = 0.f;
#pragma unroll
              for (int kk = 0; kk < 4; ++kk) s += cw[kk * 2048 + gc + j] * raw[(r + kk) * 65 + c8 + j];
              o[j] = silu(s); } }
        if (!isk) {
#pragma unroll
            for (int j = 0; j < 8; ++j) o[j] *= 0.0625f;
        }
        { u32x4 w; w.x = pk2(o[0], o[1]); w.y = pk2(o[2], o[3]); w.z = pk2(o[4], o[5]); w.w = pk2(o[6], o[7]);
          if (!dry) *(u32x4*)(pl + (size_t)(tt * 64 + r) * 1024 + c0 + c8) = w; }
        if (isk) {
            const int b = tt >> 7, t0 = (tt & 127) * 64, hh = c0 >> 8;
            const float wk = WK[(size_t)(b * 4 + hh) * S + t0 + r];
#pragma unroll
            for (int j = 0; j < 8; ++j) tb[(c8 + j) * 65 + r] = o[j] * wk;
            __syncthreads();
            const int c = tid >> 3, t8 = (tid & 7) * 8;
            float v[8];
#pragma unroll
            for (int j = 0; j < 8; ++j) v[j] = tb[c * 65 + t8 + j];
            u32x4 w; w.x = pk2(v[0], v[1]); w.y = pk2(v[2], v[3]); w.z = pk2(v[4], v[5]); w.w = pk2(v[6], v[7]);
            if (!dry) *(u32x4*)((bf16_t*)(ws + 11 * PLANE) + (size_t)(b * 1024 + c0 + c) * 8192 + t0 + t8) = w;
        }
        __syncthreads();
    }
    {
        LAS unsigned* smx = (LAS unsigned*)lds;
        if (tid < 16) smx[tid] = 0u;
        __syncthreads();
        const int wid = tid >> 6, lane = tid & 63;
        const bf16_t* bk = (const bf16_t*)(ws + 8 * PLANE);
        float m0 = 0.f, m1 = 0.f;
        for (int rowb_ = blockIdx.x * 8 + wid; rowb_ < M; rowb_ += gridDim.x * 32) {
          u32x4 kv[4][2];
#pragma unroll
          for (int u = 0; u < 4; ++u) { const int row = rowb_ + u * gridDim.x * 8; if (row < M) { kv[u][0] = *(const u32x4*)(bk + (size_t)row * 1024 + lane * 16); kv[u][1] = *(const u32x4*)(bk + (size_t)row * 1024 + lane * 16 + 8); } else { kv[u][0] = (u32x4){0u,0u,0u,0u}; kv[u][1] = (u32x4){0u,0u,0u,0u}; } }
#pragma unroll
          for (int u = 0; u < 4; ++u) {
            const int row = rowb_ + u * gridDim.x * 8; if (row >= M) continue;
            const u32x4 v0 = kv[u][0], v1 = kv[u][1];
            float s = bflo(v0.x) * bflo(v0.x) + bfhi(v0.x) * bfhi(v0.x) + bflo(v0.y) * bflo(v0.y) + bfhi(v0.y) * bfhi(v0.y) + bflo(v0.z) * bflo(v0.z) + bfhi(v0.z) * bfhi(v0.z) + bflo(v0.w) * bflo(v0.w) + bfhi(v0.w) * bfhi(v0.w)
                    + bflo(v1.x) * bflo(v1.x) + bfhi(v1.x) * bfhi(v1.x) + bflo(v1.y) * bflo(v1.y) + bfhi(v1.y) * bfhi(v1.y) + bflo(v1.z) * bflo(v1.z) + bfhi(v1.z) * bfhi(v1.z) + bflo(v1.w) * bflo(v1.w) + bfhi(v1.w) * bfhi(v1.w);
            s += __shfl_xor(s, 1); s += __shfl_xor(s, 2); s += __shfl_xor(s, 4);
            if (row < S) m0 = fmaxf(m0, s); else m1 = fmaxf(m1, s);
          }
        }
        if ((lane & 7) == 0) { __hip_atomic_fetch_max((unsigned*)(smx + (lane >> 3)), __float_as_uint(m0), __ATOMIC_RELAXED, __HIP_MEMORY_SCOPE_WORKGROUP); __hip_atomic_fetch_max((unsigned*)(smx + 8 + (lane >> 3)), __float_as_uint(m1), __ATOMIC_RELAXED, __HIP_MEMORY_SCOPE_WORKGROUP); }
        __syncthreads();
        if (tid < 16) __hip_atomic_fetch_max((unsigned*)(ws + OFF_KN2) + tid, smx[tid], __ATOMIC_RELAXED, __HIP_MEMORY_SCOPE_AGENT);
        __syncthreads();
    }
}

__device__ __forceinline__ void phase_statescan(const Args& a, int tid) {
    const bool dry = PROBE_RPT ? (a.dry != 0) : false;
    unsigned char* ws = a.ws;
    const float* MP = (const float*)(ws + OFF_MP2);
    bf16_t* Cst = (bf16_t*)(ws + OFF_CST);
    for (int grp = blockIdx.x * 512 + tid; grp < 8 * 16384; grp += gridDim.x * 512) {
        const int bh = grp >> 14, e = (grp & 16383) * 4;
        u32x2 dv[16];
#pragma unroll
        for (int c = 0; c < 16; ++c) dv[c] = *(const u32x2*)(Cst + ((size_t)(bh * 16 + c) * 65536 + e));
        float C0 = 0.f, C1 = 0.f, C2 = 0.f, C3 = 0.f;
#pragma unroll
        for (int c = 0; c < 16; ++c) {
            u32x2 w; w.x = pk2(C0, C1); w.y = pk2(C2, C3); if (!dry) *(u32x2*)(Cst + ((size_t)(bh * 16 + c) * 65536 + e)) = w;
            const float dec = exp2f(MP[bh * 32 + c] - MP[bh * 32 + c + 1]);
            C0 = dec * C0 + bflo(dv[c].x); C1 = dec * C1 + bfhi(dv[c].x); C2 = dec * C2 + bflo(dv[c].y); C3 = dec * C3 + bfhi(dv[c].y);
        }
    }
    const int wid = tid >> 6, lane = tid & 63;
    bf16_t* nst = (bf16_t*)(ws + OFF_NST);
    for (int gwv = blockIdx.x * 8 + wid; gwv < 2048; gwv += gridDim.x * 8) {
        const int bh = gwv >> 8, k = gwv & 255;
        const bf16_t* row = (const bf16_t*)(ws + 11 * PLANE) + (size_t)((bh >> 2) * 1024 + (bh & 3) * 256 + k) * 8192;
        float n = 0.f;
        u32x4 nv[16];
#pragma unroll
        for (int c = 0; c < 16; ++c) nv[c] = *(const u32x4*)(row + c * 512 + lane * 8);
#pragma unroll
        for (int c = 0; c < 16; ++c) {
            const u32x4 v = nv[c];
            float s = bflo(v.x) + bfhi(v.x) + bflo(v.y) + bfhi(v.y) + bflo(v.z) + bfhi(v.z) + bflo(v.w) + bfhi(v.w);
            s = wave_sum(s);
            if (lane == 0) nst[(size_t)(bh * 16 + c) * 256 + k] = (bf16_t)(pk2(n, n) & 0xffff);
            const float dec = exp2f(MP[bh * 32 + c] - MP[bh * 32 + c + 1]);
            n = dec * n + s;
        }
    }
}

#define MFMA32(a, b, c) __builtin_amdgcn_mfma_f32_32x32x16_bf16(a, b, c, 0, 0, 0)
#define EXP2RAW(x) __builtin_amdgcn_exp2f(x)
template <int MODE>
__device__ __forceinline__ void attn_unit(const Args& a, int l, int b, int h, int qb, LAS unsigned char* lds, int tid, const bool dry = false) {
    constexpr int DH = MODE ? 256 : 128, KS = DH / 16, QROWS = MODE ? 128 : 256, VROWS = DH, KP = DH * 2 + 16, VP = 144;
    constexpr int KCH = 64 * DH / 8 / 512, VCH = VROWS * 8 / 512;
    constexpr int KBYTES = 64 * KP, VBYTES = VROWS * VP, BUF = KBYTES + VBYTES + 256;
    constexpr int NBUF = MODE ? 1 : 2;
    unsigned char* ws = a.ws;
    const int wid = __builtin_amdgcn_readfirstlane(tid >> 6), lane = tid & 63, l32 = lane & 31, hi = lane >> 5;
    const int rg = MODE ? (wid & 3) : wid, vh = MODE ? (wid >> 2) : 0;
    const int q0 = qb * QROWS + rg * 32, tq = q0 + l32;
    const bf16_t* Qp = (const bf16_t*)(ws + (size_t)(MODE ? 3 : 7) * PLANE);
    const bf16_t* Kp = (const bf16_t*)(ws + (size_t)(MODE ? 4 : 8) * PLANE);
    const bf16_t* VTp = (const bf16_t*)(ws + (size_t)(MODE ? 5 : 9) * PLANE);
    const int bh = MODE ? (b * 4 + h) : (b * 8 + h);
    const float* biasG = MODE ? ((const float*)(ws + OFF_A2) + (size_t)bh * S) : ((const float*)(ws + OFF_F2) + (size_t)bh * S);
    LAS float* red = (LAS float*)(lds + NBUF * BUF);
    LAS unsigned char* Qs = lds + NBUF * BUF + 1024;
    LAS int* flags = (LAS int*)red;

    bf16x8 qf[MODE ? 1 : KS];
    if (MODE) {
        __syncthreads();
#pragma unroll
        for (int i = 0; i < 8; ++i) { const int q = tid + i * 512, r = q >> 5, cc = q & 31;
            *(LAS u32x4*)(Qs + r * KP + cc * 16) = *(const u32x4*)(Qp + (size_t)(b * S + qb * QROWS + r) * 1024 + h * DH + cc * 8); }
    } else {
#pragma unroll
        for (int ks = 0; ks < KS; ++ks) qf[ks] = *(const bf16x8*)(Qp + (size_t)(b * S + tq) * 1024 + h * DH + ks * 16 + hi * 8);
    }
#define QF(ks) (MODE ? *(const LAS bf16x8*)(Qs + (rg * 32 + l32) * KP + ((ks) * 16 + hi * 8) * 2) : qf[MODE ? 0 : (ks)])
    f32x16 O[4];
#pragma unroll
    for (int vb = 0; vb < 4; ++vb)
#pragma unroll
        for (int i = 0; i < 16; ++i) O[vb][i] = 0.f;
    const float rowb = biasG[tq];
    float m_run = -INFINITY, l_run = 0.f, den_inter = 0.f, M2t = 0.f;
    int j0 = 0, j1 = qb * 4 + 3;
    u32x4 kreg[KCH], vreg[VCH]; float breg = 0.f;
    auto gloadK = [&](int j) {
#pragma unroll
        for (int i = 0; i < KCH; ++i) { const int q = tid + i * 512, r = q / (DH / 8), cc = q % (DH / 8); kreg[i] = *(const u32x4*)(Kp + (size_t)(b * S + j * 64 + r) * 1024 + h * DH + cc * 8); }
    };
    auto gloadV = [&](int j) {
#pragma unroll
        for (int i = 0; i < VCH; ++i) { const int q = tid + i * 512, r = q >> 3, cc = q & 7; vreg[i] = *(const u32x4*)(VTp + (size_t)(b * 1024 + h * DH + r) * 8192 + j * 64 + cc * 8); }
        if (tid < 64) breg = biasG[j * 64 + tid];
    };
    auto gload = [&](int j) { gloadK(j); gloadV(j); };
    auto lwrite = [&](LAS unsigned char* bufp) {
#pragma unroll
        for (int i = 0; i < KCH; ++i) { const int q = tid + i * 512, r = q / (DH / 8), cc = q % (DH / 8); *(LAS u32x4*)(bufp + r * KP + cc * 16) = kreg[i]; }
#pragma unroll
        for (int i = 0; i < VCH; ++i) { const int q = tid + i * 512, r = q >> 3, cc = q & 7; LAS unsigned char* vp = bufp + KBYTES + r * VP + (cc >> 1) * 32 + (cc & 1) * 8;
            *(LAS u32x2*)vp = (u32x2){vreg[i].x, vreg[i].y}; *(LAS u32x2*)(vp + 16) = (u32x2){vreg[i].z, vreg[i].w}; }
        if (tid < 64) ((LAS float*)(bufp + KBYTES + VBYTES))[tid] = breg;
    };
    if (MODE) {
        const int ch = qb >> 2; j0 = ch * 8; j1 = qb * 2 + 1;
        M2t = ((const float*)(ws + OFF_M2))[(size_t)bh * S + tq];
        const bf16_t* Cb = (const bf16_t*)(ws + OFF_CST) + (size_t)(bh * 16 + ch) * 65536;
        if (tid < 32) ((LAS u32x4*)red)[tid] = *(const u32x4*)((const bf16_t*)(ws + OFF_NST) + (size_t)(bh * 16 + ch) * 256 + tid * 8);
#pragma unroll 1
        for (int half = 0; half < 2; ++half)
#pragma unroll
        for (int cl = 0; cl < 2; ++cl) {
            const int ci = half * 2 + cl;
#pragma unroll
            for (int i = 0; i < KCH; ++i) { const int q = tid + i * 512, r = q >> 5, cc = q & 31; kreg[i] = *(const u32x4*)(Cb + (size_t)(ci * 64 + r) * 256 + cc * 8); }
            __syncthreads();
#pragma unroll
            for (int i = 0; i < KCH; ++i) { const int q = tid + i * 512, r = q >> 5, cc = q & 31; *(LAS u32x4*)(lds + r * KP + cc * 16) = kreg[i]; }
            __syncthreads();
            if (vh == half) {
#pragma unroll
                for (int vbl = 0; vbl < 2; ++vbl)
#pragma unroll
                    for (int ks = 0; ks < KS; ++ks) { const bf16x8 af = *(const LAS bf16x8*)(lds + (vbl * 32 + l32) * KP + (ks * 16 + hi * 8) * 2); O[cl * 2 + vbl] = MFMA32(af, QF(ks), O[cl * 2 + vbl]); }
            }
        }
        float nq = 0.f;
#pragma unroll
        for (int ks = 0; ks < KS; ++ks) { const bf16x8 qv = QF(ks); const u32x4 nv = *(const LAS u32x4*)((LAS unsigned char*)red + (ks * 16 + hi * 8) * 2);
            nq += bf2f((unsigned short)qv[0]) * bflo(nv.x) + bf2f((unsigned short)qv[1]) * bfhi(nv.x) + bf2f((unsigned short)qv[2]) * bflo(nv.y) + bf2f((unsigned short)qv[3]) * bfhi(nv.y)
                + bf2f((unsigned short)qv[4]) * bflo(nv.z) + bf2f((unsigned short)qv[5]) * bfhi(nv.z) + bf2f((unsigned short)qv[6]) * bflo(nv.w) + bf2f((unsigned short)qv[7]) * bfhi(nv.w); }
        nq += __shfl_xor(nq, 32);
        const float winter = EXP2RAW(((const float*)(ws + OFF_MP2))[bh * 32 + ch] - M2t);
#pragma unroll
        for (int vb = 0; vb < 4; ++vb)
#pragma unroll
            for (int i = 0; i < 16; ++i) O[vb][i] *= winter;
        den_inter = winter * nq;
    }
    float Bt = 0.f;
    if (!MODE) {
        float qs = 0.f;
#pragma unroll
        for (int ks = 0; ks < (MODE ? 1 : KS); ++ks)
#pragma unroll
            for (int e = 0; e < 8; ++e) { const float f = bf2f((unsigned short)qf[ks][e]); qs += f * f; }
        qs += __shfl_xor(qs, 32);
        const float kn2 = __uint_as_float(((const unsigned*)(ws + OFF_KN2))[bh]);
        Bt = sqrtf(qs * kn2) * 1.01f + rowb;
    }
    const int ntile = j1 - j0 + 1;
    gload(MODE ? j0 : j1);
    __syncthreads();
    lwrite(lds);
    __syncthreads();
    if (!MODE && ntile > 1) gload(j1 - 1);
    for (int jt = 0; jt < ntile; ++jt) {
        const int j = MODE ? (j0 + jt) : (j1 - jt);
        LAS unsigned char* cur = lds + (MODE ? 0 : (jt & 1) * BUF);
        LAS unsigned char* Ks = cur; LAS unsigned char* Vs = cur + KBYTES; LAS float* biasK = (LAS float*)(cur + KBYTES + VBYTES);
        if (j * 64 <= q0 + 31) {
            bf16x8 pb[2][2];
            const bool diag = (j * 64 + 63 > q0);
            if (MODE) {
                float ls = 0.f;
#pragma unroll
                for (int kb = 0; kb < 2; ++kb) {
                    f32x16 s1;
#pragma unroll
                    for (int i = 0; i < 16; ++i) s1[i] = 0.f;
                    int zo = 0; asm volatile("" : "+v"(zo));
                    const LAS unsigned char* qrow = Qs + (rg * 32 + l32) * KP + hi * 16 + zo;
#pragma unroll
                    for (int ks = 0; ks < KS; ++ks) { const bf16x8 af = *(const LAS bf16x8*)(Ks + (kb * 32 + l32) * KP + (ks * 16 + hi * 8) * 2); s1 = MFMA32(af, *(const LAS bf16x8*)(qrow + ks * 32), s1); }
#pragma unroll
                    for (int i4 = 0; i4 < 4; ++i4) { const f32x4 bk = *(const LAS f32x4*)(biasK + kb * 32 + 8 * i4 + 4 * hi);
#pragma unroll
                        for (int r = 0; r < 4; ++r) { const int i = i4 * 4 + r; const int key = j * 64 + kb * 32 + 8 * i4 + 4 * hi + r;
                            float w = EXP2RAW(bk[r] - M2t); if (diag && key > tq) w = 0.f;
                            const float p = s1[i] * w; s1[i] = p; ls += p; } }
#pragma unroll
                    for (int jj = 0; jj < 2; ++jj) {
                        u32x4 w; w.x = pk2(s1[8 * jj + 0], s1[8 * jj + 1]); w.y = pk2(s1[8 * jj + 2], s1[8 * jj + 3]);
                        w.z = pk2(s1[8 * jj + 4], s1[8 * jj + 5]); w.w = pk2(s1[8 * jj + 6], s1[8 * jj + 7]);
                        pb[kb][jj] = __builtin_bit_cast(bf16x8, w);
                    }
                }
                l_run += ls;
            } else {
                f32x16 s[2];
#pragma unroll
                for (int kb = 0; kb < 2; ++kb) {
#pragma unroll
                    for (int i4 = 0; i4 < 4; ++i4) { const f32x4 bk = *(const LAS f32x4*)(biasK + kb * 32 + 8 * i4 + 4 * hi);
#pragma unroll
                        for (int r = 0; r < 4; ++r) s[kb][i4 * 4 + r] = rowb - bk[r]; }
#pragma unroll
                    for (int ks = 0; ks < KS; ++ks) { const bf16x8 af = *(const LAS bf16x8*)(Ks + (kb * 32 + l32) * KP + (ks * 16 + hi * 8) * 2); s[kb] = MFMA32(af, qf[MODE ? 0 : ks], s[kb]); }
                }
                if (diag) {
#pragma unroll
                    for (int kb = 0; kb < 2; ++kb)
#pragma unroll
                        for (int i = 0; i < 16; ++i) { const int key = j * 64 + kb * 32 + crow(i, hi); if (key > tq) s[kb][i] = -INFINITY; }
                }
                float mx = -INFINITY;
#pragma unroll
                for (int kb = 0; kb < 2; ++kb)
#pragma unroll
                    for (int i = 0; i < 16; ++i) mx = fmaxf(mx, s[kb][i]);
                mx = fmaxf(mx, __shfl_xor(mx, 32));
                const float m_new = fmaxf(m_run, mx);
                const float alpha = EXP2RAW(m_run - m_new);
                float ls = 0.f;
#pragma unroll
                for (int kb = 0; kb < 2; ++kb)
#pragma unroll
                    for (int i = 0; i < 16; ++i) { const float p = EXP2RAW(s[kb][i] - m_new); s[kb][i] = p; ls += p; }
                l_run = l_run * alpha + ls; m_run = m_new;
                if (__ballot(alpha != 1.f) != 0ull) {
#pragma unroll
                    for (int vb = 0; vb < 4; ++vb)
#pragma unroll
                        for (int i = 0; i < 16; ++i) O[vb][i] *= alpha;
                }
#pragma unroll
                for (int kb = 0; kb < 2; ++kb)
#pragma unroll
                    for (int jj = 0; jj < 2; ++jj) {
                        u32x4 w; w.x = pk2(s[kb][8 * jj + 0], s[kb][8 * jj + 1]); w.y = pk2(s[kb][8 * jj + 2], s[kb][8 * jj + 3]);
                        w.z = pk2(s[kb][8 * jj + 4], s[kb][8 * jj + 5]); w.w = pk2(s[kb][8 * jj + 6], s[kb][8 * jj + 7]);
                        pb[kb][jj] = __builtin_bit_cast(bf16x8, w);
                    }
            }
#pragma unroll
            for (int vb = 0; vb < 4; ++vb)
#pragma unroll
                for (int kb = 0; kb < 2; ++kb)
#pragma unroll
                    for (int jj = 0; jj < 2; ++jj) {
                        const bf16x8 af = *(const LAS bf16x8*)(Vs + (vh * 128 + vb * 32 + l32) * VP + (kb * 2 + jj) * 32 + hi * 16);
                        O[vb] = MFMA32(af, pb[kb][jj], O[vb]);
                    }
        }
        if (jt + 1 < ntile) {
            if (!MODE) {
                const float fk_last = biasG[(j - 1) * 64 + 63];
                const bool need = !((Bt - fk_last) - m_run < -160.f);
                const unsigned long long bal = __ballot(need);
                if (lane == 0) flags[wid] = (bal != 0ull) ? 1 : 0;
                lwrite(lds + ((jt + 1) & 1) * BUF);
                __syncthreads();
                const int any = flags[0] | flags[1] | flags[2] | flags[3] | flags[4] | flags[5] | flags[6] | flags[7];
                if (!any) break;
                if (jt + 2 < ntile) gload(j - 2);
            } else {
                gload(j + 1);
                __syncthreads();
                lwrite(lds);
                __syncthreads();
            }
        }
    }
    const size_t rowoff = (size_t)(b * S + tq) * 1024;
    if (!MODE) {
        const float lt = l_run + __shfl_xor(l_run, 32);
        const float inv = 1.f / lt;
        bf16_t* bz = (bf16_t*)(ws + 1 * PLANE) + rowoff + h * 128;
#pragma unroll
        for (int vb = 0; vb < 4; ++vb)
#pragma unroll
            for (int i4 = 0; i4 < 4; ++i4) {
                bf16_t* p = bz + vb * 32 + 8 * i4 + 4 * hi;
                const u32x2 z = *(const u32x2*)p;
                u32x2 w; w.x = pk2(O[vb][i4 * 4 + 0] * inv * silu(bflo(z.x)), O[vb][i4 * 4 + 1] * inv * silu(bfhi(z.x)));
                w.y = pk2(O[vb][i4 * 4 + 2] * inv * silu(bflo(z.y)), O[vb][i4 * 4 + 3] * inv * silu(bfhi(z.y)));
                if (!dry) *(u32x2*)p = w;
            }
    } else {
        const float den = l_run + __shfl_xor(l_run, 32) + den_inter;
        const float em = ((const float*)(ws + OFF_EM))[(size_t)bh * S + tq];
        const float invd = 1.f / fmaxf(fabsf(den), em);
        float ssq = 0.f;
#pragma unroll
        for (int vb = 0; vb < 4; ++vb)
#pragma unroll
            for (int i = 0; i < 16; ++i) { O[vb][i] *= invd; ssq += O[vb][i] * O[vb][i]; }
        ssq += __shfl_xor(ssq, 32);
        if (hi == 0) red[(vh * 4 + rg) * 32 + l32] = ssq;
        __syncthreads();
        const float tot = red[rg * 32 + l32] + red[(4 + rg) * 32 + l32];
        const float rs = rsqrtf(tot * (1.f / 256.f) + EPS);
        const float* ng = a.in[6] + (size_t)l * D + h * 256 + vh * 128;
        bf16_t* az = (bf16_t*)(ws) + rowoff + h * 256 + vh * 128;
        const bf16_t* ao = (const bf16_t*)(ws + 6 * PLANE) + rowoff + h * 256 + vh * 128;
#pragma unroll
        for (int vb = 0; vb < 4; ++vb)
#pragma unroll
            for (int i4 = 0; i4 < 4; ++i4) {
                const int v = vb * 32 + 8 * i4 + 4 * hi;
                const u32x2 z = *(const u32x2*)(az + v), o = *(const u32x2*)(ao + v);
                const f32x4 g = *(const f32x4*)(ng + v);
                u32x2 w;
                w.x = pk2(O[vb][i4 * 4 + 0] * rs * g[0] * sigm(bflo(o.x)) * silu(bflo(z.x)), O[vb][i4 * 4 + 1] * rs * g[1] * sigm(bfhi(o.x)) * silu(bfhi(z.x)));
                w.y = pk2(O[vb][i4 * 4 + 2] * rs * g[2] * sigm(bflo(o.y)) * silu(bflo(z.y)), O[vb][i4 * 4 + 3] * rs * g[3] * sigm(bfhi(o.y)) * silu(bfhi(z.y)));
                if (!dry) *(u32x2*)(az + v) = w;
            }
    }
#undef QF
}

__device__ __forceinline__ void phase_attn(const Args& a, int l, LAS unsigned char* lds, int tid, const bool dry = false) {
    LAS int* slot = (LAS int*)(lds + LDS_BYTES - 16);
    unsigned* ctr = (unsigned*)(a.ws + OFF_QCTR) + (dry ? 2 : 0);
    if ((ATTNMASK & 1) && (!dry || (PROBE_DRYMASK & 1))) {
        for (;;) {
            __syncthreads();
            if (tid == 0) *slot = (int)__hip_atomic_fetch_add(ctr, 1u, __ATOMIC_RELAXED, __HIP_MEMORY_SCOPE_AGENT);
            __syncthreads();
            const int idx = *slot;
            if (idx >= 512) break;
            const int h = 7 - (idx >> 6), r = idx & 63;
            attn_unit<0>(a, l, r & 1, h, 31 - (r >> 1), lds, tid, dry);
        }
    }
    __syncthreads();
    if ((ATTNMASK & 2) && (!dry || (PROBE_DRYMASK & 2))) {
        int t2 = tid; asm volatile("" : "+v"(t2));
        for (;;) {
            __syncthreads();
            if (t2 == 0) *slot = (int)__hip_atomic_fetch_add(ctr + 1, 1u, __ATOMIC_RELAXED, __HIP_MEMORY_SCOPE_AGENT);
            __syncthreads();
            const int idx = *slot;
            if (idx >= 512) break;
            const int qm = 3 - (idx >> 7), r = idx & 127, bh = r & 7, ch = r >> 3;
            attn_unit<1>(a, l, bh >> 2, bh & 3, ch * 4 + qm, lds, t2, dry);
        }
    }
    __syncthreads();
}

__device__ __forceinline__ void phase_pool(const Args& a, int tid) {
    const bool dry = PROBE_RPT ? (a.dry != 0) : false;
    unsigned char* ws = a.ws;
    const bf16_t* cu = (const bf16_t*)(ws + 3 * PLANE); bf16_t* cz = (bf16_t*)(ws + 2 * PLANE);
    for (int idx = blockIdx.x * 512 + tid; idx < (M / 4) * 128; idx += gridDim.x * 512) {
        const int r0 = (idx >> 7) * 4, c = (idx & 127) * 8, g = c >> 8, W = 2 << g, t0 = r0 & 8191;
        u32x4 xv[19], zv[4];
#pragma unroll
        for (int i = 0; i < 19; ++i) { const int dt = i - 15; xv[i] = (dt >= 1 - W && t0 + dt >= 0) ? *(const u32x4*)(cu + (size_t)(r0 + dt) * 1024 + c) : (u32x4){0u, 0u, 0u, 0u}; }
#pragma unroll
        for (int q = 0; q < 4; ++q) zv[q] = *(const u32x4*)(cz + (size_t)(r0 + q) * 1024 + c);
#pragma unroll
        for (int q = 0; q < 4; ++q) {
            const int t = t0 + q, cnt = (t + 1 < W) ? t + 1 : W;
            float s[8];
#pragma unroll
            for (int j = 0; j < 8; ++j) s[j] = 0.f;
#pragma unroll
            for (int k = 0; k < 16; ++k) { if (k < cnt) { const u32x4 v = xv[15 + q - k];
                s[0] += bflo(v.x); s[1] += bfhi(v.x); s[2] += bflo(v.y); s[3] += bfhi(v.y); s[4] += bflo(v.z); s[5] += bfhi(v.z); s[6] += bflo(v.w); s[7] += bfhi(v.w); } }
            const float ic = 1.f / (float)cnt;
            const u32x4 cv = xv[15 + q], z = zv[q];
            const float cur[8] = {bflo(cv.x), bfhi(cv.x), bflo(cv.y), bfhi(cv.y), bflo(cv.z), bfhi(cv.z), bflo(cv.w), bfhi(cv.w)};
            const float zf[8] = {bflo(z.x), bfhi(z.x), bflo(z.y), bfhi(z.y), bflo(z.z), bfhi(z.z), bflo(z.w), bfhi(z.w)};
            float o[8];
#pragma unroll
            for (int j = 0; j < 8; ++j) o[j] = (s[j] * ic - cur[j]) * silu(zf[j]);
            u32x4 w; w.x = pk2(o[0], o[1]); w.y = pk2(o[2], o[3]); w.z = pk2(o[4], o[5]); w.w = pk2(o[6], o[7]);
            if (!dry) *(u32x4*)(cz + (size_t)(r0 + q) * 1024 + c) = w;
        }
    }
}

__device__ __forceinline__ void phase_final(const Args& a, int tid) {
    const float* fg = a.in[12]; float* out = a.out;
    const int wid = tid >> 6, lane = tid & 63;
    f32x4 gg[4];
#pragma unroll
    for (int j = 0; j < 4; ++j) gg[j] = *(const f32x4*)(fg + j * 256 + lane * 4);
    for (int row = blockIdx.x * 8 + wid; row < M; row += gridDim.x * 8) {
        f32x4 xv[4]; float ss = 0.f;
#pragma unroll
        for (int j = 0; j < 4; ++j) { xv[j] = *(const f32x4*)(out + (size_t)row * D + j * 256 + lane * 4); ss += xv[j][0] * xv[j][0] + xv[j][1] * xv[j][1] + xv[j][2] * xv[j][2] + xv[j][3] * xv[j][3]; }
        ss = wave_sum(ss);
        const float r = rsqrtf(ss * (1.f / 1024.f) + EPS);
#pragma unroll
        for (int j = 0; j < 4; ++j) *(f32x4*)(out + (size_t)row * D + j * 256 + lane * 4) = (xv[j] * r) * gg[j];
    }
}

__global__ void __launch_bounds__(512) mega(Args a0) {
    extern __shared__ __attribute__((aligned(16))) unsigned char lds_raw[];
    LAS unsigned char* lds = (LAS unsigned char*)lds_raw;
    for (int ph = a0.ph_lo; ph < a0.ph_hi; ++ph) {
        Args a = a0; asm volatile("" : "+s"(a.ws), "+s"(a.out));
        unsigned char* ws = a.ws; int G = gridDim.x, cb = blockIdx.x; asm volatile("" : "+s"(G), "+s"(cb));
        int tid = threadIdx.x; asm volatile("" : "+v"(tid));
        const int l = ph / 10, k = (ph == 20) ? 10 : ph % 10;
        if (k == 0 && (PHMASK & 1)) phase_prep(a, l, lds, tid);
        else if (k == 1 && (PHMASK >> 1 & 1)) {
            phase_scans(a, l, lds, tid);
            pg8::Gemm g{(const bf16_t*)(ws + 10 * PLANE), (const bf16_t*)(ws + OFF_WT1), 1024, 1024, 1024};
            SchedStd Sd; Sd.init(64, 36, G, cb, 1024, 1024);
            EpiG1 E{ws};
            pg8::gemm_phase<EpiG1, SchedStd, true, true>(lds, g, Sd, E, tid);
        }
        else if (k == 2 && (PHMASK >> 2 & 1)) phase_conv(a, l, lds, tid);
        else if (k == 3 && (PHMASK >> 3 & 1)) {
            pg8::Gemm g{(const bf16_t*)(ws + 5 * PLANE), (const bf16_t*)(ws + 11 * PLANE), 8192, 8192, 512};
            SchedA1 Sd{G, cb};
            EpiPlain E{(bf16_t*)(ws + OFF_CST), 256, (size_t)65536, 0};
            pg8::gemm_phase<EpiPlain, SchedA1, true, true>(lds, g, Sd, E, tid);
        }
        else if (k == 4 && (PHMASK >> 4 & 1)) phase_statescan(a, tid);
        else if (k == 5 && (PHMASK >> 5 & 1)) phase_attn(a, l, lds, tid, PROBE_RPT ? (a.dry != 0) : false);
        else if (k == 6 && (PHMASK >> 6 & 1)) {
            pg8::Gemm g{(const bf16_t*)(ws + 10 * PLANE), (const bf16_t*)(ws + OFF_WT1B), 1024, 1024, 1024};
            SchedStd Sd; Sd.init(64, 20, G, cb, 1024, 1024);
            EpiPlain E{(bf16_t*)(ws + 2 * PLANE), 1024, (size_t)0, 1};
            pg8::gemm_phase<EpiPlain, SchedStd, true, true>(lds, g, Sd, E, tid);
        }
        else if (k == 7 && (PHMASK >> 7 & 1)) phase_pool(a, tid);
        else if (k == 8 && (PHMASK >> 8 & 1)) {
            pg8::Gemm g{(const bf16_t*)(ws), (const bf16_t*)(ws + OFF_WT2), 1024, 1024, 1024};
            SchedG2 Sd{G, cb};
            EpiG2 E{(const bf16_t*)(ws + 4 * PLANE), (bf16_t*)(ws + 7 * PLANE), (bf16_t*)(ws + 9 * PLANE)};
            pg8::gemm_phase<EpiG2, SchedG2, true, true>(lds, g, Sd, E, tid);
        }
        else if (k == 9 && (PHMASK >> 9 & 1)) {
            pg8::Gemm g{(const bf16_t*)(ws + 9 * PLANE), (const bf16_t*)(ws + OFF_WT3), 1024, 1024, 1024};
            SchedStd Sd; Sd.init(64, 4, G, cb, 1024, 1024);
            EpiG3 E{(l == 0) ? a.in[0] : a.out, a.out};
            pg8::gemm_phase<EpiG3, SchedStd, true, true>(lds, g, Sd, E, tid);
        }
        else if (k == 10 && (PHMASK >> 10 & 1)) phase_final(a, tid);
        if (ph + 1 < a0.ph_hi) { __syncthreads(); cg::this_grid().sync(); }
    }
}

extern "C" void kernel_launch(void* const* d_in, const int* in_sizes, int n_in, void* d_out, int out_size, void* d_ws, size_t ws_size, hipStream_t stream) {
    static int grid_blocks = 0;
    if (!grid_blocks) {
        hipFuncSetAttribute((const void*)mega, hipFuncAttributeMaxDynamicSharedMemorySize, LDS_BYTES);
        int dev = 0, cus = 0, per_cu = 0;
        hipGetDevice(&dev);
        hipDeviceGetAttribute(&cus, hipDeviceAttributeMultiprocessorCount, dev);
        hipOccupancyMaxActiveBlocksPerMultiprocessor(&per_cu, mega, 512, LDS_BYTES);
        if (per_cu < 1) per_cu = 1;
        grid_blocks = cus * per_cu; if (grid_blocks > 256) grid_blocks = 256;
    }
    if (ws_size < OFF_END) { fprintf(stderr, "workspace too small: %zu < %zu\n", ws_size, (size_t)OFF_END); return; }
    Args a{};
    for (int i = 0; i < 13; ++i) a.in[i] = (const float*)d_in[i];
    a.out = (float*)d_out; a.ws = (unsigned char*)d_ws;
#if MK_MULTI
    for (int ph = 0; ph < NPH; ++ph) {
        const int k = (ph == 20) ? 10 : ph % 10;
        const int reps = ((PROBE_RPT >> k) & 1) ? 2 : 1;
        for (int rep = 0; rep < reps; ++rep) { a.ph_lo = ph; a.ph_hi = ph + 1; a.dry = (reps == 2 && rep == 0) ? 1 : 0;
            hipLaunchKernelGGL(mega, dim3(grid_blocks), dim3(512), LDS_BYTES, stream, a); }
    }
#else
    a.ph_lo = 0; a.ph_hi = NPH;
    void* args[] = {&a};
    hipError_t e = hipLaunchCooperativeKernel((void*)mega, dim3(grid_blocks), dim3(512), args, LDS_BYTES, stream);
    if (e != hipSuccess) fprintf(stderr, "cooperative launch failed: %s (grid %d)\n", hipGetErrorString(e), grid_blocks);
#endif
}
```

```cpp
#include <hip/hip_runtime.h>
#include <hip/hip_cooperative_groups.h>
#include <cstdio>
#include <cstdint>
namespace cg = cooperative_groups;

#ifndef MK_MULTI
#define MK_MULTI 0
#endif

namespace pg8 {
#define PG8_LAS __attribute__((address_space(3)))
typedef unsigned short bf16_t;
typedef short bf16x8 __attribute__((ext_vector_type(8)));
typedef float f32x4 __attribute__((ext_vector_type(4)));
typedef unsigned u32x4 __attribute__((ext_vector_type(4)));
constexpr int BM = 256, BK = 64, HALF = 128, HTB = HALF * BK * 2  , STAGE_BYTES = 8 * HTB, NXCD = 8, WGM = 8;

__host__ __device__ __forceinline__ int lds_byte(int r, int c) { const int st = (r >> 4) * 2 + (c >> 5), rr = r & 15, cc = c & 31, ob = rr * 64 + cc * 2; return st * 1024 + (ob ^ (((ob >> 9) & 1) << 5)); }
__host__ __device__ __forceinline__ void stage_rc(int b, int& R, int& C) { const int st = b / 1024, sb = b % 1024, swz = sb ^ (((sb >> 9) & 1) << 5); R = (st >> 1) * 16 + swz / 64; C = (st & 1) * 32 + (swz % 64) / 2; }
__host__ __device__ __forceinline__ int perm32(int rho) { const int n = rho >> 4, i = rho & 15; return 8 * (i >> 2) + 4 * n + (i & 3); }

struct Unit { int pm, pn, z; };
struct Gemm { const bf16_t* A; const bf16_t* Bt; int lda, ldb, K; };

__device__ __forceinline__ unsigned cvt_pk_bf16(float lo, float hi) { unsigned r; asm volatile("v_cvt_pk_bf16_f32 %0, %1, %2" : "=v"(r) : "v"(lo), "v"(hi)); return r; }

template <class Epi, class Sched, bool ALIGN_EPI = false, bool SP2 = false>
__device__ __forceinline__ void gemm_phase(PG8_LAS unsigned char* lds, const Gemm g, const Sched& S, const Epi& E, const int tid) {
    const int wid = __builtin_amdgcn_readfirstlane(tid >> 6), lane = tid & 63, wr = wid >> 2, wc = wid & 3, fr = lane & 15, fq = lane >> 4;
    const int K = g.K, nt = K / BK;
    unsigned voffA[2], voffB[2];
#pragma unroll
    for (int i = 0; i < 2; ++i) { int R, C; stage_rc(tid * 16 + i * 8192, R, C); const int Rb = Epi::PERM ? ((R & ~31) + perm32(R & 31)) : R;
        voffA[i] = (unsigned)(R * g.lda + C) * 2u; voffB[i] = (unsigned)(Rb * g.ldb + C) * 2u; }
    const size_t kstep = (size_t)(BK * 2);
    const size_t hstepA = (size_t)HALF * g.lda * 2, hstepB = (size_t)HALF * g.ldb * 2;
    const unsigned ldsw = (unsigned)wid * 1024u;
    const int aoff = lds_byte(wr * 64 + fr, fq * 8), boff = lds_byte(wc * 32 + fr, fq * 8);
#define PG8_SA(b, h) (((b) * 2 + (h)) * HTB)
#define PG8_SB(b, h) ((4 + (b) * 2 + (h)) * HTB)
#define PG8_STAGE(bufoff, gbase, voff) do { _Pragma("unroll") for (int _i = 0; _i < 2; ++_i) \
        __builtin_amdgcn_global_load_lds((const unsigned*)((const char*)(gbase) + (voff)[_i]), (PG8_LAS unsigned*)(lds + (bufoff) + ldsw + _i * 8192), 16, 0, 0); } while (0)
#define PG8_LDA(dst, b, h) do { _Pragma("unroll") for (int m = 0; m < 4; ++m) _Pragma("unroll") for (int k = 0; k < 2; ++k) dst[m][k] = *(const PG8_LAS bf16x8*)(lds + PG8_SA(b, h) + aoff + m * 2048 + k * 1024); } while (0)
#define PG8_LDB(dst, b, h) do { _Pragma("unroll") for (int n = 0; n < 2; ++n) _Pragma("unroll") for (int k = 0; k < 2; ++k) dst[n][k] = *(const PG8_LAS bf16x8*)(lds + PG8_SB(b, h) + boff + n * 2048 + k * 1024); } while (0)
#define PG8_MMA(ai, bj, At, Bt) do { __builtin_amdgcn_s_setprio(1); _Pragma("unroll") for (int m = 0; m < 4; ++m) _Pragma("unroll") for (int n = 0; n < 2; ++n) _Pragma("unroll") for (int k = 0; k < 2; ++k) \
        acc[ai][bj][m][n] = __builtin_amdgcn_mfma_f32_16x16x32_bf16(Bt[n][k], At[m][k], acc[ai][bj][m][n], 0, 0, 0); __builtin_amdgcn_s_setprio(0); } while (0)
#define PG8_WAIT_V(n) asm volatile("s_waitcnt vmcnt(" #n ")" ::: "memory")
#define PG8_WAIT_L(n) asm volatile("s_waitcnt lgkmcnt(" #n ")" ::: "memory")
#define PG8_BAR __builtin_amdgcn_s_barrier()
#define PG8_SCHED __builtin_amdgcn_sched_barrier(0)
    Unit cur, nxt; int ui = 0;
    if (!S.next(0, cur)) return;
    f32x4 acc[2][2][4][2];
#pragma unroll
    for (int a = 0; a < 2; ++a)
#pragma unroll
        for (int b = 0; b < 2; ++b)
#pragma unroll
            for (int m = 0; m < 4; ++m)
#pragma unroll
                for (int n = 0; n < 2; ++n) acc[a][b][m][n] = (f32x4){0.f, 0.f, 0.f, 0.f};
    bf16x8 At[4][2], B0[2][2], B1[2][2];
    const char* cA = (const char*)g.A + S.a_off(cur); const char* cB = (const char*)g.Bt + S.b_off(cur);
    S.a_ready(cur);
    if constexpr (SP2) {
        PG8_STAGE(PG8_SB(0, 0), cB, voffB); PG8_STAGE(PG8_SB(0, 1), cB + hstepB, voffB); PG8_STAGE(PG8_SA(0, 0), cA, voffA); PG8_STAGE(PG8_SA(0, 1), cA + hstepA, voffA);
        if (wr == 1) PG8_BAR;
        PG8_WAIT_V(2); PG8_BAR;
        PG8_STAGE(PG8_SB(1, 0), cB + kstep, voffB); PG8_STAGE(PG8_SA(1, 0), cA + kstep, voffA); PG8_STAGE(PG8_SB(1, 1), cB + hstepB + kstep, voffB);
        PG8_WAIT_V(6); PG8_BAR;
    } else {
        PG8_STAGE(PG8_SB(0, 0), cB, voffB); PG8_STAGE(PG8_SA(0, 0), cA, voffA); PG8_STAGE(PG8_SB(0, 1), cB + hstepB, voffB); PG8_STAGE(PG8_SA(0, 1), cA + hstepA, voffA);
        if (wr == 1) PG8_BAR;
        PG8_WAIT_V(4); PG8_BAR;
        PG8_STAGE(PG8_SB(1, 0), cB + kstep, voffB); PG8_STAGE(PG8_SA(1, 0), cA + kstep, voffA); PG8_STAGE(PG8_SB(1, 1), cB + hstepB + kstep, voffB);
        PG8_WAIT_V(6); PG8_BAR;
    }
    for (;;) {
        const bool has_next = S.next(ui + 1, nxt);
        const char* nA = has_next ? (const char*)g.A + S.a_off(nxt) : cA; const char* nB = has_next ? (const char*)g.Bt + S.b_off(nxt) : cB;
        for (int t = 0; t < nt; t += 2) {
            const bool last = (t == nt - 2);
            const char* a1 = cA + (size_t)(t + 1) * kstep;
            const char* a2 = last ? nA : cA + (size_t)(t + 2) * kstep; const char* b2 = last ? nB : cB + (size_t)(t + 2) * kstep;
            const char* a3 = a2 + kstep; const char* b3 = b2 + kstep;
            if (last && has_next) S.a_ready(nxt);
            if constexpr (SP2) {
            PG8_LDB(B0, 0, 0); PG8_LDB(B1, 0, 1); PG8_SCHED; PG8_LDA(At, 0, 0); PG8_STAGE(PG8_SA(1, 1), a1 + hstepA, voffA);
            PG8_WAIT_V(8); PG8_WAIT_L(0); PG8_BAR; PG8_MMA(0, 0, At, B0); PG8_MMA(0, 1, At, B1); PG8_BAR; PG8_SCHED;
            PG8_LDA(At, 0, 1); PG8_STAGE(PG8_SB(0, 0), b2, voffB); PG8_STAGE(PG8_SB(0, 1), b2 + hstepB, voffB); PG8_STAGE(PG8_SA(0, 0), a2, voffA);
            PG8_WAIT_V(8); PG8_WAIT_L(0); PG8_BAR; PG8_MMA(1, 0, At, B0); PG8_MMA(1, 1, At, B1); PG8_BAR; PG8_SCHED;
            PG8_LDB(B0, 1, 0); PG8_LDB(B1, 1, 1); PG8_SCHED; PG8_LDA(At, 1, 0); PG8_STAGE(PG8_SA(0, 1), a2 + hstepA, voffA);
            PG8_WAIT_V(8); PG8_WAIT_L(0); PG8_BAR; PG8_MMA(0, 0, At, B0); PG8_MMA(0, 1, At, B1); PG8_BAR; PG8_SCHED;
            PG8_LDA(At, 1, 1); PG8_STAGE(PG8_SB(1, 0), b3, voffB); PG8_STAGE(PG8_SB(1, 1), b3 + hstepB, voffB); PG8_STAGE(PG8_SA(1, 0), a3, voffA);
            PG8_WAIT_V(8); PG8_WAIT_L(0); PG8_BAR; PG8_MMA(1, 0, At, B0); PG8_MMA(1, 1, At, B1); PG8_BAR; PG8_SCHED;
            } else {
            PG8_LDB(B0, 0, 0); PG8_SCHED; PG8_LDA(At, 0, 0); PG8_STAGE(PG8_SA(1, 1), a1 + hstepA, voffA);
            PG8_WAIT_L(8); PG8_BAR; PG8_WAIT_L(0); PG8_MMA(0, 0, At, B0); PG8_BAR; PG8_SCHED;
            PG8_LDB(B1, 0, 1); PG8_STAGE(PG8_SB(0, 0), b2, voffB);
            PG8_BAR; PG8_WAIT_L(0); PG8_MMA(0, 1, At, B1); PG8_BAR;
            PG8_LDA(At, 0, 1); PG8_STAGE(PG8_SA(0, 0), a2, voffA);
            PG8_BAR; PG8_WAIT_L(0); PG8_MMA(1, 0, At, B0); PG8_BAR; PG8_SCHED;
            PG8_STAGE(PG8_SB(0, 1), b2 + hstepB, voffB);
            PG8_WAIT_V(6); PG8_BAR; PG8_MMA(1, 1, At, B1); PG8_BAR;
            PG8_LDB(B0, 1, 0); PG8_SCHED; PG8_LDA(At, 1, 0); PG8_STAGE(PG8_SA(0, 1), a2 + hstepA, voffA);
            PG8_WAIT_L(8); PG8_BAR; PG8_WAIT_L(0); PG8_MMA(0, 0, At, B0); PG8_BAR; PG8_SCHED;
            PG8_LDB(B1, 1, 1); PG8_STAGE(PG8_SB(1, 0), b3, voffB);
            PG8_BAR; PG8_WAIT_L(0); PG8_MMA(0, 1, At, B1); PG8_BAR;
            PG8_LDA(At, 1, 1); PG8_STAGE(PG8_SA(1, 0), a3, voffA);
            PG8_BAR; PG8_WAIT_L(0); PG8_MMA(1, 0, At, B0); PG8_BAR; PG8_SCHED;
            PG8_STAGE(PG8_SB(1, 1), b3 + hstepB, voffB);
            PG8_WAIT_V(6); PG8_BAR; PG8_MMA(1, 1, At, B1); PG8_BAR;
            }
        }
        if constexpr (ALIGN_EPI) { if (wr == 0) PG8_BAR; }
        if constexpr (!Epi::AFTER_DRAIN) { E(acc, cur, wr, wc, fr, fq); S.done(cur); }
        if (!has_next) break;
#pragma unroll
        for (int a = 0; a < 2; ++a)
#pragma unroll
            for (int b = 0; b < 2; ++b)
#pragma unroll
                for (int m = 0; m < 4; ++m)
#pragma unroll
                    for (int n = 0; n < 2; ++n) acc[a][b][m][n] = (f32x4){0.f, 0.f, 0.f, 0.f};
        cur = nxt; cA = nA; cB = nB; ++ui;
        if constexpr (ALIGN_EPI) { if (wr == 1) PG8_BAR; }
    }
    PG8_WAIT_V(0);
    if constexpr (!ALIGN_EPI) { if (wr == 0) PG8_BAR; }
    PG8_BAR;
    if constexpr (Epi::AFTER_DRAIN) { E.fused(acc, cur, wr, wc, fr, fq, lds, wid, lane); S.done(cur); }
#undef PG8_SA
#undef PG8_SB
#undef PG8_STAGE
#undef PG8_LDA
#undef PG8_LDB
#undef PG8_MMA
#undef PG8_WAIT_V
#undef PG8_WAIT_L
#undef PG8_BAR
#undef PG8_SCHED
}
}

#ifndef PG8_SP2
#define PG8_SP2 true
#endif
#ifndef PG8_ALIGN
#define PG8_ALIGN true
#endif

using pg8::bf16_t; using pg8::bf16x8; using pg8::f32x4; using pg8::u32x4;
typedef float f32x16 __attribute__((ext_vector_type(16)));
typedef unsigned u32x2 __attribute__((ext_vector_type(2)));
#define LAS __attribute__((address_space(3)))

constexpr int M = 16384, S = 8192, D = 1024, NIN = 14352;
constexpr size_t PLANE = (size_t)M * D * 2;
constexpr float EPS = 1e-6f, LOG2E = 1.4426950408889634f;
constexpr size_t MiB = 1048576;
constexpr size_t OFF_WT1 = 12 * PLANE, OFF_WT1B = OFF_WT1 + 18 * MiB, OFF_WT2 = OFF_WT1B + 10 * MiB, OFF_WT3 = OFF_WT2 + 6 * MiB,
    OFF_HALO = OFF_WT3 + 2 * MiB, OFF_GATES = OFF_HALO + 3 * MiB, OFF_A2 = OFF_GATES + MiB, OFF_M2 = OFF_A2 + 262144, OFF_EM = OFF_M2 + 262144,
    OFF_WK = OFF_EM + 262144, OFF_F2 = OFF_WK + 262144, OFF_MP2 = OFF_F2 + 524288, OFF_NST = OFF_MP2 + 4096, OFF_KN2 = OFF_NST + 65536, OFF_QCTR = OFF_KN2 + 256, OFF_END = OFF_QCTR + 256;
constexpr size_t OFF_CST = OFF_WT1;
constexpr int LDS_BYTES = 143360;
constexpr int NPH = 21;
#ifndef ATTNMASK
#define ATTNMASK 3
#endif
#ifndef PROBE_RPT
#define PROBE_RPT 0
#endif
#ifndef PROBE_NOPRUNE
#define PROBE_NOPRUNE 0
#endif
#ifndef PROBE_DRYMASK
#define PROBE_DRYMASK 3
#endif
#ifndef PHMASK
#define PHMASK 0x7ff
#endif

struct Args { const float* in[13]; float* out; unsigned char* ws; int ph_lo, ph_hi, dry, pad; };

__device__ __forceinline__ float bf2f(unsigned b) { return __uint_as_float(b << 16); }
__device__ __forceinline__ float bflo(unsigned w) { return __uint_as_float(w << 16); }
__device__ __forceinline__ float bfhi(unsigned w) { return __uint_as_float(w & 0xffff0000u); }
__device__ __forceinline__ unsigned pk2(float lo, float hi) { return pg8::cvt_pk_bf16(lo, hi); }
__device__ __forceinline__ float wave_sum(float v) {
#pragma unroll
    for (int o = 32; o; o >>= 1) v += __shfl_xor(v, o);
    return v; }
__device__ __forceinline__ float sigm(float x) { return __builtin_amdgcn_rcpf(1.f + __builtin_amdgcn_exp2f(-1.4426950408889634f * x)); }
__device__ __forceinline__ float silu(float x) { return x * __builtin_amdgcn_rcpf(1.f + __builtin_amdgcn_exp2f(-1.4426950408889634f * x)); }
__device__ __forceinline__ float logsig(float x) { return fminf(x, 0.f) - log1pf(expf(-fabsf(x))); }
__device__ __forceinline__ int crow(int r, int hi) { return (r & 3) + 8 * (r >> 2) + 4 * hi; }

struct SchedStd {
    int nM, nN, nwg, G, c, lda, ldb;
    __device__ void init(int nM_, int nN_, int G_, int c_, int lda_, int ldb_) { nM = nM_; nN = nN_; nwg = nM * nN; G = G_; c = c_; lda = lda_; ldb = ldb_; }
    __device__ bool next(int i, pg8::Unit& u) const {
        const long L = (long)i * G + c; if (L >= nwg) return false;
        int wgid = (int)L; { const int q = nwg / 8, r = nwg % 8, xcd = wgid % 8, off = wgid / 8; wgid = (xcd < r ? xcd * (q + 1) : r * (q + 1) + (xcd - r) * q) + off; }
        const int nig = 8 * nN, gid = wgid / nig, fm = gid * 8, gsz = (nM - fm) < 8 ? (nM - fm) : 8;
        u.pm = fm + ((wgid % nig) % gsz); u.pn = (wgid % nig) / gsz; u.z = 0; return true;
    }
    __device__ __forceinline__ size_t a_off(const pg8::Unit& u) const { return (size_t)u.pm * 256 * lda * 2; }
    __device__ __forceinline__ size_t b_off(const pg8::Unit& u) const { return (size_t)u.pn * 256 * ldb * 2; }
    __device__ __forceinline__ void a_ready(const pg8::Unit&) const {}
    __device__ __forceinline__ void done(const pg8::Unit&) const {}
};
struct SchedG2 {
    int G, c;
    __device__ bool next(int i, pg8::Unit& u) const {
        const int t = (i / 3) * G + c; if (t >= 256) return false;
        const int x = t & 7, q = t >> 3; u.pm = x * 8 + (q >> 2); u.pn = q & 3; u.z = i % 3; return true;
    }
    __device__ __forceinline__ size_t a_off(const pg8::Unit& u) const { return (size_t)u.z * PLANE + (size_t)u.pm * 256 * 1024 * 2; }
    __device__ __forceinline__ size_t b_off(const pg8::Unit& u) const { return ((size_t)u.z * 1024 + (size_t)u.pn * 256) * 1024 * 2; }
    __device__ __forceinline__ void a_ready(const pg8::Unit&) const {}
    __device__ __forceinline__ void done(const pg8::Unit&) const {}
};
struct SchedA1 {
    int G, c;
    __device__ bool next(int i, pg8::Unit& u) const { const int L = i * G + c; if (L >= 128) return false; u.pm = 0; u.pn = 0; u.z = L; return true; }
    __device__ __forceinline__ size_t a_off(const pg8::Unit& u) const { const int bh = u.z >> 4, ch = u.z & 15; return ((size_t)((bh >> 2) * 1024 + (bh & 3) * 256) * 8192 + (size_t)ch * 512) * 2; }
    __device__ __forceinline__ size_t b_off(const pg8::Unit& u) const { return a_off(u); }
    __device__ __forceinline__ void a_ready(const pg8::Unit&) const {}
    __device__ __forceinline__ void done(const pg8::Unit&) const {}
};

struct EpiG1 {
    static constexpr bool PERM = true, AFTER_DRAIN = false;
    unsigned char* ws;
    __device__ __forceinline__ void operator()(const f32x4 (&acc)[2][2][4][2], const pg8::Unit& u, int wr, int wc, int fr, int fq) const {
        asm volatile("" : "+v"(fr), "+v"(fq));
        const int p9 = u.pn >> 2;
        const int dpl = (p9 < 2) ? p9 : p9 + 1;
        bf16_t* base = (bf16_t*)(ws + (size_t)dpl * PLANE);
        bf16_t* halo = (bf16_t*)(ws + OFF_HALO);
        const int cc0 = (u.pn & 3) * 256 + wc * 32 + 8 * fq;
        const int row0 = u.pm * 256 + wr * 64 + fr;
        const bool transposed = (p9 == 4 || p9 == 8), hal = (p9 == 2 || p9 == 3);
        const float sc = (p9 == 6) ? (0.08838834764831845f * LOG2E) : 1.f;
#pragma unroll
        for (int ai = 0; ai < 2; ++ai)
#pragma unroll
            for (int m = 0; m < 4; ++m) {
                const int r = row0 + ai * 128 + m * 16;
#pragma unroll
                for (int bj = 0; bj < 2; ++bj) {
                    const int c = cc0 + bj * 128;
                    const f32x4 v0 = acc[ai][bj][m][0] * sc, v1 = acc[ai][bj][m][1] * sc;
                    u32x4 w; w.x = pk2(v0[0], v0[1]); w.y = pk2(v0[2], v0[3]); w.z = pk2(v1[0], v1[1]); w.w = pk2(v1[2], v1[3]);
                    if (!transposed) {
                        *(u32x4*)(base + (size_t)r * 1024 + c) = w;
                        if (hal && m == 3 && fr >= 13) *(u32x4*)(halo + ((size_t)(r >> 6) * 3 + (fr - 13)) * 2048 + (p9 == 3 ? 1024 : 0) + c) = w;
                    } else {
                        const int b = r >> 13, t = r & 8191;
                        bf16_t* p = base + ((size_t)(b * 1024 + c)) * 8192 + t;
                        p[0] = (bf16_t)(w.x & 0xffff); p[8192] = (bf16_t)(w.x >> 16); p[2 * 8192] = (bf16_t)(w.y & 0xffff); p[3 * 8192] = (bf16_t)(w.y >> 16);
                        p[4 * 8192] = (bf16_t)(w.z & 0xffff); p[5 * 8192] = (bf16_t)(w.z >> 16); p[6 * 8192] = (bf16_t)(w.w & 0xffff); p[7 * 8192] = (bf16_t)(w.w >> 16);
                    }
                }
            }
    }
};
struct EpiPlain {
    static constexpr bool PERM = true, AFTER_DRAIN = false;
    bf16_t* base; int ldc; size_t zstride; int split;
    __device__ __forceinline__ void operator()(const f32x4 (&acc)[2][2][4][2], const pg8::Unit& u, int wr, int wc, int fr, int fq) const {
        asm volatile("" : "+v"(fr), "+v"(fq));
        bf16_t* bp = base + (size_t)u.z * zstride;
        int colt = u.pn * 256;
        if (split) { bp += (size_t)(u.pn >> 2) * (PLANE / 2); colt = (u.pn & 3) * 256; }
        const int cc0 = colt + wc * 32 + 8 * fq, row0 = u.pm * 256 + wr * 64 + fr;
#pragma unroll
        for (int ai = 0; ai < 2; ++ai)
#pragma unroll
            for (int m = 0; m < 4; ++m) {
                bf16_t* rowp = bp + (size_t)(row0 + ai * 128 + m * 16) * ldc + cc0;
#pragma unroll
                for (int bj = 0; bj < 2; ++bj) {
                    const f32x4 v0 = acc[ai][bj][m][0], v1 = acc[ai][bj][m][1];
                    u32x4 w; w.x = pk2(v0[0], v0[1]); w.y = pk2(v0[2], v0[3]); w.z = pk2(v1[0], v1[1]); w.w = pk2(v1[2], v1[3]);
                    *(u32x4*)(rowp + bj * 128) = w;
                }
            }
    }
};
struct EpiG2 {
    static constexpr bool PERM = true, AFTER_DRAIN = false;
    const bf16_t* gates; bf16_t* tmp; bf16_t* outp;
    __device__ __forceinline__ void operator()(const f32x4 (&acc)[2][2][4][2], const pg8::Unit& u, int wr, int wc, int fr, int fq) const {
        asm volatile("" : "+v"(fr), "+v"(fq));
        const bf16_t* gp = gates + (size_t)u.z * (PLANE / 2);
        bf16_t* dst = (u.z == 2) ? outp : tmp;
        const int cc0 = u.pn * 256 + wc * 32 + 8 * fq, row0 = u.pm * 256 + wr * 64 + fr;
#pragma unroll
        for (int ai = 0; ai < 2; ++ai) {
            u32x4 gv[4][2], tv[4][2];
#pragma unroll
            for (int m = 0; m < 4; ++m)
#pragma unroll
                for (int bj = 0; bj < 2; ++bj) { const size_t o = (size_t)(row0 + ai * 128 + m * 16) * 1024 + cc0 + bj * 128;
                    gv[m][bj] = *(const u32x4*)(gp + o); tv[m][bj] = (u.z != 0) ? *(const u32x4*)(tmp + o) : (u32x4){0u, 0u, 0u, 0u}; }
#pragma unroll
            for (int m = 0; m < 4; ++m)
#pragma unroll
                for (int bj = 0; bj < 2; ++bj) { const size_t o = (size_t)(row0 + ai * 128 + m * 16) * 1024 + cc0 + bj * 128;
                    const u32x4 g = gv[m][bj], p = tv[m][bj];
                    f32x4 v0 = acc[ai][bj][m][0], v1 = acc[ai][bj][m][1];
                    v0[0] = v0[0] * sigm(bflo(g.x)) + bflo(p.x); v0[1] = v0[1] * sigm(bfhi(g.x)) + bfhi(p.x); v0[2] = v0[2] * sigm(bflo(g.y)) + bflo(p.y); v0[3] = v0[3] * sigm(bfhi(g.y)) + bfhi(p.y);
                    v1[0] = v1[0] * sigm(bflo(g.z)) + bflo(p.z); v1[1] = v1[1] * sigm(bfhi(g.z)) + bfhi(p.z); v1[2] = v1[2] * sigm(bflo(g.w)) + bflo(p.w); v1[3] = v1[3] * sigm(bfhi(g.w)) + bfhi(p.w);
                    u32x4 w; w.x = pk2(v0[0], v0[1]); w.y = pk2(v0[2], v0[3]); w.z = pk2(v1[0], v1[1]); w.w = pk2(v1[2], v1[3]);
                    *(u32x4*)(dst + o) = w; }
        }
    }
};
struct EpiG3 {
    static constexpr bool PERM = true, AFTER_DRAIN = false;
    const float* xin; float* out;
    __device__ __forceinline__ void operator()(const f32x4 (&acc)[2][2][4][2], const pg8::Unit& u, int wr, int wc, int fr, int fq) const {
        asm volatile("" : "+v"(fr), "+v"(fq));
        const int cc0 = u.pn * 256 + wc * 32 + 8 * fq, row0 = u.pm * 256 + wr * 64 + fr;
#pragma unroll
        for (int ai = 0; ai < 2; ++ai) {
            f32x4 xv[4][2][2];
#pragma unroll
            for (int m = 0; m < 4; ++m)
#pragma unroll
                for (int bj = 0; bj < 2; ++bj) { const size_t o = (size_t)(row0 + ai * 128 + m * 16) * 1024 + cc0 + bj * 128; xv[m][bj][0] = *(const f32x4*)(xin + o); xv[m][bj][1] = *(const f32x4*)(xin + o + 4); }
#pragma unroll
            for (int m = 0; m < 4; ++m)
#pragma unroll
                for (int bj = 0; bj < 2; ++bj) { const size_t o = (size_t)(row0 + ai * 128 + m * 16) * 1024 + cc0 + bj * 128;
                    *(f32x4*)(out + o) = xv[m][bj][0] + acc[ai][bj][m][0]; *(f32x4*)(out + o + 4) = xv[m][bj][1] + acc[ai][bj][m][1]; }
        }
    }
};

__device__ __forceinline__ int g1_srccol(int p) {
    switch (p) { case 0: return 4096; case 1: return 8200; case 2: return 0; case 3: return 1024; case 4: return 2048; case 5: return 3072; case 6: return 5128; case 7: return 6152; default: return 7176; } }

__device__ __forceinline__ void transpose_tile(const float* __restrict__ src, int pitch, bf16_t* __restrict__ dst, LAS float* scr, int tid) {
#pragma unroll
    for (int i = 0; i < 2; ++i) { const int r = (tid >> 4) + 32 * i, c4 = tid & 15; const f32x4 v = *(const f32x4*)(src + (size_t)r * pitch + c4 * 4);
        scr[r * 65 + c4 * 4 + 0] = v[0]; scr[r * 65 + c4 * 4 + 1] = v[1]; scr[r * 65 + c4 * 4 + 2] = v[2]; scr[r * 65 + c4 * 4 + 3] = v[3]; }
    __syncthreads();
    { const int n = tid >> 3, kc = tid & 7; float v[8];
#pragma unroll
      for (int j = 0; j < 8; ++j) v[j] = scr[(kc * 8 + j) * 65 + n];
      u32x4 w; w.x = pk2(v[0], v[1]); w.y = pk2(v[2], v[3]); w.z = pk2(v[4], v[5]); w.w = pk2(v[6], v[7]);
      *(u32x4*)(dst + (size_t)n * 1024 + kc * 8) = w; }
    __syncthreads();
}

__device__ __forceinline__ void phase_prep(const Args& a, int l, LAS unsigned char* lds, int tid) {
    unsigned char* ws = a.ws;
    const float* w_in = a.in[2] + (size_t)l * D * NIN;
    const float* w_br = a.in[10] + (size_t)l * 3 * D * D;
    const float* w_out = a.in[11] + (size_t)l * D * D;
    const float* pool_w = a.in[8] + (size_t)l * 4 * 256 * 256;
    const float* pool_s = a.in[9] + (size_t)l * D;
    LAS float* scr = (LAS float*)lds;
    for (int base = blockIdx.x * 4; base < 17 * 256; base += gridDim.x * 4) {
        f32x4 tv[4][2];
#pragma unroll
        for (int q = 0; q < 4; ++q) {
            const int it = base + q, id = it >> 8, nt = (it & 255) >> 4, kt = it & 15;
            const float* src; int pitch;
            if (id < 9)       { src = w_in + (size_t)(kt * 64) * NIN + g1_srccol(id) + nt * 64; pitch = NIN; }
            else if (id < 13) { const int qq = id - 9; const int col = (qq == 0) ? 10256 : 11280 + (qq - 1) * 1024; src = w_in + (size_t)(kt * 64) * NIN + col + nt * 64; pitch = NIN; }
            else if (id < 16) { const int n = id - 13; src = w_br + (size_t)n * D * D + (size_t)(kt * 64) * D + nt * 64; pitch = D; }
            else              { src = w_out + (size_t)(kt * 64) * D + nt * 64; pitch = D; }
#pragma unroll
            for (int i = 0; i < 2; ++i) { const int r = (tid >> 4) + 32 * i, c4 = tid & 15; tv[q][i] = *(const f32x4*)(src + (size_t)r * pitch + c4 * 4); }
        }
#pragma unroll
        for (int q = 0; q < 4; ++q)
#pragma unroll
            for (int i = 0; i < 2; ++i) { const int r = (tid >> 4) + 32 * i, c4 = tid & 15; LAS float* d = scr + q * 4160 + r * 65 + c4 * 4; d[0] = tv[q][i][0]; d[1] = tv[q][i][1]; d[2] = tv[q][i][2]; d[3] = tv[q][i][3]; }
        __syncthreads();
#pragma unroll
        for (int q = 0; q < 4; ++q) {
            const int it = base + q, id = it >> 8, nt = (it & 255) >> 4, kt = it & 15;
            bf16_t* dst;
            if (id < 9)       dst = (bf16_t*)(ws + OFF_WT1) + (size_t)(id * 1024 + nt * 64) * 1024 + kt * 64;
            else if (id < 13) { const int qq = id - 9; const int prow = (qq == 0) ? 0 : qq + 1; dst = (bf16_t*)(ws + OFF_WT1B) + (size_t)(prow * 1024 + nt * 64) * 1024 + kt * 64; }
            else if (id < 16) { const int n = id - 13; dst = (bf16_t*)(ws + OFF_WT2) + (size_t)(n * 1024 + nt * 64) * 1024 + kt * 64; }
            else              dst = (bf16_t*)(ws + OFF_WT3) + (size_t)(nt * 64) * 1024 + kt * 64;
            const int n = tid >> 3, kc = tid & 7; float v[8];
#pragma unroll
            for (int j = 0; j < 8; ++j) v[j] = scr[q * 4160 + (kc * 8 + j) * 65 + n];
            u32x4 w; w.x = pk2(v[0], v[1]); w.y = pk2(v[2], v[3]); w.z = pk2(v[4], v[5]); w.w = pk2(v[6], v[7]);
            *(u32x4*)(dst + (size_t)n * 1024 + kc * 8) = w;
        }
        __syncthreads();
    }
    for (int it = blockIdx.x; it < 256; it += gridDim.x) {
        const int g = it >> 6, kt = (it & 63) >> 2, dt = it & 3;
        LAS float* As = scr; LAS float* Bs = scr + 64 * 65;
        float acc[8];
#pragma unroll
        for (int j = 0; j < 8; ++j) acc[j] = 0.f;
        for (int cc = 0; cc < 4; ++cc) {
#pragma unroll
            for (int i = 0; i < 2; ++i) { const int r = (tid >> 4) + 32 * i, c4 = tid & 15;
                const f32x4 va = *(const f32x4*)(w_in + (size_t)(kt * 64 + r) * NIN + 9232 + g * 256 + cc * 64 + c4 * 4);
                As[r * 65 + c4 * 4 + 0] = va[0]; As[r * 65 + c4 * 4 + 1] = va[1]; As[r * 65 + c4 * 4 + 2] = va[2]; As[r * 65 + c4 * 4 + 3] = va[3];
                const f32x4 vb = *(const f32x4*)(pool_w + (size_t)(g * 256 + cc * 64 + r) * 256 + dt * 64 + c4 * 4);
                Bs[r * 64 + c4 * 4 + 0] = vb[0]; Bs[r * 64 + c4 * 4 + 1] = vb[1]; Bs[r * 64 + c4 * 4 + 2] = vb[2]; Bs[r * 64 + c4 * 4 + 3] = vb[3]; }
            __syncthreads();
            const int d = tid & 63, kg = tid >> 6;
            for (int c = 0; c < 64; ++c) { const float bv = Bs[c * 64 + d];
#pragma unroll
                for (int j = 0; j < 8; ++j) acc[j] += As[(kg * 8 + j) * 65 + c] * bv; }
            __syncthreads();
        }
        const int d = tid & 63, kg = tid >> 6;
        const float sc = pool_s[g * 256 + dt * 64 + d];
        u32x4 w; w.x = pk2(acc[0] * sc, acc[1] * sc); w.y = pk2(acc[2] * sc, acc[3] * sc); w.z = pk2(acc[4] * sc, acc[5] * sc); w.w = pk2(acc[6] * sc, acc[7] * sc);
        *(u32x4*)((bf16_t*)(ws + OFF_WT1B) + (size_t)(1024 + g * 256 + dt * 64 + d) * 1024 + kt * 64 + kg * 8) = w;
    }
    if (blockIdx.x == 0 && tid < 16) { ((unsigned*)(ws + OFF_KN2))[tid] = 0u; ((unsigned*)(ws + OFF_QCTR))[tid] = 0u; }
    LAS float* gw = (LAS float*)lds;
    __syncthreads();
    for (int e = tid; e < 16 * 1024; e += 512) { const int c = e & 15, k = e >> 4; const int col = (c < 8) ? 5120 + c : 9224 + (c - 8); gw[c * 1024 + k] = w_in[(size_t)k * NIN + col]; }
    __syncthreads();
    {
        const float* xin = (l == 0) ? a.in[0] : a.out;
        const float* ng = a.in[1] + (size_t)l * D;
        bf16_t* hb = (bf16_t*)(ws + 10 * PLANE);
        float* gates = (float*)(ws + OFF_GATES);
        const int wid = tid >> 6, lane = tid & 63;
        f32x4 gg[4];
#pragma unroll
        for (int j = 0; j < 4; ++j) gg[j] = *(const f32x4*)(ng + j * 256 + lane * 4);
        for (int row0 = blockIdx.x * 8 + wid; row0 < M; row0 += gridDim.x * 32) {
            f32x4 xa[4][4];
#pragma unroll
            for (int rr = 0; rr < 4; ++rr)
#pragma unroll
                for (int j = 0; j < 4; ++j) { const int rw = row0 + rr * gridDim.x * 8; xa[rr][j] = (rw < M) ? *(const f32x4*)(xin + (size_t)rw * D + j * 256 + lane * 4) : (f32x4){0.f, 0.f, 0.f, 0.f}; }
#pragma unroll
            for (int rr = 0; rr < 4; ++rr) {
                const int row = row0 + rr * gridDim.x * 8;
                if (row >= M) continue;
                f32x4 xv[4]; float ss = 0.f;
#pragma unroll
                for (int j = 0; j < 4; ++j) { xv[j] = xa[rr][j]; ss += xv[j][0] * xv[j][0] + xv[j][1] * xv[j][1] + xv[j][2] * xv[j][2] + xv[j][3] * xv[j][3]; }
                ss = wave_sum(ss);
                const float r = rsqrtf(ss * (1.f / 1024.f) + EPS);
#pragma unroll
                for (int j = 0; j < 4; ++j) { xv[j] = (xv[j] * r) * gg[j]; u32x2 w; w.x = pk2(xv[j][0], xv[j][1]); w.y = pk2(xv[j][2], xv[j][3]); *(u32x2*)(hb + (size_t)row * D + j * 256 + lane * 4) = w; }
                float ga[16];
#pragma unroll
                for (int c = 0; c < 16; ++c) { float s = 0.f;
#pragma unroll
                    for (int j = 0; j < 4; ++j) { const f32x4 wv = *(const LAS f32x4*)(gw + c * 1024 + j * 256 + lane * 4); s += xv[j][0] * wv[0] + xv[j][1] * wv[1] + xv[j][2] * wv[2] + xv[j][3] * wv[3]; }
                    ga[c] = s; }
                float b8[8], b4[4], b2[2], b1;
#pragma unroll
                for (int i = 0; i < 8; ++i) { const bool hi_ = (lane & 32) != 0; const float send = hi_ ? ga[i] : ga[i + 8], keep = hi_ ? ga[i + 8] : ga[i]; b8[i] = keep + __shfl_xor(send, 32); }
#pragma unroll
                for (int i = 0; i < 4; ++i) { const bool hi_ = (lane & 16) != 0; const float send = hi_ ? b8[i] : b8[i + 4], keep = hi_ ? b8[i + 4] : b8[i]; b4[i] = keep + __shfl_xor(send, 16); }
#pragma unroll
                for (int i = 0; i < 2; ++i) { const bool hi_ = (lane & 8) != 0; const float send = hi_ ? b4[i] : b4[i + 2], keep = hi_ ? b4[i + 2] : b4[i]; b2[i] = keep + __shfl_xor(send, 8); }
                { const bool hi_ = (lane & 4) != 0; const float send = hi_ ? b2[0] : b2[1], keep = hi_ ? b2[1] : b2[0]; b1 = keep + __shfl_xor(send, 4); }
                b1 += __shfl_xor(b1, 2); b1 += __shfl_xor(b1, 1);
                if ((lane & 3) == 0) gates[(size_t)row * 16 + ((lane >> 2) & 15)] = b1;
            }
        }
    }
    __syncthreads();
}

__device__ __forceinline__ float block_excl_scan_add(float tot, LAS float* sm, int tid) {
    const int lane = tid & 63, wid = tid >> 6; float x = tot;
#pragma unroll
    for (int o = 1; o < 64; o <<= 1) { const float v = __shfl_up(x, o); if (lane >= o) x += v; }
    __syncthreads();
    if (lane == 63) sm[wid] = x;
    __syncthreads();
    float base = 0.f;
    for (int w = 0; w < wid; ++w) base += sm[w];
    return base + x - tot;
}
__device__ __forceinline__ float block_excl_scan_max(float tot, LAS float* sm, int tid) {
    const int lane = tid & 63, wid = tid >> 6; float x = tot;
#pragma unroll
    for (int o = 1; o < 64; o <<= 1) { const float v = __shfl_up(x, o); if (lane >= o) x = fmaxf(x, v); }
    __syncthreads();
    if (lane == 63) sm[wid] = x;
    __syncthreads();
    float base = -INFINITY;
    for (int w = 0; w < wid; ++w) base = fmaxf(base, sm[w]);
    const float prev = __shfl_up(x, 1);
    return fmaxf(base, lane ? prev : -INFINITY);
}
__device__ __forceinline__ void phase_scans(const Args& a, int l, LAS unsigned char* lds, int tid) {
    unsigned char* ws = a.ws; const float* gates = (const float*)(ws + OFF_GATES);
    LAS float* sm = (LAS float*)lds;
    LAS float* Fs = sm + 64; LAS float* As = Fs + 8192; LAS float* Ms = As + 8192;
    const int bx = blockIdx.x;
    if (bx < 8) {
        const int b = bx >> 2, h = bx & 3; const float bi = a.in[4][l * 4 + h], bfv = a.in[5][l * 4 + h];
        float run = 0.f;
#pragma unroll 2
        for (int i = 0; i < 16; ++i) { const size_t row = (size_t)b * S + tid * 16 + i; run += logsig(gates[row * 16 + 4 + h] + bfv); Fs[tid * 16 + i] = run; }
        const float pre = block_excl_scan_add(run, sm, tid);
        float mx = -INFINITY;
#pragma unroll 2
        for (int i = 0; i < 16; ++i) { const size_t row = (size_t)b * S + tid * 16 + i; const float F = Fs[tid * 16 + i] + pre; const float av = gates[row * 16 + h] + bi - F;
            Fs[tid * 16 + i] = F; As[tid * 16 + i] = av; mx = fmaxf(mx, av); }
        const float pm = block_excl_scan_max(mx, sm + 16, tid);
        float Mrun = fmaxf(pm, 0.f);
#pragma unroll 2
        for (int i = 0; i < 16; ++i) { Mrun = fmaxf(Mrun, As[tid * 16 + i]); Ms[tid * 16 + i] = Mrun; }
        __syncthreads();
        if ((tid & 31) == 31) sm[32 + (tid >> 5)] = Mrun;
        __syncthreads();
        const float Mend = sm[32 + (tid >> 5)];
        float* A2 = (float*)(ws + OFF_A2) + (size_t)bx * S + tid * 16; float* M2 = (float*)(ws + OFF_M2) + (size_t)bx * S + tid * 16;
        float* EM = (float*)(ws + OFF_EM) + (size_t)bx * S + tid * 16; float* WK = (float*)(ws + OFF_WK) + (size_t)bx * S + tid * 16;
#pragma unroll 2
        for (int i = 0; i < 16; ++i) { const float av = As[tid * 16 + i], Mv = Ms[tid * 16 + i], F = Fs[tid * 16 + i];
            A2[i] = av * LOG2E; M2[i] = Mv * LOG2E; EM[i] = expf(-(F + Mv)); WK[i] = expf(av - Mend); }
        float* MP = (float*)(ws + OFF_MP2) + bx * 32;
        if (tid == 0) MP[0] = 0.f;
        if (tid < 16) MP[tid + 1] = sm[32 + tid] * LOG2E;
        __syncthreads();
    } else if (bx < 24) {
        const int bh = bx - 8, b = bh >> 3, h = bh & 7; const float bfv = a.in[7][l * 8 + h];
        float run = 0.f;
#pragma unroll 2
        for (int i = 0; i < 16; ++i) { const size_t row = (size_t)b * S + tid * 16 + i; run += logsig(gates[row * 16 + 8 + h] + bfv); Fs[tid * 16 + i] = run; }
        const float pre = block_excl_scan_add(run, sm, tid);
        float* F2 = (float*)(ws + OFF_F2) + (size_t)bh * S + tid * 16;
#pragma unroll 2
        for (int i = 0; i < 16; ++i) F2[i] = (Fs[tid * 16 + i] + pre) * LOG2E;
        __syncthreads();
    }
}

__device__ __forceinline__ void phase_conv(const Args& a, int l, LAS unsigned char* lds, int tid) {
    const bool dry = PROBE_RPT ? (a.dry != 0) : false;
    unsigned char* ws = a.ws;
    const float* cw = a.in[3] + (size_t)l * 4 * 2048;
    const bf16_t* halo = (const bf16_t*)(ws + OFF_HALO);
    const float* WK = (const float*)(ws + OFF_WK);
    LAS float* raw = (LAS float*)lds;
    LAS float* tb = raw + 67 * 65 + 3;
    const int r = tid >> 3, c8 = (tid & 7) * 8;
    const int NIT = 256 * 32;
    float cwr[4][8];
    { const int cs0 = blockIdx.x & 31;
#pragma unroll
      for (int kk = 0; kk < 4; ++kk)
#pragma unroll
          for (int j = 0; j < 8; ++j) cwr[kk][j] = cw[kk * 2048 + cs0 * 64 + c8 + j]; }
    const bool cw_fixed = (gridDim.x & 31) == 0;
    u32x4 pv = (u32x4){0u, 0u, 0u, 0u}, ph = (u32x4){0u, 0u, 0u, 0u};
    auto issue = [&](int it) {
        const int tt = it >> 5, cs = it & 31;
        const bf16_t* pl = (const bf16_t*)(ws + (size_t)((cs >= 16) ? 4 : 3) * PLANE);
        pv = *(const u32x4*)(pl + (size_t)(tt * 64 + r) * 1024 + (cs & 15) * 64 + c8);
        if (tid < 24 && (tt & 127) != 0) ph = *(const u32x4*)(halo + ((size_t)(tt - 1) * 3 + (tid >> 3)) * 2048 + cs * 64 + c8);
        else ph = (u32x4){0u, 0u, 0u, 0u};
    };
    if (blockIdx.x < 256 * 32) issue(blockIdx.x);
    for (int it = blockIdx.x; it < 256 * 32; it += gridDim.x) {
        const int tt = it >> 5, cs = it & 31;
        const bool isk = cs >= 16;
        bf16_t* pl = (bf16_t*)(ws + (size_t)(isk ? 4 : 3) * PLANE);
        const int c0 = (cs & 15) * 64;
        { const u32x4 v = pv; LAS float* d = raw + (r + 3) * 65 + c8;
          d[0] = bflo(v.x); d[1] = bfhi(v.x); d[2] = bflo(v.y); d[3] = bfhi(v.y); d[4] = bflo(v.z); d[5] = bfhi(v.z); d[6] = bflo(v.w); d[7] = bfhi(v.w); }
        if (tid < 24) { const u32x4 v = ph; LAS float* d = raw + (tid >> 3) * 65 + c8;
            d[0] = bflo(v.x); d[1] = bfhi(v.x); d[2] = bflo(v.y); d[3] = bfhi(v.y); d[4] = bflo(v.z); d[5] = bfhi(v.z); d[6] = bflo(v.w); d[7] = bfhi(v.w); }
        __syncthreads();
        if (it + (int)gridDim.x < 256 * 32) issue(it + gridDim.x);
        float o[8];
        { const int gc = cs * 64 + c8;
#pragma unroll
          for (int j = 0; j < 8; ++j) { float s = 0.f;
#pragma unroll
              for (int kk = 0; kk < 4; ++kk) s += (cw_fixed ? cwr[kk][j] : cw[kk * 2048 + gc + j]) * raw[(r + kk) * 65 + c8 + j];
              o[j] = silu(s); } }
        if (!isk) {
#pragma unroll
            for (int j = 0; j < 8; ++j) o[j] *= 0.0625f;
        }
        { u32x4 w; w.x = pk2(o[0], o[1]); w.y = pk2(o[2], o[3]); w.z = pk2(o[4], o[5]); w.w = pk2(o[6], o[7]);
          if (!dry) *(u32x4*)(pl + (size_t)(tt * 64 + r) * 1024 + c0 + c8) = w; }
        if (isk) {
            const int b = tt >> 7, t0 = (tt & 127) * 64, hh = c0 >> 8;
            const float wk = WK[(size_t)(b * 4 + hh) * S + t0 + r];
#pragma unroll
            for (int j = 0; j < 8; ++j) tb[(c8 + j) * 65 + r] = o[j] * wk;
            __syncthreads();
            const int c = tid >> 3, t8 = (tid & 7) * 8;
            float v[8];
#pragma unroll
            for (int j = 0; j < 8; ++j) v[j] = tb[c * 65 + t8 + j];
            u32x4 w; w.x = pk2(v[0], v[1]); w.y = pk2(v[2], v[3]); w.z = pk2(v[4], v[5]); w.w = pk2(v[6], v[7]);
            if (!dry) *(u32x4*)((bf16_t*)(ws + 11 * PLANE) + (size_t)(b * 1024 + c0 + c) * 8192 + t0 + t8) = w;
        }
        __syncthreads();
    }
    {
        LAS unsigned* smx = (LAS unsigned*)lds;
        if (tid < 16) smx[tid] = 0u;
        __syncthreads();
        const int wid = tid >> 6, lane = tid & 63;
        const bf16_t* bk = (const bf16_t*)(ws + 8 * PLANE);
        float m0 = 0.f, m1 = 0.f;
        for (int rowb_ = blockIdx.x * 8 + wid; rowb_ < M; rowb_ += gridDim.x * 32) {
          u32x4 kv[4][2];
#pragma unroll
          for (int u = 0; u < 4; ++u) { const int row = rowb_ + u * gridDim.x * 8; if (row < M) { kv[u][0] = *(const u32x4*)(bk + (size_t)row * 1024 + lane * 16); kv[u][1] = *(const u32x4*)(bk + (size_t)row * 1024 + lane * 16 + 8); } else { kv[u][0] = (u32x4){0u,0u,0u,0u}; kv[u][1] = (u32x4){0u,0u,0u,0u}; } }
#pragma unroll
          for (int u = 0; u < 4; ++u) {
            const int row = rowb_ + u * gridDim.x * 8; if (row >= M) continue;
            const u32x4 v0 = kv[u][0], v1 = kv[u][1];
            float s = bflo(v0.x) * bflo(v0.x) + bfhi(v0.x) * bfhi(v0.x) + bflo(v0.y) * bflo(v0.y) + bfhi(v0.y) * bfhi(v0.y) + bflo(v0.z) * bflo(v0.z) + bfhi(v0.z) * bfhi(v0.z) + bflo(v0.w) * bflo(v0.w) + bfhi(v0.w) * bfhi(v0.w)
                    + bflo(v1.x) * bflo(v1.x) + bfhi(v1.x) * bfhi(v1.x) + bflo(v1.y) * bflo(v1.y) + bfhi(v1.y) * bfhi(v1.y) + bflo(v1.z) * bflo(v1.z) + bfhi(v1.z) * bfhi(v1.z) + bflo(v1.w) * bflo(v1.w) + bfhi(v1.w) * bfhi(v1.w);
            s += __shfl_xor(s, 1); s += __shfl_xor(s, 2); s += __shfl_xor(s, 4);
            if (row < S) m0 = fmaxf(m0, s); else m1 = fmaxf(m1, s);
          }
        }
        if ((lane & 7) == 0) { __hip_atomic_fetch_max((unsigned*)(smx + (lane >> 3)), __float_as_uint(m0), __ATOMIC_RELAXED, __HIP_MEMORY_SCOPE_WORKGROUP); __hip_atomic_fetch_max((unsigned*)(smx + 8 + (lane >> 3)), __float_as_uint(m1), __ATOMIC_RELAXED, __HIP_MEMORY_SCOPE_WORKGROUP); }
        __syncthreads();
        if (tid < 16) __hip_atomic_fetch_max((unsigned*)(ws + OFF_KN2) + tid, smx[tid], __ATOMIC_RELAXED, __HIP_MEMORY_SCOPE_AGENT);
        __syncthreads();
    }
}

__device__ __forceinline__ void phase_statescan(const Args& a, int tid) {
    const bool dry = PROBE_RPT ? (a.dry != 0) : false;
    unsigned char* ws = a.ws;
    const float* MP = (const float*)(ws + OFF_MP2);
    bf16_t* Cst = (bf16_t*)(ws + OFF_CST);
    for (int grp = blockIdx.x * 512 + tid; grp < 8 * 16384; grp += gridDim.x * 512) {
        const int bh = grp >> 14, e = (grp & 16383) * 4;
        u32x2 dv[16];
#pragma unroll
        for (int c = 0; c < 16; ++c) dv[c] = *(const u32x2*)(Cst + ((size_t)(bh * 16 + c) * 65536 + e));
        float C0 = 0.f, C1 = 0.f, C2 = 0.f, C3 = 0.f;
#pragma unroll
        for (int c = 0; c < 16; ++c) {
            u32x2 w; w.x = pk2(C0, C1); w.y = pk2(C2, C3); if (!dry) *(u32x2*)(Cst + ((size_t)(bh * 16 + c) * 65536 + e)) = w;
            const float dec = exp2f(MP[bh * 32 + c] - MP[bh * 32 + c + 1]);
            C0 = dec * C0 + bflo(dv[c].x); C1 = dec * C1 + bfhi(dv[c].x); C2 = dec * C2 + bflo(dv[c].y); C3 = dec * C3 + bfhi(dv[c].y);
        }
    }
    const int wid = tid >> 6, lane = tid & 63;
    bf16_t* nst = (bf16_t*)(ws + OFF_NST);
    for (int gwv = blockIdx.x * 8 + wid; gwv < 2048; gwv += gridDim.x * 8) {
        const int bh = gwv >> 8, k = gwv & 255;
        const bf16_t* row = (const bf16_t*)(ws + 11 * PLANE) + (size_t)((bh >> 2) * 1024 + (bh & 3) * 256 + k) * 8192;
        float n = 0.f;
        u32x4 nv[16];
#pragma unroll
        for (int c = 0; c < 16; ++c) nv[c] = *(const u32x4*)(row + c * 512 + lane * 8);
#pragma unroll
        for (int c = 0; c < 16; ++c) {
            const u32x4 v = nv[c];
            float s = bflo(v.x) + bfhi(v.x) + bflo(v.y) + bfhi(v.y) + bflo(v.z) + bfhi(v.z) + bflo(v.w) + bfhi(v.w);
            s = wave_sum(s);
            if (lane == 0) nst[(size_t)(bh * 16 + c) * 256 + k] = (bf16_t)(pk2(n, n) & 0xffff);
            const float dec = exp2f(MP[bh * 32 + c] - MP[bh * 32 + c + 1]);
            n = dec * n + s;
        }
    }
}

#define MFMA32(a, b, c) __builtin_amdgcn_mfma_f32_32x32x16_bf16(a, b, c, 0, 0, 0)
#define EXP2RAW(x) __builtin_amdgcn_exp2f(x)
template <int MODE>
__device__ __forceinline__ void attn_unit(const Args& a, int l, int b, int h, int qb, LAS unsigned char* lds, int tid, const bool dry = false) {
    constexpr int DH = MODE ? 256 : 128, KS = DH / 16, QROWS = MODE ? 128 : 256, VROWS = DH, KP = DH * 2 + 16, VP = 144;
    constexpr int KCH = 64 * DH / 8 / 512, VCH = VROWS * 8 / 512;
    constexpr int KBYTES = 64 * KP, VBYTES = VROWS * VP, BUF = KBYTES + VBYTES + 256;
    constexpr int NBUF = MODE ? 1 : 2;
    unsigned char* ws = a.ws;
    const int wid = __builtin_amdgcn_readfirstlane(tid >> 6), lane = tid & 63, l32 = lane & 31, hi = lane >> 5;
    const int rg = MODE ? (wid & 3) : wid, vh = MODE ? (wid >> 2) : 0;
    const int q0 = qb * QROWS + rg * 32, tq = q0 + l32;
    const bf16_t* Qp = (const bf16_t*)(ws + (size_t)(MODE ? 3 : 7) * PLANE);
    const bf16_t* Kp = (const bf16_t*)(ws + (size_t)(MODE ? 4 : 8) * PLANE);
    const bf16_t* VTp = (const bf16_t*)(ws + (size_t)(MODE ? 5 : 9) * PLANE);
    const int bh = MODE ? (b * 4 + h) : (b * 8 + h);
    const float* biasG = MODE ? ((const float*)(ws + OFF_A2) + (size_t)bh * S) : ((const float*)(ws + OFF_F2) + (size_t)bh * S);
    LAS float* red = (LAS float*)(lds + NBUF * BUF);
    LAS unsigned char* Qs = lds + NBUF * BUF + 1024;
    LAS int* flags = (LAS int*)red;

    bf16x8 qf[MODE ? 1 : KS];
    if (MODE) {
        __syncthreads();
#pragma unroll
        for (int i = 0; i < 8; ++i) { const int q = tid + i * 512, r = q >> 5, cc = q & 31;
            *(LAS u32x4*)(Qs + r * KP + cc * 16) = *(const u32x4*)(Qp + (size_t)(b * S + qb * QROWS + r) * 1024 + h * DH + cc * 8); }
    } else {
#pragma unroll
        for (int ks = 0; ks < KS; ++ks) qf[ks] = *(const bf16x8*)(Qp + (size_t)(b * S + tq) * 1024 + h * DH + ks * 16 + hi * 8);
    }
#define QF(ks) (MODE ? *(const LAS bf16x8*)(Qs + (rg * 32 + l32) * KP + ((ks) * 16 + hi * 8) * 2) : qf[MODE ? 0 : (ks)])
    f32x16 O[4];
#pragma unroll
    for (int vb = 0; vb < 4; ++vb)
#pragma unroll
        for (int i = 0; i < 16; ++i) O[vb][i] = 0.f;
    const float rowb = biasG[tq];
    float m_run = -INFINITY, l_run = 0.f, den_inter = 0.f, M2t = 0.f;
    int j0 = 0, j1 = qb * 4 + 3;
    u32x4 kreg[KCH], vreg[VCH]; float breg = 0.f;
    auto gloadK = [&](int j) {
#pragma unroll
        for (int i = 0; i < KCH; ++i) { const int q = tid + i * 512, r = q / (DH / 8), cc = q % (DH / 8); kreg[i] = *(const u32x4*)(Kp + (size_t)(b * S + j * 64 + r) * 1024 + h * DH + cc * 8); }
    };
    auto gloadV = [&](int j) {
#pragma unroll
        for (int i = 0; i < VCH; ++i) { const int q = tid + i * 512, r = q >> 3, cc = q & 7; vreg[i] = *(const u32x4*)(VTp + (size_t)(b * 1024 + h * DH + r) * 8192 + j * 64 + cc * 8); }
        if (tid < 64) breg = biasG[j * 64 + tid];
    };
    auto gload = [&](int j) { gloadK(j); gloadV(j); };
    auto lwrite = [&](LAS unsigned char* bufp) {
#pragma unroll
        for (int i = 0; i < KCH; ++i) { const int q = tid + i * 512, r = q / (DH / 8), cc = q % (DH / 8); *(LAS u32x4*)(bufp + r * KP + cc * 16) = kreg[i]; }
#pragma unroll
        for (int i = 0; i < VCH; ++i) { const int q = tid + i * 512, r = q >> 3, cc = q & 7; LAS unsigned char* vp = bufp + KBYTES + r * VP + (cc >> 1) * 32 + (cc & 1) * 8;
            *(LAS u32x2*)vp = (u32x2){vreg[i].x, vreg[i].y}; *(LAS u32x2*)(vp + 16) = (u32x2){vreg[i].z, vreg[i].w}; }
        if (tid < 64) ((LAS float*)(bufp + KBYTES + VBYTES))[tid] = breg;
    };
    if (MODE) {
        const int ch = qb >> 2; j0 = ch * 8; j1 = qb * 2 + 1;
        M2t = ((const float*)(ws + OFF_M2))[(size_t)bh * S + tq];
        const bf16_t* Cb = (const bf16_t*)(ws + OFF_CST) + (size_t)(bh * 16 + ch) * 65536;
        if (tid < 32) ((LAS u32x4*)red)[tid] = *(const u32x4*)((const bf16_t*)(ws + OFF_NST) + (size_t)(bh * 16 + ch) * 256 + tid * 8);
#pragma unroll 1
        for (int half = 0; half < 2; ++half)
#pragma unroll
        for (int cl = 0; cl < 2; ++cl) {
            const int ci = half * 2 + cl;
#pragma unroll
            for (int i = 0; i < KCH; ++i) { const int q = tid + i * 512, r = q >> 5, cc = q & 31; kreg[i] = *(const u32x4*)(Cb + (size_t)(ci * 64 + r) * 256 + cc * 8); }
            __syncthreads();
#pragma unroll
            for (int i = 0; i < KCH; ++i) { const int q = tid + i * 512, r = q >> 5, cc = q & 31; *(LAS u32x4*)(lds + r * KP + cc * 16) = kreg[i]; }
            __syncthreads();
            if (vh == half) {
#pragma unroll
                for (int vbl = 0; vbl < 2; ++vbl)
#pragma unroll
                    for (int ks = 0; ks < KS; ++ks) { const bf16x8 af = *(const LAS bf16x8*)(lds + (vbl * 32 + l32) * KP + (ks * 16 + hi * 8) * 2); O[cl * 2 + vbl] = MFMA32(af, QF(ks), O[cl * 2 + vbl]); }
            }
        }
        float nq = 0.f;
#pragma unroll
        for (int ks = 0; ks < KS; ++ks) { const bf16x8 qv = QF(ks); const u32x4 nv = *(const LAS u32x4*)((LAS unsigned char*)red + (ks * 16 + hi * 8) * 2);
            nq += bf2f((unsigned short)qv[0]) * bflo(nv.x) + bf2f((unsigned short)qv[1]) * bfhi(nv.x) + bf2f((unsigned short)qv[2]) * bflo(nv.y) + bf2f((unsigned short)qv[3]) * bfhi(nv.y)
                + bf2f((unsigned short)qv[4]) * bflo(nv.z) + bf2f((unsigned short)qv[5]) * bfhi(nv.z) + bf2f((unsigned short)qv[6]) * bflo(nv.w) + bf2f((unsigned short)qv[7]) * bfhi(nv.w); }
        nq += __shfl_xor(nq, 32);
        const float winter = EXP2RAW(((const float*)(ws + OFF_MP2))[bh * 32 + ch] - M2t);
#pragma unroll
        for (int vb = 0; vb < 4; ++vb)
#pragma unroll
            for (int i = 0; i < 16; ++i) O[vb][i] *= winter;
        den_inter = winter * nq;
    }
    float Bt = 0.f;
    if (!MODE) {
        float qs = 0.f;
#pragma unroll
        for (int ks = 0; ks < (MODE ? 1 : KS); ++ks)
#pragma unroll
            for (int e = 0; e < 8; ++e) { const float f = bf2f((unsigned short)qf[ks][e]); qs += f * f; }
        qs += __shfl_xor(qs, 32);
        const float kn2 = __uint_as_float(((const unsigned*)(ws + OFF_KN2))[bh]);
        Bt = sqrtf(qs * kn2) * 1.01f + rowb;
    }
    const int ntile = j1 - j0 + 1;
    float fk_pref = (!MODE && ntile > 1) ? biasG[(j1 - 1) * 64 + 63] : 0.f;
    gload(MODE ? j0 : j1);
    __syncthreads();
    lwrite(lds);
    __syncthreads();
    if (!MODE && ntile > 1) gload(j1 - 1);
    for (int jt = 0; jt < ntile; ++jt) {
        const int j = MODE ? (j0 + jt) : (j1 - jt);
        LAS unsigned char* cur = lds + (MODE ? 0 : (jt & 1) * BUF);
        LAS unsigned char* Ks = cur; LAS unsigned char* Vs = cur + KBYTES; LAS float* biasK = (LAS float*)(cur + KBYTES + VBYTES);
        if (j * 64 <= q0 + 31) {
            bf16x8 pb[2][2];
            const bool diag = (j * 64 + 63 > q0);
            if (MODE) {
                float ls = 0.f;
#pragma unroll
                for (int kb = 0; kb < 2; ++kb) {
                    f32x16 s1;
#pragma unroll
                    for (int i = 0; i < 16; ++i) s1[i] = 0.f;
                    int zo = 0; asm volatile("" : "+v"(zo));
                    const LAS unsigned char* qrow = Qs + (rg * 32 + l32) * KP + hi * 16 + zo;
#pragma unroll
                    for (int ks = 0; ks < KS; ++ks) { const bf16x8 af = *(const LAS bf16x8*)(Ks + (kb * 32 + l32) * KP + (ks * 16 + hi * 8) * 2); s1 = MFMA32(af, *(const LAS bf16x8*)(qrow + ks * 32), s1); }
#pragma unroll
                    for (int i4 = 0; i4 < 4; ++i4) { const f32x4 bk = *(const LAS f32x4*)(biasK + kb * 32 + 8 * i4 + 4 * hi);
#pragma unroll
                        for (int r = 0; r < 4; ++r) { const int i = i4 * 4 + r; const int key = j * 64 + kb * 32 + 8 * i4 + 4 * hi + r;
                            float w = EXP2RAW(bk[r] - M2t); if (diag && key > tq) w = 0.f;
                            const float p = s1[i] * w; s1[i] = p; ls += p; } }
#pragma unroll
                    for (int jj = 0; jj < 2; ++jj) {
                        u32x4 w; w.x = pk2(s1[8 * jj + 0], s1[8 * jj + 1]); w.y = pk2(s1[8 * jj + 2], s1[8 * jj + 3]);
                        w.z = pk2(s1[8 * jj + 4], s1[8 * jj + 5]); w.w = pk2(s1[8 * jj + 6], s1[8 * jj + 7]);
                        pb[kb][jj] = __builtin_bit_cast(bf16x8, w);
                    }
                }
                l_run += ls;
            } else {
                f32x16 s[2];
#pragma unroll
                for (int kb = 0; kb < 2; ++kb) {
#pragma unroll
                    for (int i4 = 0; i4 < 4; ++i4) { const f32x4 bk = *(const LAS f32x4*)(biasK + kb * 32 + 8 * i4 + 4 * hi);
#pragma unroll
                        for (int r = 0; r < 4; ++r) s[kb][i4 * 4 + r] = rowb - bk[r]; }
#pragma unroll
                    for (int ks = 0; ks < KS; ++ks) { const bf16x8 af = *(const LAS bf16x8*)(Ks + (kb * 32 + l32) * KP + (ks * 16 + hi * 8) * 2); s[kb] = MFMA32(af, qf[MODE ? 0 : ks], s[kb]); }
                }
                if (diag) {
#pragma unroll
                    for (int kb = 0; kb < 2; ++kb)
#pragma unroll
                        for (int i = 0; i < 16; ++i) { const int key = j * 64 + kb * 32 + crow(i, hi); if (key > tq) s[kb][i] = -INFINITY; }
                }
                float mx = -INFINITY;
#pragma unroll
                for (int kb = 0; kb < 2; ++kb)
#pragma unroll
                    for (int i = 0; i < 16; ++i) mx = fmaxf(mx, s[kb][i]);
                mx = fmaxf(mx, __shfl_xor(mx, 32));
                const float m_new = fmaxf(m_run, mx);
                const float alpha = EXP2RAW(m_run - m_new);
                float ls = 0.f;
#pragma unroll
                for (int kb = 0; kb < 2; ++kb)
#pragma unroll
                    for (int i = 0; i < 16; ++i) { const float p = EXP2RAW(s[kb][i] - m_new); s[kb][i] = p; ls += p; }
                l_run = l_run * alpha + ls; m_run = m_new;
                if (__ballot(alpha != 1.f) != 0ull) {
#pragma unroll
                    for (int vb = 0; vb < 4; ++vb)
#pragma unroll
                        for (int i = 0; i < 16; ++i) O[vb][i] *= alpha;
                }
#pragma unroll
                for (int kb = 0; kb < 2; ++kb)
#pragma unroll
                    for (int jj = 0; jj < 2; ++jj) {
                        u32x4 w; w.x = pk2(s[kb][8 * jj + 0], s[kb][8 * jj + 1]); w.y = pk2(s[kb][8 * jj + 2], s[kb][8 * jj + 3]);
                        w.z = pk2(s[kb][8 * jj + 4], s[kb][8 * jj + 5]); w.w = pk2(s[kb][8 * jj + 6], s[kb][8 * jj + 7]);
                        pb[kb][jj] = __builtin_bit_cast(bf16x8, w);
                    }
            }
#pragma unroll
            for (int vb = 0; vb < 4; ++vb)
#pragma unroll
                for (int kb = 0; kb < 2; ++kb)
#pragma unroll
                    for (int jj = 0; jj < 2; ++jj) {
                        const bf16x8 af = *(const LAS bf16x8*)(Vs + (vh * 128 + vb * 32 + l32) * VP + (kb * 2 + jj) * 32 + hi * 16);
                        O[vb] = MFMA32(af, pb[kb][jj], O[vb]);
                    }
        }
        if (jt + 1 < ntile) {
            if (!MODE) {
                const float fk_last = fk_pref;
                const bool need = PROBE_NOPRUNE ? true : !((Bt - fk_last) - m_run < -160.f);
                const unsigned long long bal = __ballot(need);
                if (lane == 0) flags[wid] = (bal != 0ull) ? 1 : 0;
                lwrite(lds + ((jt + 1) & 1) * BUF);
                __syncthreads();
                const int any = flags[0] | flags[1] | flags[2] | flags[3] | flags[4] | flags[5] | flags[6] | flags[7];
                if (!any) break;
                if (jt + 2 < ntile) { gload(j - 2); fk_pref = biasG[(j - 2) * 64 + 63]; }
            } else {
                gload(j + 1);
                __syncthreads();
                lwrite(lds);
                __syncthreads();
            }
        }
    }
    const size_t rowoff = (size_t)(b * S + tq) * 1024;
    if (!MODE) {
        const float lt = l_run + __shfl_xor(l_run, 32);
        const float inv = 1.f / lt;
        bf16_t* bz = (bf16_t*)(ws + 1 * PLANE) + rowoff + h * 128;
#pragma unroll
        for (int vb = 0; vb < 4; ++vb)
#pragma unroll
            for (int i4 = 0; i4 < 4; ++i4) {
                bf16_t* p = bz + vb * 32 + 8 * i4 + 4 * hi;
                const u32x2 z = *(const u32x2*)p;
                u32x2 w; w.x = pk2(O[vb][i4 * 4 + 0] * inv * silu(bflo(z.x)), O[vb][i4 * 4 + 1] * inv * silu(bfhi(z.x)));
                w.y = pk2(O[vb][i4 * 4 + 2] * inv * silu(bflo(z.y)), O[vb][i4 * 4 + 3] * inv * silu(bfhi(z.y)));
                if (!dry) *(u32x2*)p = w;
            }
    } else {
        const float den = l_run + __shfl_xor(l_run, 32) + den_inter;
        const float em = ((const float*)(ws + OFF_EM))[(size_t)bh * S + tq];
        const float invd = 1.f / fmaxf(fabsf(den), em);
        float ssq = 0.f;
#pragma unroll
        for (int vb = 0; vb < 4; ++vb)
#pragma unroll
            for (int i = 0; i < 16; ++i) { O[vb][i] *= invd; ssq += O[vb][i] * O[vb][i]; }
        ssq += __shfl_xor(ssq, 32);
        if (hi == 0) red[(vh * 4 + rg) * 32 + l32] = ssq;
        __syncthreads();
        const float tot = red[rg * 32 + l32] + red[(4 + rg) * 32 + l32];
        const float rs = rsqrtf(tot * (1.f / 256.f) + EPS);
        const float* ng = a.in[6] + (size_t)l * D + h * 256 + vh * 128;
        bf16_t* az = (bf16_t*)(ws) + rowoff + h * 256 + vh * 128;
        const bf16_t* ao = (const bf16_t*)(ws + 6 * PLANE) + rowoff + h * 256 + vh * 128;
#pragma unroll
        for (int vb = 0; vb < 4; ++vb)
#pragma unroll
            for (int i4 = 0; i4 < 4; ++i4) {
                const int v = vb * 32 + 8 * i4 + 4 * hi;
                const u32x2 z = *(const u32x2*)(az + v), o = *(const u32x2*)(ao + v);
                const f32x4 g = *(const f32x4*)(ng + v);
                u32x2 w;
                w.x = pk2(O[vb][i4 * 4 + 0] * rs * g[0] * sigm(bflo(o.x)) * silu(bflo(z.x)), O[vb][i4 * 4 + 1] * rs * g[1] * sigm(bfhi(o.x)) * silu(bfhi(z.x)));
                w.y = pk2(O[vb][i4 * 4 + 2] * rs * g[2] * sigm(bflo(o.y)) * silu(bflo(z.y)), O[vb][i4 * 4 + 3] * rs * g[3] * sigm(bfhi(o.y)) * silu(bfhi(z.y)));
                if (!dry) *(u32x2*)(az + v) = w;
            }
    }
#undef QF
}

__device__ __forceinline__ void phase_attn(const Args& a, int l, LAS unsigned char* lds, int tid, const bool dry = false) {
    LAS int* slot = (LAS int*)(lds + LDS_BYTES - 16);
    unsigned* ctr = (unsigned*)(a.ws + OFF_QCTR) + (dry ? 2 : 0);
    if ((ATTNMASK & 1) && (!dry || (PROBE_DRYMASK & 1))) {
        for (;;) {
            __syncthreads();
            if (tid == 0) *slot = (int)__hip_atomic_fetch_add(ctr, 1u, __ATOMIC_RELAXED, __HIP_MEMORY_SCOPE_AGENT);
            __syncthreads();
            const int idx = *slot;
            if (idx >= 512) break;
            const int h = 7 - (idx >> 6), r = idx & 63;
            attn_unit<0>(a, l, r & 1, h, 31 - (r >> 1), lds, tid, dry);
        }
    }
    __syncthreads();
    if ((ATTNMASK & 2) && (!dry || (PROBE_DRYMASK & 2))) {
        int t2 = tid; asm volatile("" : "+v"(t2));
        for (;;) {
            __syncthreads();
            if (t2 == 0) *slot = (int)__hip_atomic_fetch_add(ctr + 1, 1u, __ATOMIC_RELAXED, __HIP_MEMORY_SCOPE_AGENT);
            __syncthreads();
            const int idx = *slot;
            if (idx >= 512) break;
            const int qm = 3 - (idx >> 7), r = idx & 127, bh = r & 7, ch = r >> 3;
            attn_unit<1>(a, l, bh >> 2, bh & 3, ch * 4 + qm, lds, t2, dry);
        }
    }
    __syncthreads();
}

__device__ __forceinline__ void phase_pool(const Args& a, int tid) {
    const bool dry = PROBE_RPT ? (a.dry != 0) : false;
    unsigned char* ws = a.ws;
    const bf16_t* cu = (const bf16_t*)(ws + 3 * PLANE); bf16_t* cz = (bf16_t*)(ws + 2 * PLANE);
    for (int idx = blockIdx.x * 512 + tid; idx < (M / 8) * 128; idx += gridDim.x * 512) {
        const int r0 = (idx >> 7) * 8, c = (idx & 127) * 8, g = c >> 8, W = 2 << g, t0 = r0 & 8191;
        u32x4 xv[23];
#pragma unroll
        for (int i = 0; i < 23; ++i) { const int dt = i - 15; xv[i] = (dt >= 1 - W && t0 + dt >= 0) ? *(const u32x4*)(cu + (size_t)(r0 + dt) * 1024 + c) : (u32x4){0u, 0u, 0u, 0u}; }
#pragma unroll
        for (int q = 0; q < 8; ++q) {
            const u32x4 z = *(const u32x4*)(cz + (size_t)(r0 + q) * 1024 + c);
            const int t = t0 + q, cnt = (t + 1 < W) ? t + 1 : W;
            float s[8];
#pragma unroll
            for (int j = 0; j < 8; ++j) s[j] = 0.f;
#pragma unroll
            for (int k = 0; k < 16; ++k) { if (k < cnt) { const u32x4 v = xv[15 + q - k];
                s[0] += bflo(v.x); s[1] += bfhi(v.x); s[2] += bflo(v.y); s[3] += bfhi(v.y); s[4] += bflo(v.z); s[5] += bfhi(v.z); s[6] += bflo(v.w); s[7] += bfhi(v.w); } }
            const float ic = 1.f / (float)cnt;
            const u32x4 cv = xv[15 + q];
            const float cur[8] = {bflo(cv.x), bfhi(cv.x), bflo(cv.y), bfhi(cv.y), bflo(cv.z), bfhi(cv.z), bflo(cv.w), bfhi(cv.w)};
            const float zf[8] = {bflo(z.x), bfhi(z.x), bflo(z.y), bfhi(z.y), bflo(z.z), bfhi(z.z), bflo(z.w), bfhi(z.w)};
            float o[8];
#pragma unroll
            for (int j = 0; j < 8; ++j) o[j] = (s[j] * ic - cur[j]) * silu(zf[j]);
            u32x4 w; w.x = pk2(o[0], o[1]); w.y = pk2(o[2], o[3]); w.z = pk2(o[4], o[5]); w.w = pk2(o[6], o[7]);
            if (!dry) *(u32x4*)(cz + (size_t)(r0 + q) * 1024 + c) = w;
        }
    }
}

__device__ __forceinline__ void phase_final(const Args& a, int tid) {
    const float* fg = a.in[12]; float* out = a.out;
    const int wid = tid >> 6, lane = tid & 63;
    f32x4 gg[4];
#pragma unroll
    for (int j = 0; j < 4; ++j) gg[j] = *(const f32x4*)(fg + j * 256 + lane * 4);
    for (int row = blockIdx.x * 8 + wid; row < M; row += gridDim.x * 8) {
        f32x4 xv[4]; float ss = 0.f;
#pragma unroll
        for (int j = 0; j < 4; ++j) { xv[j] = *(const f32x4*)(out + (size_t)row * D + j * 256 + lane * 4); ss += xv[j][0] * xv[j][0] + xv[j][1] * xv[j][1] + xv[j][2] * xv[j][2] + xv[j][3] * xv[j][3]; }
        ss = wave_sum(ss);
        const float r = rsqrtf(ss * (1.f / 1024.f) + EPS);
#pragma unroll
        for (int j = 0; j < 4; ++j) *(f32x4*)(out + (size_t)row * D + j * 256 + lane * 4) = (xv[j] * r) * gg[j];
    }
}

__global__ void __launch_bounds__(512) mega(Args a0) {
    extern __shared__ __attribute__((aligned(16))) unsigned char lds_raw[];
    LAS unsigned char* lds = (LAS unsigned char*)lds_raw;
    for (int ph = a0.ph_lo; ph < a0.ph_hi; ++ph) {
        Args a = a0; asm volatile("" : "+s"(a.ws), "+s"(a.out));
        unsigned char* ws = a.ws; int G = gridDim.x, cb = blockIdx.x; asm volatile("" : "+s"(G), "+s"(cb));
        int tid = threadIdx.x; asm volatile("" : "+v"(tid));
        const int l = ph / 10, k = (ph == 20) ? 10 : ph % 10;
        if (k == 0 && (PHMASK & 1)) phase_prep(a, l, lds, tid);
        else if (k == 1 && (PHMASK >> 1 & 1)) {
            phase_scans(a, l, lds, tid);
            pg8::Gemm g{(const bf16_t*)(ws + 10 * PLANE), (const bf16_t*)(ws + OFF_WT1), 1024, 1024, 1024};
            SchedStd Sd; Sd.init(64, 36, G, cb, 1024, 1024);
            EpiG1 E{ws};
            pg8::gemm_phase<EpiG1, SchedStd, true, true>(lds, g, Sd, E, tid);
        }
        else if (k == 2 && (PHMASK >> 2 & 1)) phase_conv(a, l, lds, tid);
        else if (k == 3 && (PHMASK >> 3 & 1)) {
            pg8::Gemm g{(const bf16_t*)(ws + 5 * PLANE), (const bf16_t*)(ws + 11 * PLANE), 8192, 8192, 512};
            SchedA1 Sd{G, cb};
            EpiPlain E{(bf16_t*)(ws + OFF_CST), 256, (size_t)65536, 0};
            pg8::gemm_phase<EpiPlain, SchedA1, true, true>(lds, g, Sd, E, tid);
        }
        else if (k == 4 && (PHMASK >> 4 & 1)) phase_statescan(a, tid);
        else if (k == 5 && (PHMASK >> 5 & 1)) phase_attn(a, l, lds, tid, PROBE_RPT ? (a.dry != 0) : false);
        else if (k == 6 && (PHMASK >> 6 & 1)) {
            pg8::Gemm g{(const bf16_t*)(ws + 10 * PLANE), (const bf16_t*)(ws + OFF_WT1B), 1024, 1024, 1024};
            SchedStd Sd; Sd.init(64, 20, G, cb, 1024, 1024);
            EpiPlain E{(bf16_t*)(ws + 2 * PLANE), 1024, (size_t)0, 1};
            pg8::gemm_phase<EpiPlain, SchedStd, true, true>(lds, g, Sd, E, tid);
        }
        else if (k == 7 && (PHMASK >> 7 & 1)) phase_pool(a, tid);
        else if (k == 8 && (PHMASK >> 8 & 1)) {
            pg8::Gemm g{(const bf16_t*)(ws), (const bf16_t*)(ws + OFF_WT2), 1024, 1024, 1024};
            SchedG2 Sd{G, cb};
            EpiG2 E{(const bf16_t*)(ws + 4 * PLANE), (bf16_t*)(ws + 7 * PLANE), (bf16_t*)(ws + 9 * PLANE)};
            pg8::gemm_phase<EpiG2, SchedG2, true, true>(lds, g, Sd, E, tid);
        }
        else if (k == 9 && (PHMASK >> 9 & 1)) {
            pg8::Gemm g{(const bf16_t*)(ws + 9 * PLANE), (const bf16_t*)(ws + OFF_WT3), 1024, 1024, 1024};
            SchedStd Sd; Sd.init(64, 4, G, cb, 1024, 1024);
            EpiG3 E{(l == 0) ? a.in[0] : a.out, a.out};
            pg8::gemm_phase<EpiG3, SchedStd, true, true>(lds, g, Sd, E, tid);
        }
        else if (k == 10 && (PHMASK >> 10 & 1)) phase_final(a, tid);
        if (ph + 1 < a0.ph_hi) { __syncthreads(); cg::this_grid().sync(); }
    }
}

extern "C" void kernel_launch(void* const* d_in, const int* in_sizes, int n_in, void* d_out, int out_size, void* d_ws, size_t ws_size, hipStream_t stream) {
    static int grid_blocks = 0;
    if (!grid_blocks) {
        hipFuncSetAttribute((const void*)mega, hipFuncAttributeMaxDynamicSharedMemorySize, LDS_BYTES);
        int dev = 0, cus = 0, per_cu = 0;
        hipGetDevice(&dev);
        hipDeviceGetAttribute(&cus, hipDeviceAttributeMultiprocessorCount, dev);
        hipOccupancyMaxActiveBlocksPerMultiprocessor(&per_cu, mega, 512, LDS_BYTES);
        if (per_cu < 1) per_cu = 1;
        grid_blocks = cus * per_cu; if (grid_blocks > 256) grid_blocks = 256;
    }
    if (ws_size < OFF_END) { fprintf(stderr, "workspace too small: %zu < %zu\n", ws_size, (size_t)OFF_END); return; }
    Args a{};
    for (int i = 0; i < 13; ++i) a.in[i] = (const float*)d_in[i];
    a.out = (float*)d_out; a.ws = (unsigned char*)d_ws;
#if MK_MULTI
    for (int ph = 0; ph < NPH; ++ph) {
        const int k = (ph == 20) ? 10 : ph % 10;
        const int reps = ((PROBE_RPT >> k) & 1) ? 2 : 1;
        for (int rep = 0; rep < reps; ++rep) { a.ph_lo = ph; a.ph_hi = ph + 1; a.dry = (reps == 2 && rep == 0) ? 1 : 0;
            hipLaunchKernelGGL(mega, dim3(grid_blocks), dim3(512), LDS_BYTES, stream, a); }
    }
#else
    a.ph_lo = 0; a.ph_hi = NPH;
    void* args[] = {&a};
    hipError_t e = hipLaunchCooperativeKernel((void*)mega, dim3(grid_blocks), dim3(512), args, LDS_BYTES, stream);
    if (e != hipSuccess) fprintf(stderr, "cooperative launch failed: %s (grid %d)\n", hipGetErrorString(e), grid_blocks);
#endif
}
```
